# Optimizing an MI355X kernel written in HIP

```python
import jax, jax.numpy as jnp
from jax import lax
import numpy as np

D_MODEL = 1024
BATCH = 1
SEQ = 16384
DEPTH = 2

GRID_W = 64
CTX_LEN = 256
N_MIXERS = 2
N_HEADS = 16
HEAD_DIM = D_MODEL // N_HEADS
NA_MAX_ROWS = 8
NA_COLS = 16
POOL_SIZES = (2, 4, 8, 16)
N_POOL_GROUPS = len(POOL_SIZES)
POOL_GROUP_DIM = D_MODEL // N_POOL_GROUPS
N_EXPERTS = 32
TOP_K = 4
D_EXPERT = D_MODEL
SWIGLU_LIMIT = 7.0
SWIGLU_ALPHA = 1.702
RMS_EPS = 1e-6
N_ATTN_LAYERS = (DEPTH + N_MIXERS - 1) // N_MIXERS
N_POOL_LAYERS = DEPTH // N_MIXERS

kernel_name = 'hybrid_natten_pool_moe_dit'


def rms_norm(x, g):
    xf = x.astype(jnp.float32)
    y = xf * lax.rsqrt(jnp.mean(xf * xf, axis=-1, keepdims=True) + RMS_EPS)
    return (y * g.astype(jnp.float32)).astype(x.dtype)


def adaln(cond, w, b):
    mod = jax.nn.silu(cond) @ w + b
    return jnp.split(mod, 6, axis=-1)


def modulate(x, g, shift, scale):
    return rms_norm(x, g) * (1 + scale) + shift


def neighbourhood_attention(q, k, v, k_ctx, v_ctx, rpb):
    B, L, H, Dh = q.shape
    rows = L // GRID_W
    kh = min(NA_MAX_ROWS, rows)
    kw = NA_COLS
    q = q * (Dh ** -0.5)
    qg = q.reshape(B, rows, GRID_W, H, Dh).transpose(1, 0, 2, 3, 4)
    kg = k.reshape(B, rows, GRID_W, H, Dh)
    vg = v.reshape(B, rows, GRID_W, H, Dh)
    r_idx = jnp.arange(rows)
    row_start = jnp.clip(r_idx - kh // 2, 0, rows - kh)
    c_idx = jnp.arange(GRID_W)
    col_start = jnp.clip(c_idx - kw // 2, 0, GRID_W - kw)
    col_win = col_start[:, None] + jnp.arange(kw)[None, :]
    dc = col_win - c_idx[:, None] + (NA_COLS - 1)

    def row_block(args):
        q_r, r, r0 = args
        k_blk = lax.dynamic_slice_in_dim(kg, r0, kh, axis=1)
        v_blk = lax.dynamic_slice_in_dim(vg, r0, kh, axis=1)
        k_win = k_blk[:, :, col_win]
        v_win = v_blk[:, :, col_win]
        dr = r0 + jnp.arange(kh) - r + (NA_MAX_ROWS - 1)
        bias = rpb[:, dr[:, None, None], dc[None, :, :]]
        s_loc = jnp.einsum('bchd,bicjhd->bhcij', q_r, k_win, preferred_element_type=jnp.float32)
        s_loc = s_loc + bias.transpose(0, 2, 1, 3)[None].astype(jnp.float32)
        s_loc = s_loc.reshape(B, H, GRID_W, kh * kw)
        s_ctx = jnp.einsum('bchd,bnhd->bhcn', q_r, k_ctx, preferred_element_type=jnp.float32)
        p = jax.nn.softmax(jnp.concatenate([s_loc, s_ctx], axis=-1), axis=-1).astype(v.dtype)
        p_loc = p[..., :kh * kw].reshape(B, H, GRID_W, kh, kw)
        p_ctx = p[..., kh * kw:]
        return (jnp.einsum('bhcij,bicjhd->bchd', p_loc, v_win)
                + jnp.einsum('bhcn,bnhd->bchd', p_ctx, v_ctx))

    o = lax.map(row_block, (qg, r_idx, row_start))
    return o.transpose(1, 0, 2, 3, 4).reshape(B, L, H * Dh)


def context_attention(q, k, v):
    B, C, H, Dh = q.shape
    s = jnp.einsum('bqhd,bkhd->bhqk', q * (Dh ** -0.5), k, preferred_element_type=jnp.float32)
    p = jax.nn.softmax(s, axis=-1).astype(v.dtype)
    return jnp.einsum('bhqk,bkhd->bqhd', p, v).reshape(B, C, H * Dh)


def multiscale_pool(h, w, b, scale):
    B, L, D = h.shape
    hf = h.astype(jnp.float32)
    csum = jnp.concatenate([jnp.zeros((B, 1, D), jnp.float32), jnp.cumsum(hf, axis=1)], axis=1)
    t = jnp.arange(L)
    diffs = []
    for g, size in enumerate(POOL_SIZES):
        sl = slice(g * POOL_GROUP_DIM, (g + 1) * POOL_GROUP_DIM)
        lo = jnp.clip(t - size // 2, 0, L)
        hi = jnp.clip(t - size // 2 + size, 0, L)
        cnt = (hi - lo).astype(jnp.float32)[None, :, None]
        mean = (csum[:, hi, sl] - csum[:, lo, sl]) / cnt
        diffs.append(mean - hf[:, :, sl])
    diff = jnp.stack(diffs, axis=2).astype(h.dtype)
    y = jnp.einsum('blgc,gcd->blgd', diff, w) + b
    return y.reshape(B, L, D) * scale


def moe(x, w_router, b_router, w_up, b_up, w_down, b_down):
    B, L, D = x.shape
    xt = x.reshape(B * L, D)
    logits = (xt @ w_router + b_router).astype(jnp.float32)
    top_v, top_i = lax.top_k(logits, TOP_K)
    top_w = jax.nn.softmax(top_v, axis=-1)
    gates = jnp.sum(jax.nn.one_hot(top_i, N_EXPERTS, dtype=jnp.float32) * top_w[..., None], axis=1)
    out = jnp.zeros((B * L, D), jnp.float32)
    for e in range(N_EXPERTS):
        hid = xt @ w_up[e] + b_up[e]
        x_glu = jnp.minimum(hid[:, :D_EXPERT], SWIGLU_LIMIT)
        x_lin = jnp.clip(hid[:, D_EXPERT:], -SWIGLU_LIMIT, SWIGLU_LIMIT)
        act = x_glu * jax.nn.sigmoid(SWIGLU_ALPHA * x_glu) * (x_lin + 1)
        y = act @ w_down[e] + b_down[e]
        out = out + gates[:, e:e + 1] * y.astype(jnp.float32)
    return out.astype(x.dtype).reshape(B, L, D)


def setup_inputs(seed: int = 0) -> dict:
    key = jax.random.key(seed)
    ks = jax.random.split(key, 20)
    f32 = jnp.float32
    D = D_MODEL
    nrm = lambda k, shape, s: jax.random.normal(k, shape, f32) * s
    return {
        'x': nrm(ks[0], (BATCH, SEQ, D), 1.0),
        'c': nrm(ks[1], (BATCH, D), 1.0),
        'ctx': nrm(ks[2], (BATCH, CTX_LEN, D), 1.0),
        'c_ctx': nrm(ks[3], (D,), 1.0),
        'ada_w': nrm(ks[4], (DEPTH, D, 6 * D), 0.5 * D ** -0.5),
        'ada_b': nrm(ks[5], (DEPTH, 6 * D), 0.02),
        'norm_g': 1.0 + nrm(ks[6], (DEPTH, 4, D), 0.05),
        'na_w_qkv': nrm(ks[7], (N_ATTN_LAYERS, D, 3 * D), D ** -0.5),
        'na_w_o': nrm(ks[8], (N_ATTN_LAYERS, D, D), D ** -0.5),
        'na_rpb': nrm(ks[9], (N_ATTN_LAYERS, N_HEADS, 2 * NA_MAX_ROWS - 1, 2 * NA_COLS - 1), 0.1),
        'pool_w': nrm(ks[10], (N_POOL_LAYERS, N_POOL_GROUPS, POOL_GROUP_DIM, POOL_GROUP_DIM), POOL_GROUP_DIM ** -0.5),
        'pool_b': nrm(ks[11], (N_POOL_LAYERS, N_POOL_GROUPS, POOL_GROUP_DIM), 0.02),
        'pool_scale': 1.0 + nrm(ks[12], (N_POOL_LAYERS, D), 0.1),
        'moe_w_router': nrm(ks[13], (DEPTH, D, N_EXPERTS), D ** -0.5),
        'moe_b_router': nrm(ks[14], (DEPTH, N_EXPERTS), 0.01),
        'moe_w_up': nrm(ks[15], (DEPTH, N_EXPERTS, D, 2 * D_EXPERT), D ** -0.5),
        'moe_b_up': nrm(ks[16], (DEPTH, N_EXPERTS, 2 * D_EXPERT), 0.02),
        'moe_w_down': nrm(ks[17], (DEPTH, N_EXPERTS, D_EXPERT, D), D_EXPERT ** -0.5),
        'moe_b_down': nrm(ks[18], (DEPTH, N_EXPERTS, D), 0.02),
    }


def reference(x, c, ctx, c_ctx, ada_w, ada_b, norm_g, na_w_qkv, na_w_o, na_rpb, pool_w, pool_b, pool_scale,
              moe_w_router, moe_b_router, moe_w_up, moe_b_up, moe_w_down, moe_b_down):
    B, L, D = x.shape
    C = ctx.shape[1]
    h_ctx = ctx
    for i in range(DEPTH):
        mixer = i % N_MIXERS
        ctx_needed = any(j % N_MIXERS == 0 for j in range(i + 1, DEPTH))
        sh1, sc1, g1, sh2, sc2, g2 = [m[:, None, :] for m in adaln(c, ada_w[i], ada_b[i])]
        if mixer == 0 or ctx_needed:
            csh1, csc1, cg1, csh2, csc2, cg2 = adaln(c_ctx, ada_w[i], ada_b[i])
            hc = modulate(h_ctx, norm_g[i, 0], csh1, csc1)
        hx = modulate(x, norm_g[i, 0], sh1, sc1)
        if mixer == 0:
            a = i // N_MIXERS
            qkv_x = (hx @ na_w_qkv[a]).reshape(B, L, 3, N_HEADS, HEAD_DIM)
            qkv_c = (hc @ na_w_qkv[a]).reshape(B, C, 3, N_HEADS, HEAD_DIM)
            q, k, v = qkv_x[:, :, 0], qkv_x[:, :, 1], qkv_x[:, :, 2]
            qc, kc, vc = qkv_c[:, :, 0], qkv_c[:, :, 1], qkv_c[:, :, 2]
            mx = neighbourhood_attention(q, k, v, kc, vc, na_rpb[a]) @ na_w_o[a]
            if ctx_needed:
                mc = context_attention(qc, kc, vc) @ na_w_o[a]
        else:
            p = i // N_MIXERS
            mx = multiscale_pool(hx, pool_w[p], pool_b[p], pool_scale[p])
            if ctx_needed:
                mc = multiscale_pool(hc, pool_w[p], pool_b[p], pool_scale[p])
        x = x + g1 * rms_norm(mx, norm_g[i, 1])
        hx2 = modulate(x, norm_g[i, 2], sh2, sc2)
        if ctx_needed:
            h_ctx = h_ctx + cg1 * rms_norm(mc, norm_g[i, 1])
            hc2 = modulate(h_ctx, norm_g[i, 2], csh2, csc2)
            f_all = moe(jnp.concatenate([hx2, hc2], axis=1), moe_w_router[i], moe_b_router[i],
                        moe_w_up[i], moe_b_up[i], moe_w_down[i], moe_b_down[i])
            fx, fc = f_all[:, :L], f_all[:, L:]
            h_ctx = h_ctx + cg2 * rms_norm(fc, norm_g[i, 3])
        else:
            fx = moe(hx2, moe_w_router[i], moe_b_router[i], moe_w_up[i], moe_b_up[i],
                     moe_w_down[i], moe_b_down[i])
        x = x + g2 * rms_norm(fx, norm_g[i, 3])
    return x
```

```cpp
#include <hip/hip_runtime.h>
#include <cstdio>
#include <cstdint>

#ifndef Y_FP8
#define Y_FP8 1
#endif
#ifndef MK_ONE_LAUNCH
#define MK_ONE_LAUNCH 1
#ifndef PROBE_HOT
#define PROBE_HOT 0
#endif
#ifndef PROBE_NT5
#define PROBE_NT5 0
#endif
#ifndef PROBE_NOEPI
#define PROBE_NOEPI 0
#endif
#ifndef QKV_FP8
#define QKV_FP8 1
#endif
#endif

#define GAS __attribute__((address_space(1)))
#define LAS __attribute__((address_space(3)))
typedef unsigned short bf16_t;
typedef short bf16x8 __attribute__((ext_vector_type(8)));
typedef short s16x4 __attribute__((ext_vector_type(4)));
typedef float f32x4 __attribute__((ext_vector_type(4)));
typedef float f32x2 __attribute__((ext_vector_type(2)));
typedef unsigned u32x4 __attribute__((ext_vector_type(4)));
typedef unsigned u32x2 __attribute__((ext_vector_type(2)));
typedef int v8i __attribute__((ext_vector_type(8)));
typedef int v4i __attribute__((ext_vector_type(4)));

constexpr int L = 16384, D = 1024, CTX = 256, NH = 16, HD = 64, NE = 32, GW = 64;
constexpr int MQ = L + CTX;
constexpr float RMS_EPS = 1e-6f;
constexpr float LOG2E = 1.4426950408889634f;
constexpr float QSCALE = 0.125f * LOG2E;
constexpr int NWAVES = 8, NT = 512;

constexpr size_t MiB = 1u << 20;
constexpr size_t WS_CTL = 0, CTL_ZERO_BYTES = 128 * 1024;
constexpr size_t WS_MOD = 1 * MiB;
constexpr size_t WS_POS = 1 * MiB + 256 * 1024;
constexpr size_t WS_VEC = 1 * MiB + 512 * 1024;
constexpr size_t WS_WRT = 1 * MiB + 768 * 1024;
constexpr size_t WS_WQKV = 2 * MiB;
constexpr size_t WS_WO = 8 * MiB;
constexpr size_t WS_WPOOL = 10 * MiB;
constexpr size_t WS_LIST = 12 * MiB;
constexpr size_t WS_GATE = 14 * MiB;
constexpr size_t WS_HX = 16 * MiB;
constexpr size_t WS_Q = 50 * MiB, WS_K = 83 * MiB, WS_V = 116 * MiB;
constexpr size_t WS_O = 150 * MiB;
constexpr size_t WS_MX = 182 * MiB;
constexpr size_t WS_HX2 = 214 * MiB;
constexpr size_t WS_ACT = 256 * MiB;
constexpr size_t WS_Y = 408 * MiB;
constexpr size_t WS_WUP = 544 * MiB;
constexpr size_t WS_WDN = 816 * MiB;
constexpr size_t WS_XR = 952 * MiB;
constexpr size_t WS_END = 984 * MiB;
constexpr int CW_BAR = 4096;
constexpr int CW_CNT = 16384;
constexpr int CW_Q = 20480;
constexpr int CW_DONE = 24576;
constexpr int ACT_ROWS = 73728, LIST_CAP = 16384;

constexpr int RING_BYTES = 131072;
constexpr int MISC_OFF = RING_BYTES;
constexpr int M_PRE = MISC_OFF + 8192;
#ifndef Y_SORTED
#define Y_SORTED 0
#endif
#ifndef EPI_STAGE
#define EPI_STAGE 1
#endif
constexpr int STG0 = 3 * 16384;
constexpr int STG1 = 147456;
constexpr int LDS_BYTES = EPI_STAGE ? 163840 : 147456;

#define LDS_WAIT() asm volatile("s_waitcnt lgkmcnt(0)" ::: "memory")
#define VM_WAIT() asm volatile("s_waitcnt vmcnt(0)" ::: "memory")

typedef __bf16 bf16x2_t __attribute__((ext_vector_type(2)));
__device__ __forceinline__ unsigned cvt_pk_bf16(float lo, float hi) { const f32x2 v = {lo, hi}; return __builtin_bit_cast(unsigned, __builtin_convertvector(v, bf16x2_t)); }
__device__ __forceinline__ float clamp448(float v) { return __builtin_amdgcn_fmed3f(v, -448.0f, 448.0f); }
__device__ __forceinline__ unsigned cvt_pk4_fp8(float a, float b, float c, float d) { int w = __builtin_amdgcn_cvt_pk_fp8_f32(a, b, 0, false); w = __builtin_amdgcn_cvt_pk_fp8_f32(c, d, w, true); return (unsigned)w; }
__device__ __forceinline__ unsigned cvt_pk4_fp8_sat(float a, float b, float c, float d) { return cvt_pk4_fp8(clamp448(a), clamp448(b), clamp448(c), clamp448(d)); }
__device__ __forceinline__ float bf_lo(unsigned u) { return __uint_as_float(u << 16); }
__device__ __forceinline__ float bf_hi(unsigned u) { return __uint_as_float(u & 0xffff0000u); }
#ifndef WT_STORES
#define WT_STORES 0
#endif
__device__ __forceinline__ void st16(void* p, u32x4 v) {
#if WT_STORES
    asm volatile("global_store_dwordx4 %0, %1, off sc1\n\ts_nop 1" :: "v"(p), "v"(v) : "memory");
#else
    *(u32x4*)p = v;
#endif
}
#ifndef STAGE_NT
#define STAGE_NT 1
#endif
#ifndef NT_DOWN
#define NT_DOWN 0
#endif
__device__ __forceinline__ void st16nt(void* p, u32x4 v) { __builtin_nontemporal_store(v, (u32x4*)p); }
__device__ __forceinline__ void st8(void* p, u32x2 v) {
#if 0
    asm volatile("global_store_dwordx2 %0, %1, off sc1\n\ts_nop 1" :: "v"(p), "v"(v) : "memory");
#else
    *(u32x2*)p = v;
#endif
}
__device__ __forceinline__ void st4(void* p, unsigned v) {
#if 0
    asm volatile("global_store_dword %0, %1, off sc1\n\ts_nop 1" :: "v"(p), "v"(v) : "memory");
#else
    *(unsigned*)p = v;
#endif
}
__device__ __forceinline__ float wave_sum(float v) {
    v += __builtin_bit_cast(float, __builtin_amdgcn_update_dpp(0, __builtin_bit_cast(int, v), 0xB1, 0xf, 0xf, true));
    v += __builtin_bit_cast(float, __builtin_amdgcn_update_dpp(0, __builtin_bit_cast(int, v), 0x4E, 0xf, 0xf, true));
    v += __builtin_bit_cast(float, __builtin_amdgcn_update_dpp(0, __builtin_bit_cast(int, v), 0x124, 0xf, 0xf, true));
    v += __builtin_bit_cast(float, __builtin_amdgcn_update_dpp(0, __builtin_bit_cast(int, v), 0x128, 0xf, 0xf, true));
    v += __builtin_bit_cast(float, __builtin_amdgcn_ds_swizzle(__builtin_bit_cast(int, v), 0x401F));
    return __builtin_bit_cast(float, __builtin_amdgcn_readlane(__builtin_bit_cast(int, v), 0)) + __builtin_bit_cast(float, __builtin_amdgcn_readlane(__builtin_bit_cast(int, v), 32));
}

#define XB_TMO      128
#define XB_XCNT(j)  (256  + 64 * (j))
#define XB_XSUB(j)  (1280 + 64 * (j))
#define XB_XGEN(j)  (2304 + 64 * (j))
#define XB_TOP      3328
#define XB_TOPGEN   3392
#define XCD_BAR_WORDS 3456
#define XB_SPIN_CAP (1u << 18)
__device__ __forceinline__ unsigned xb_ld(unsigned* p)              { return __hip_atomic_load(p, __ATOMIC_RELAXED, __HIP_MEMORY_SCOPE_AGENT); }
__device__ __forceinline__ unsigned xb_add(unsigned* p, unsigned v) { return __hip_atomic_fetch_add(p, v, __ATOMIC_RELAXED, __HIP_MEMORY_SCOPE_AGENT); }
__device__ __forceinline__ unsigned xb_xcc_id() { return (unsigned)__builtin_amdgcn_s_getreg((3 << 11) | 20) & 0xFu; }
#define XB_SPIN(cond, bar) do { unsigned _sp = 0; while (cond) { __builtin_amdgcn_s_sleep(1); \
    if ((++_sp & 255u) == 0u) { if (xb_ld(&(bar)[XB_TMO])) break; if (_sp > XB_SPIN_CAP) { atomicAdd(&(bar)[XB_TMO], 1u); break; } } } } while (0)
struct XcdBarrier { unsigned* bar; unsigned x; volatile LAS unsigned* st; };
__device__ __forceinline__ XcdBarrier xcd_barrier_post(unsigned* bar, volatile LAS unsigned* st, bool leader) {
    XcdBarrier b; b.bar = bar; b.x = xb_xcc_id(); b.st = st;
    if (leader) (void)xb_add(&bar[XB_XCNT(b.x)], 1u);
    return b;
}
__device__ __forceinline__ void xcd_barrier_complete(unsigned* bar, unsigned x, unsigned& nloc, unsigned& nx) {
    const unsigned G = gridDim.x * gridDim.y * gridDim.z;
    unsigned sum, cnt, mine, sp = 0u;
    for (;;) {
        sum = 0u; cnt = 0u; mine = 0u;
#pragma unroll
        for (unsigned j = 0; j < 16; ++j) { const unsigned c = xb_ld(&bar[XB_XCNT(j)]); sum += c; cnt += (c > 0u) ? 1u : 0u; mine = (j == x) ? c : mine; }
        if (sum == G) break;
        __builtin_amdgcn_s_sleep(1);
        if ((++sp & 255u) == 0u) { if (xb_ld(&bar[XB_TMO])) break; if (sp > XB_SPIN_CAP) { atomicAdd(&bar[XB_TMO], 1u); break; } }
    }
    nloc = mine > 0u ? mine : 1u; nx = cnt > 0u ? cnt : 1u;
}
__device__ __forceinline__ void xcd_barrier(const XcdBarrier& b, bool leader) {
    asm volatile("s_waitcnt vmcnt(0)" ::: "memory");
    __syncthreads();
    if (leader) {
        unsigned* bar = b.bar;
        __builtin_amdgcn_s_waitcnt(0);
        unsigned nloc = b.st[0], nx = b.st[1];
        if (nloc == 0u) { xcd_barrier_complete(bar, b.x, nloc, nx); b.st[0] = nloc; b.st[1] = nx; }
        const unsigned old = xb_add(&bar[XB_XSUB(b.x)], 1u);
        const unsigned gen = old / nloc;
        if (old + 1u == (gen + 1u) * nloc) {
            __builtin_amdgcn_fence(__ATOMIC_RELEASE, "agent");
            asm volatile("s_waitcnt vmcnt(0)" ::: "memory");
            const unsigned og = xb_add(&bar[XB_TOP], 1u);
            const unsigned tg = og / nx;
            if (og + 1u == (tg + 1u) * nx) xb_add(&bar[XB_TOPGEN], 1u);
            else XB_SPIN(xb_ld(&bar[XB_TOPGEN]) == tg, bar);
            __builtin_amdgcn_fence(__ATOMIC_ACQUIRE, "agent");
            xb_add(&bar[XB_XGEN(b.x)], 1u);
            asm volatile("s_waitcnt vmcnt(0)" ::: "memory");
        } else {
            XB_SPIN(xb_ld(&bar[XB_XGEN(b.x)]) == gen, bar);
            __builtin_amdgcn_fence(__ATOMIC_ACQUIRE, "agent");
            asm volatile("s_waitcnt vmcnt(0)" ::: "memory");
        }
    }
    __syncthreads();
}

#ifndef K_ROT
#define K_ROT 0
#endif
namespace gm {
constexpr int BM = 256, BK = 64, HALF = 128, HTB = HALF * BK * 2, STAGE_BYTES = 8 * HTB, NXCD = 8, WGM = 8;
__device__ __forceinline__ int lds_byte(int r, int c) { const int st = (r >> 4) * 2 + (c >> 5), rr = r & 15, cc = c & 31, ob = rr * 64 + cc * 2; return st * 1024 + (ob ^ (((ob >> 9) & 1) << 5)); }
__device__ __forceinline__ void stage_rc(int b, int& R, int& C) { const int st = b / 1024, sb = b % 1024, swz = sb ^ (((sb >> 9) & 1) << 5); R = (st >> 1) * 16 + swz / 64; C = (st & 1) * 32 + (swz % 64) / 2; }
__device__ __forceinline__ int perm32(int rho) { const int n = rho >> 4, i = rho & 15; return 8 * (i >> 2) + 4 * n + (i & 3); }

struct Unit { int pm, pn, e, aux, rot; const char* Ab; const char* Bb; };

__device__ __forceinline__ bool static_order(int i, int G, int c, int nM, int nN, int& pm, int& pn) {
    const int nwg = nM * nN; const int Lx = i * G + c; if (Lx >= nwg) return false;
    int wgid = Lx; { const int q = nwg / NXCD, r = nwg % NXCD, xcd = wgid % NXCD, off = wgid / NXCD; wgid = (xcd < r ? xcd * (q + 1) : r * (q + 1) + (xcd - r) * q) + off; }
    const int nig = WGM * nN, gid = wgid / nig, fm = gid * WGM, gsz = (nM - fm) < WGM ? (nM - fm) : WGM;
    pm = fm + ((wgid % nig) % gsz); pn = (wgid % nig) / gsz; return true;
}

template <class Prob, class Epi>
__device__ __forceinline__ void gemm_phase(LAS unsigned char* lds, const int tid, const Prob& P, const Epi& E) {
    const int wid = __builtin_amdgcn_readfirstlane(tid >> 6), lane = tid & 63, wr = wid >> 2, wc = wid & 3, fr = lane & 15, fq = lane >> 4;
    const int nt = Prob::FP8 ? P.K / 128 : P.K / BK;
    int Rl[2], Cl[2]; unsigned offB[2];
#pragma unroll
    for (int i = 0; i < 2; ++i) { int R, C; stage_rc(tid * 16 + i * 8192, R, C); const int Rb = (R & ~31) + perm32(R & 31); Rl[i] = R; Cl[i] = C; offB[i] = (unsigned)Rb * P.ldb + (unsigned)C * 2u; }
    const size_t hB = (size_t)HALF * P.ldb;
    const unsigned ldsw = (unsigned)wid * 1024u;
    const int aoff = lds_byte(wr * 64 + fr, fq * 8), boff = lds_byte(wc * 32 + fr, fq * 8);
#define GM_SA(b, h) (((b) * 2 + (h)) * HTB)
#define GM_SB(b, h) ((4 + (b) * 2 + (h)) * HTB)
#define GM_STAGE(bufoff, gbase, voff, kb) do { _Pragma("unroll") for (int _i = 0; _i < 2; ++_i)   \
        __builtin_amdgcn_global_load_lds((const unsigned*)((const char*)(gbase) + ((voff)[_i] + (unsigned)(kb))), (LAS unsigned*)(lds + (bufoff) + ldsw + _i * 8192), 16, 0, 0); } while (0)
#define GM_LD8(addr) __builtin_shufflevector(*(const LAS v4i*)(addr), *(const LAS v4i*)((addr) + 1024), 0, 1, 2, 3, 4, 5, 6, 7)
#define GM_LDA(dst, b, h) do { _Pragma("unroll") for (int m = 0; m < 4; ++m) dst[m] = GM_LD8(lds + GM_SA(b, h) + aoff + m * 2048); } while (0)
#define GM_LDB(dst, b, h) do { _Pragma("unroll") for (int n = 0; n < 2; ++n) dst[n] = GM_LD8(lds + GM_SB(b, h) + boff + n * 2048); } while (0)
#define GM_LO(x) __builtin_bit_cast(bf16x8, __builtin_shufflevector(x, x, 0, 1, 2, 3))
#define GM_HI(x) __builtin_bit_cast(bf16x8, __builtin_shufflevector(x, x, 4, 5, 6, 7))
#define GM_MMA(ai, bj, At, Bt) do { __builtin_amdgcn_s_setprio(1); _Pragma("unroll") for (int m = 0; m < 4; ++m) _Pragma("unroll") for (int n = 0; n < 2; ++n) { \
        if (Prob::FP8)   \
            acc[ai][bj][m][n] = __builtin_amdgcn_mfma_scale_f32_16x16x128_f8f6f4(Bt[n], At[m], acc[ai][bj][m][n], 0, 0, 0, 0, 0, 0); \
        else { acc[ai][bj][m][n] = __builtin_amdgcn_mfma_f32_16x16x32_bf16(GM_LO(Bt[n]), GM_LO(At[m]), acc[ai][bj][m][n], 0, 0, 0); \
               acc[ai][bj][m][n] = __builtin_amdgcn_mfma_f32_16x16x32_bf16(GM_HI(Bt[n]), GM_HI(At[m]), acc[ai][bj][m][n], 0, 0, 0); } } \
        __builtin_amdgcn_s_setprio(0); } while (0)
#define GM_WAIT_V(n) asm volatile("s_waitcnt vmcnt(" #n ")" ::: "memory")
#define GM_WAIT_L(n) asm volatile("s_waitcnt lgkmcnt(" #n ")" ::: "memory")
#define GM_BAR __builtin_amdgcn_s_barrier()
#define GM_SCHED __builtin_amdgcn_sched_barrier(0)
    Unit cur, nxt; int ui = 0;
    if (!P.next(0, cur)) return;
    unsigned offC[2][2];
    P.a_off(cur, Rl, Cl, offC);
    f32x4 acc[2][2][4][2];
#pragma unroll
    for (int a = 0; a < 2; ++a)
#pragma unroll
        for (int b = 0; b < 2; ++b)
#pragma unroll
            for (int m = 0; m < 4; ++m)
#pragma unroll
                for (int n = 0; n < 2; ++n) acc[a][b][m][n] = (f32x4){0.f, 0.f, 0.f, 0.f};
    v8i At[4], B0[2], B1[2];
    typename Epi::Pre pre;
    const char* cA = cur.Ab; const char* cB = cur.Bb;
    const int ntm = nt - 1;
#define GM_KB(t_, r_) ((((t_) + (r_)) & ntm) << 7)
    { const int p0 = GM_KB(0, cur.rot), p1 = GM_KB(1, cur.rot);
    GM_STAGE(GM_SB(0, 0), cB, offB, p0); GM_STAGE(GM_SB(0, 1), cB + hB, offB, p0); GM_STAGE(GM_SA(0, 0), cA, offC[0], p0); GM_STAGE(GM_SA(0, 1), cA, offC[1], p0);
    if (wr == 1) GM_BAR;
    GM_WAIT_V(2); GM_BAR;
    GM_STAGE(GM_SB(1, 0), cB, offB, p1); GM_STAGE(GM_SA(1, 0), cA, offC[0], p1); GM_STAGE(GM_SB(1, 1), cB + hB, offB, p1); }
    GM_WAIT_V(6); GM_BAR;
    for (;;) {
        const bool has_next = P.next(ui + 1, nxt);
        unsigned offN[2][2] = {{0u, 0u}, {0u, 0u}};
        if (Prob::GATHER) { if (has_next) P.a_raw(nxt, Rl, offN); }
        const char* nA = has_next ? nxt.Ab : cA; const char* nB = has_next ? nxt.Bb : cB; const int rc = cur.rot, rn = has_next ? nxt.rot : rc;
        for (int t = 0; t < nt; t += 2) {
            const bool last = (t == nt - 2);
            if (Epi::HAS_PRE) { if (last) { unsigned l_; asm volatile("v_mbcnt_lo_u32_b32 %0, -1, 0\n\tv_mbcnt_hi_u32_b32 %0, -1, %0" : "=v"(l_)); E.pre_load(pre, cur, wr, wc, (int)(l_ & 15u), (int)(l_ >> 4)); } }
            const char* ab = last ? nA : cA; const char* bb = last ? nB : cB;
            const int k1 = GM_KB(t + 1, rc), k2 = last ? GM_KB(0, rn) : GM_KB(t + 2, rc), k3 = last ? GM_KB(1, rn) : GM_KB(t + 3, rc);
            GM_LDB(B0, 0, 0); GM_LDB(B1, 0, 1); GM_SCHED; GM_LDA(At, 0, 0); GM_STAGE(GM_SA(1, 1), cA, offC[1], k1);
            if (Prob::GATHER) { if (last && has_next) {
#pragma unroll
                for (int h = 0; h < 2; ++h)
#pragma unroll
                    for (int i = 0; i < 2; ++i) offC[h][i] = (offN[h][i] >> 2) * P.lda + (unsigned)Cl[i] * 2u; } }
            GM_WAIT_V(8); GM_WAIT_L(0); GM_BAR; GM_MMA(0, 0, At, B0); GM_MMA(0, 1, At, B1); GM_BAR; GM_SCHED;
            GM_LDA(At, 0, 1); GM_STAGE(GM_SB(0, 0), bb, offB, k2); GM_STAGE(GM_SB(0, 1), bb + hB, offB, k2); GM_STAGE(GM_SA(0, 0), ab, offC[0], k2);
            GM_WAIT_V(8); GM_WAIT_L(0); GM_BAR; GM_MMA(1, 0, At, B0); GM_MMA(1, 1, At, B1); GM_BAR; GM_SCHED;
            GM_LDB(B0, 1, 0); GM_LDB(B1, 1, 1); GM_SCHED; GM_LDA(At, 1, 0); GM_STAGE(GM_SA(0, 1), ab, offC[1], k2);
            GM_WAIT_V(8); GM_WAIT_L(0); GM_BAR; GM_MMA(0, 0, At, B0); GM_MMA(0, 1, At, B1); GM_BAR; GM_SCHED;
            GM_LDA(At, 1, 1); GM_STAGE(GM_SB(1, 0), bb, offB, k3); GM_STAGE(GM_SB(1, 1), bb + hB, offB, k3); GM_STAGE(GM_SA(1, 0), ab, offC[0], k3);
            GM_WAIT_V(8); GM_WAIT_L(0); GM_BAR; GM_MMA(1, 0, At, B0); GM_MMA(1, 1, At, B1); GM_BAR; GM_SCHED;
        }
        if (wr == 0) GM_BAR;
        { unsigned l_; asm volatile("v_mbcnt_lo_u32_b32 %0, -1, 0\n\tv_mbcnt_hi_u32_b32 %0, -1, %0" : "=v"(l_));
          E(acc, cur, wr, wc, (int)(l_ & 15u), (int)(l_ >> 4), pre); }
        if (!has_next) break;
#pragma unroll
        for (int a = 0; a < 2; ++a)
#pragma unroll
            for (int b = 0; b < 2; ++b)
#pragma unroll
                for (int m = 0; m < 4; ++m)
#pragma unroll
                    for (int n = 0; n < 2; ++n) acc[a][b][m][n] = (f32x4){0.f, 0.f, 0.f, 0.f};
        cur = nxt; cA = nA; cB = nB; ++ui;
        if (wr == 1) GM_BAR;
    }
    GM_WAIT_V(0);
    GM_BAR;
#undef GM_SA
#undef GM_KB
#undef GM_SB
#undef GM_STAGE
#undef GM_LDA
#undef GM_LDB
#undef GM_LD8
#undef GM_LO
#undef GM_HI
#undef GM_MMA
#undef GM_WAIT_V
#undef GM_WAIT_L
#undef GM_BAR
#undef GM_SCHED
}

template <bool FP8_> struct DenseProbT {
    static constexpr bool GATHER = false, FP8 = FP8_;
    __device__ __forceinline__ void a_raw(const Unit&, const int (&)[2], unsigned (&)[2][2]) const {}
    const char* A; const char* B; unsigned lda, ldb; int K, nM, nN, G, c;
    int a_col_per_pn;
    size_t b_per_pn;
    __device__ __forceinline__ bool next(int i, Unit& u) const {
        int pm, pn; if (!static_order(i, G, c, nM, nN, pm, pn)) return false;
        u.pm = pm; u.pn = pn; u.e = 0; u.aux = 0; u.rot = K_ROT ? pm + 2 * pn : 0; u.Ab = A + (size_t)pm * BM * lda + (size_t)pn * a_col_per_pn; u.Bb = B + (size_t)pn * b_per_pn; return true;
    }
    __device__ __forceinline__ void a_off(const Unit&, const int (&Rl)[2], const int (&Cl)[2], unsigned (&off)[2][2]) const {
#pragma unroll
        for (int h = 0; h < 2; ++h)
#pragma unroll
            for (int i = 0; i < 2; ++i) off[h][i] = (unsigned)(h * HALF + Rl[i]) * lda + (unsigned)Cl[i] * 2u;
    }
};
using DenseProb = DenseProbT<false>;
struct OneProb {
    static constexpr bool GATHER = false, FP8 = false;
    __device__ __forceinline__ void a_raw(const Unit&, const int (&)[2], unsigned (&)[2][2]) const {}
    const char* A; const char* B; unsigned lda, ldb; int K, pm, pn; size_t b_per_pn;
    __device__ __forceinline__ bool next(int i, Unit& u) const { if (i != 0) return false; u.pm = pm; u.pn = pn; u.e = 0; u.aux = 0; u.rot = 0; u.Ab = A + (size_t)pm * BM * lda; u.Bb = B + (size_t)pn * b_per_pn; return true; }
    __device__ __forceinline__ void a_off(const Unit&, const int (&Rl)[2], const int (&Cl)[2], unsigned (&off)[2][2]) const {
#pragma unroll
        for (int h = 0; h < 2; ++h)
#pragma unroll
            for (int i = 0; i < 2; ++i) off[h][i] = (unsigned)(h * HALF + Rl[i]) * lda + (unsigned)Cl[i] * 2u;
    }
};
struct MoeTab { LAS int* tstart; LAS int* cnt; LAS unsigned char* tile_e; int T; };
template <bool GATHER_> struct MoeProb {
    static constexpr bool GATHER = GATHER_, gather = GATHER_, FP8 = true;
    const char* A; const char* B; unsigned lda, ldb; int K, nN, G, c; MoeTab tb; const int* list; size_t b_per_e, b_per_pn;
#if PROBE_HOT == 2
    bool same = false;
#endif
    __device__ __forceinline__ bool next(int i, Unit& u) const {
        int pm, pn; if (!static_order(i, G, c, tb.T, nN, pm, pn)) return false;
        const int e = __builtin_amdgcn_readfirstlane((int)tb.tile_e[pm]);
        u.pm = pm; u.pn = pn; u.e = e; u.rot = K_ROT ? pm + 2 * pn : 0; u.aux = (pm - __builtin_amdgcn_readfirstlane(tb.tstart[e])) * BM;
        u.Ab = gather ? A : A + (size_t)pm * BM * lda; u.Bb = B + (size_t)e * b_per_e + (size_t)pn * b_per_pn;
#if PROBE_HOT == 2
        if (same) { u.Ab = A; u.Bb = B; }
#endif
        return true;
    }
    __device__ __forceinline__ void a_raw(const Unit& u, const int (&Rl)[2], unsigned (&raw)[2][2]) const {
        const int n = __builtin_amdgcn_readfirstlane(tb.cnt[u.e]);
#pragma unroll
        for (int h = 0; h < 2; ++h)
#pragma unroll
            for (int i = 0; i < 2; ++i) { const int p = u.aux + h * HALF + Rl[i]; raw[h][i] = (p < n) ? (unsigned)list[u.e * LIST_CAP + p] : 0u; }
    }
    __device__ __forceinline__ void a_off(const Unit& u, const int (&Rl)[2], const int (&Cl)[2], unsigned (&off)[2][2]) const {
        if (gather) {
            const int n = __builtin_amdgcn_readfirstlane(tb.cnt[u.e]);
#pragma unroll
            for (int h = 0; h < 2; ++h)
#pragma unroll
                for (int i = 0; i < 2; ++i) { const int p = u.aux + h * HALF + Rl[i]; int tok = 0; if (p < n) tok = list[u.e * LIST_CAP + p] >> 2; off[h][i] = (unsigned)tok * lda + (unsigned)Cl[i] * 2u; }
        } else {
#pragma unroll
            for (int h = 0; h < 2; ++h)
#pragma unroll
                for (int i = 0; i < 2; ++i) off[h][i] = (unsigned)(h * HALF + Rl[i]) * lda + (unsigned)Cl[i] * 2u;
        }
    }
};

struct EpiBf16 {
    struct Pre {}; static constexpr bool HAS_PRE = false; __device__ __forceinline__ void pre_load(Pre&, const Unit&, int, int, int, int) const {}
    bf16_t* O; int ldc; const float* bias; const float* cscale; int split_cols; size_t split_stride; float scale0; int col_per_pn; float mul;
    __device__ __forceinline__ void operator()(const f32x4 (&acc)[2][2][4][2], const Unit& u, int wr, int wc, int fr, int fq, const Pre&) const {
        const int row0 = u.pm * BM + wr * 64 + fr; int colt = u.pn * col_per_pn; bf16_t* base = O;
        float sc = mul; if (split_cols) { const int t = colt / split_cols; base += (size_t)t * split_stride; colt -= t * split_cols; if (t == 0) sc = scale0 * mul; }
        const int col0 = colt + wc * 32 + 8 * fq, bcol0 = u.pn * col_per_pn + wc * 32 + 8 * fq;
        f32x4 bv[2][2], sv[2][2];
#pragma unroll
        for (int bj = 0; bj < 2; ++bj)
#pragma unroll
            for (int n = 0; n < 2; ++n) { bv[bj][n] = bias ? *(const f32x4*)(bias + bcol0 + bj * HALF + 4 * n) : (f32x4){0.f, 0.f, 0.f, 0.f};
                                          sv[bj][n] = cscale ? *(const f32x4*)(cscale + bcol0 + bj * HALF + 4 * n) : (f32x4){1.f, 1.f, 1.f, 1.f}; }
#pragma unroll
        for (int ai = 0; ai < 2; ++ai)
#pragma unroll
            for (int m = 0; m < 4; ++m) { bf16_t* rowp = base + (size_t)(row0 + ai * HALF + m * 16) * ldc + col0;
#pragma unroll
                for (int bj = 0; bj < 2; ++bj) { f32x4 v0 = (acc[ai][bj][m][0] + bv[bj][0]) * sv[bj][0] * sc, v1 = (acc[ai][bj][m][1] + bv[bj][1]) * sv[bj][1] * sc;
                    u32x4 w; w.x = cvt_pk_bf16(v0[0], v0[1]); w.y = cvt_pk_bf16(v0[2], v0[3]); w.z = cvt_pk_bf16(v1[0], v1[1]); w.w = cvt_pk_bf16(v1[2], v1[3]);
                    st16(rowp + bj * HALF, w); } }
    }
};
struct EpiSwiglu {
    struct Pre { f32x4 bgl[2], bln[2]; }; static constexpr bool HAS_PRE = true;
    unsigned char* act; const float* bup;
#if PROBE_NOEPI
    bool skip = false;
#endif
    __device__ __forceinline__ void pre_load(Pre& p, const Unit& u, int, int wc, int, int fq) const {
        const float* bg = bup + (size_t)u.e * 2048 + u.pn * HALF + wc * 32 + 8 * fq;
#pragma unroll
        for (int n = 0; n < 2; ++n) { p.bgl[n] = *(const f32x4*)(bg + 4 * n); p.bln[n] = *(const f32x4*)(bg + 1024 + 4 * n); }
    }
    __device__ __forceinline__ void operator()(const f32x4 (&acc)[2][2][4][2], const Unit& u, int wr, int wc, int fr, int fq, const Pre& pr) const {
#if PROBE_NOEPI == 1
        if (skip) return;
#endif
        const int row0 = u.pm * BM + wr * 64 + fr, col0 = u.pn * HALF + wc * 32 + 8 * fq;
        const f32x4 (&bgl)[2] = pr.bgl; const f32x4 (&bln)[2] = pr.bln;
#pragma unroll
        for (int ai = 0; ai < 2; ++ai)
#pragma unroll
            for (int m = 0; m < 4; ++m) {
                float o[8];
#pragma unroll
                for (int n = 0; n < 2; ++n)
#pragma unroll
                    for (int jp = 0; jp < 2; ++jp) {
                        const f32x2 a0 = {acc[ai][0][m][n][2 * jp], acc[ai][0][m][n][2 * jp + 1]}, a1 = {acc[ai][1][m][n][2 * jp], acc[ai][1][m][n][2 * jp + 1]};
                        const f32x2 bg2 = {bgl[n][2 * jp], bgl[n][2 * jp + 1]}, bl2 = {bln[n][2 * jp], bln[n][2 * jp + 1]};
                        f32x2 g = a0 * 0.015625f + bg2, l = a1 * 0.015625f + bl2;
                        g.x = fminf(g.x, 7.0f); g.y = fminf(g.y, 7.0f); l.x = __builtin_amdgcn_fmed3f(l.x, -7.0f, 7.0f); l.y = __builtin_amdgcn_fmed3f(l.y, -7.0f, 7.0f);
                        const f32x2 t = g * (-1.702f * LOG2E);
                        f32x2 e; e.x = __builtin_amdgcn_exp2f(t.x); e.y = __builtin_amdgcn_exp2f(t.y);
                        const f32x2 d = e + 1.0f;
                        f32x2 r; r.x = __builtin_amdgcn_rcpf(d.x); r.y = __builtin_amdgcn_rcpf(d.y);
                        const f32x2 gr = g * r, oo = gr * l + gr;
                        o[n * 4 + 2 * jp] = oo.x; o[n * 4 + 2 * jp + 1] = oo.y;
                    }
                u32x2 w; w.x = cvt_pk4_fp8(o[0], o[1], o[2], o[3]); w.y = cvt_pk4_fp8(o[4], o[5], o[6], o[7]);
#if PROBE_NOEPI == 3
                if (skip) asm volatile("" :: "v"(w.x), "v"(w.y)); else
#endif
                st8(act + (size_t)(row0 + ai * HALF + m * 16) * D + col0, w);
            }
    }
};
struct EpiDown {
    struct Pre {}; static constexpr bool HAS_PRE = true;
    unsigned char* Y; const float* bdn; const float* gate; const int* list; MoeTab tb; LAS unsigned char* lds;
#if PROBE_NOEPI
    bool skip = false;
#endif
    __device__ __forceinline__ void pre_load(Pre&, const Unit& u, int wr, int wc, int fr, int fq) const {
        const int w = wr * 4 + wc, lane = fq * 16 + fr;
        const unsigned* src = (w < 4 ? (const unsigned*)list : (const unsigned*)gate) + (u.e * LIST_CAP + u.aux + (w & 3) * 64 + lane);
        __builtin_amdgcn_global_load_lds(src, (LAS unsigned*)(lds + M_PRE + w * 256), 4, 0, 0);
        if (w < 4) __builtin_amdgcn_global_load_lds((const unsigned*)(bdn + (size_t)u.e * D + u.pn * BM + w * 64 + lane), (LAS unsigned*)(lds + M_PRE + 2048 + w * 256), 4, 0, 0);
    }
    __device__ __forceinline__ void operator()(const f32x4 (&acc)[2][2][4][2], const Unit& u, int wr, int wc, int fr, int fq, const Pre&) const {
#if PROBE_NOEPI == 1
        if (skip) return;
#endif
        const int n = __builtin_amdgcn_readfirstlane(tb.cnt[u.e]);
        const int col0 = u.pn * BM + wc * 32 + 8 * fq;
        const LAS int* ps = (const LAS int*)(lds + M_PRE); const LAS float* pg = (const LAS float*)(lds + M_PRE + 1024); const LAS float* pb = (const LAS float*)(lds + M_PRE + 2048) + wc * 32 + 8 * fq;
        f32x4 bv[2][2];
#pragma unroll
        for (int bj = 0; bj < 2; ++bj)
#pragma unroll
            for (int nn = 0; nn < 2; ++nn) bv[bj][nn] = *(const LAS f32x4*)(pb + bj * HALF + 4 * nn);
#if Y_FP8 && EPI_STAGE
        { const int lane = fq * 16 + fr, w = wr * 4 + wc;
        unsigned char* ybase = Y + u.pn * BM + (lane & 15) * 16;
#pragma unroll
        for (int p = 0; p < 4; ++p) {
            const int ai = p >> 1, mh = p & 1;
            LAS unsigned char* stg = lds + ((p & 1) ? STG1 : STG0);
#pragma unroll
            for (int mm = 0; mm < 2; ++mm) { const int m = 2 * mh + mm, lr = wr * 32 + mm * 16 + fr;
                const float g16 = pg[ai * HALF + wr * 64 + m * 16 + fr] * 4.0f;
#pragma unroll
                for (int bj = 0; bj < 2; ++bj) { const f32x4 v0 = (acc[ai][bj][m][0] * 0.015625f + bv[bj][0]) * g16, v1 = (acc[ai][bj][m][1] * 0.015625f + bv[bj][1]) * g16;
                    u32x2 wv; wv.x = cvt_pk4_fp8(v0[0], v0[1], v0[2], v0[3]); wv.y = cvt_pk4_fp8(v1[0], v1[1], v1[2], v1[3]);
                    const int chunk = bj * 8 + wc * 2 + (fq >> 1);
                    *(LAS u32x2*)(stg + lr * 256 + ((chunk ^ (lr & 15)) << 4) + (fq & 1) * 8) = wv; } }
            LDS_WAIT(); __builtin_amdgcn_s_barrier();
#pragma unroll
            for (int k = 0; k < 2; ++k) { const int lr = k * 32 + w * 4 + (lane >> 4), j = lane & 15;
                const u32x4 v = *(const LAS u32x4*)(stg + lr * 256 + ((j ^ (lr & 15)) << 4));
                const int q = ai * HALF + (lr >> 5) * 64 + (2 * mh + ((lr >> 4) & 1)) * 16 + (lr & 15);
#if Y_SORTED
#if PROBE_NOEPI == 3
                const int sl = (!skip && u.aux + q < n) ? u.pm * BM + q : -1;
                if (skip) asm volatile("" :: "v"(v.x), "v"(v.y), "v"(v.z), "v"(v.w));
#else
                const int sl = (u.aux + q < n) ? u.pm * BM + q : -1;
#endif
#else
                const int sl = (u.aux + q < n) ? ps[q] : -1;
#endif
#if Y_SORTED
                if (sl >= 0) { unsigned char* dst = Y + ((size_t)(u.pm * 4 + u.pn) << 16) + q * 256 + (lane & 15) * 16;
                    if (STAGE_NT) st16nt(dst, v); else st16(dst, v); } }
#else
                if (sl >= 0) { if (STAGE_NT) st16nt(ybase + (size_t)sl * D, v); else st16(ybase + (size_t)sl * D, v); } }
#endif
        } }
#elif Y_FP8
#pragma unroll
        for (int ai = 0; ai < 2; ++ai) {
            float g16[4];
#pragma unroll
            for (int m = 0; m < 4; ++m) g16[m] = pg[ai * HALF + wr * 64 + m * 16 + fr] * 4.0f;
            const int q = ai * HALF + wr * 64 + fq * 16 + fr;
#if PROBE_NOEPI == 2
            const int sl = skip ? u.pm * BM + q : ((u.aux + q < n) ? ps[q] : -1);
#elif PROBE_NOEPI == 3
            const int sl = skip ? -1 : ((u.aux + q < n) ? ps[q] : -1);
#elif PROBE_NOEPI == 4
            const int sl = skip ? 65536 + (blockIdx.x * 8 + (q & 7)) : ((u.aux + q < n) ? ps[q] : -1);
#else
            const int sl = (u.aux + q < n) ? ps[q] : -1;
#endif
            unsigned W[2][4][2];
#pragma unroll
            for (int bj = 0; bj < 2; ++bj)
#pragma unroll
                for (int m = 0; m < 4; ++m) { const f32x4 v0 = (acc[ai][bj][m][0] * 0.015625f + bv[bj][0]) * g16[m], v1 = (acc[ai][bj][m][1] * 0.015625f + bv[bj][1]) * g16[m];
                    W[bj][m][0] = cvt_pk4_fp8(v0[0], v0[1], v0[2], v0[3]); W[bj][m][1] = cvt_pk4_fp8(v1[0], v1[1], v1[2], v1[3]); }
#pragma unroll
            for (int bj = 0; bj < 2; ++bj)
#pragma unroll
                for (int d = 0; d < 2; ++d) {
                    u32x2 r;
                    r = __builtin_amdgcn_permlane32_swap(W[bj][0][d], W[bj][2][d], false, false); W[bj][0][d] = r[0]; W[bj][2][d] = r[1];
                    r = __builtin_amdgcn_permlane32_swap(W[bj][1][d], W[bj][3][d], false, false); W[bj][1][d] = r[0]; W[bj][3][d] = r[1];
                    r = __builtin_amdgcn_permlane16_swap(W[bj][0][d], W[bj][1][d], false, false); W[bj][0][d] = r[0]; W[bj][1][d] = r[1];
                    r = __builtin_amdgcn_permlane16_swap(W[bj][2][d], W[bj][3][d], false, false); W[bj][2][d] = r[0]; W[bj][3][d] = r[1];
                }
#if PROBE_NOEPI == 5
            if (skip) {
                unsigned char* rp = Y + (size_t)(u.pm * 4 + u.pn) * 65536 + (wr * 4 + wc) * 8192 + ai * 4096 + (fq * 16 + fr) * 16;
#pragma unroll
                for (int bj = 0; bj < 2; ++bj) {
#if PROBE_NT5
                    st16nt(rp + bj * 2048, (u32x4){W[bj][0][0], W[bj][0][1], W[bj][1][0], W[bj][1][1]}); st16nt(rp + bj * 2048 + 1024, (u32x4){W[bj][2][0], W[bj][2][1], W[bj][3][0], W[bj][3][1]});
#else
                    st16(rp + bj * 2048, (u32x4){W[bj][0][0], W[bj][0][1], W[bj][1][0], W[bj][1][1]}); st16(rp + bj * 2048 + 1024, (u32x4){W[bj][2][0], W[bj][2][1], W[bj][3][0], W[bj][3][1]});
#endif
                }
            } else
#endif
            if (sl >= 0) {
                unsigned char* rowp = Y + (size_t)sl * D + u.pn * BM + wc * 32;
#pragma unroll
                for (int bj = 0; bj < 2; ++bj) {
                    if (NT_DOWN) { st16nt(rowp + bj * HALF, (u32x4){W[bj][0][0], W[bj][0][1], W[bj][1][0], W[bj][1][1]}); st16nt(rowp + bj * HALF + 16, (u32x4){W[bj][2][0], W[bj][2][1], W[bj][3][0], W[bj][3][1]}); }
                    else { st16(rowp + bj * HALF, (u32x4){W[bj][0][0], W[bj][0][1], W[bj][1][0], W[bj][1][1]}); st16(rowp + bj * HALF + 16, (u32x4){W[bj][2][0], W[bj][2][1], W[bj][3][0], W[bj][3][1]}); } }
            }
            asm volatile("" ::: "memory");
        }
#else
#pragma unroll
        for (int ai = 0; ai < 2; ++ai) {
            int slot[4]; float gt[4];
#pragma unroll
            for (int i = 0; i < 4; ++i) { const int q = ai * HALF + wr * 64 + i * 16 + fr; slot[i] = (u.aux + q < n) ? ps[q] : -1; gt[i] = pg[q]; }
#pragma unroll
            for (int m = 0; m < 4; ++m) {
                const int sl = slot[m];
                if (sl >= 0) {
                    bf16_t* rowp = (bf16_t*)Y + (size_t)sl * D + col0; const float g1 = gt[m];
#pragma unroll
                    for (int bj = 0; bj < 2; ++bj) { const f32x4 v0 = (acc[ai][bj][m][0] * 0.015625f + bv[bj][0]) * g1, v1 = (acc[ai][bj][m][1] * 0.015625f + bv[bj][1]) * g1;
                        u32x4 w; w.x = cvt_pk_bf16(v0[0], v0[1]); w.y = cvt_pk_bf16(v0[2], v0[3]); w.z = cvt_pk_bf16(v1[0], v1[1]); w.w = cvt_pk_bf16(v1[2], v1[3]);
                        st16(rowp + bj * HALF, w); }
                }
            }
            asm volatile("" ::: "memory");
        }
#endif
    }
};
}

struct Args {
    const float* x; const float* c; const float* ctx; const float* c_ctx; const float* ada_w; const float* ada_b; const float* norm_g;
    const float* w_qkv; const float* w_o; const float* rpb; const float* pool_w; const float* pool_b; const float* pool_scale;
    const float* w_router; const float* b_router; const float* w_up; const float* b_up; const float* w_down; const float* b_down;
    float* out; unsigned char* ws; int ph_lo, ph_hi;
};

struct Frame {
    LAS unsigned char* lds; int tid, lane, wave, G, vcu;
};

struct Row { f32x4 v[4]; };
typedef __amdgpu_buffer_rsrc_t rsrc_t;
__device__ __forceinline__ rsrc_t mk_rsrc(const void* p, unsigned bytes) { return __builtin_amdgcn_make_buffer_rsrc((void*)p, (short)0, (int)bytes, 0x00020000); }
__device__ __forceinline__ Row row_load_f32(rsrc_t rs, unsigned soff, int lane) { Row r;
#pragma unroll
    for (int j = 0; j < 4; ++j) r.v[j] = __builtin_bit_cast(f32x4, __builtin_amdgcn_raw_buffer_load_b128(rs, 16 * lane, soff + 1024 * j, 0));
    return r; }
__device__ __forceinline__ void row_load_bf16_raw(rsrc_t rs, unsigned soff, int lane, u32x2 (&w)[4]) {
#pragma unroll
    for (int j = 0; j < 4; ++j) w[j] = __builtin_bit_cast(u32x2, __builtin_amdgcn_raw_buffer_load_b64(rs, 8 * lane, soff + 512 * j, 0)); }
__device__ __forceinline__ Row row_unpack_bf16(const u32x2 (&w)[4]) { Row r;
#pragma unroll
    for (int j = 0; j < 4; ++j) r.v[j] = (f32x4){bf_lo(w[j].x), bf_hi(w[j].x), bf_lo(w[j].y), bf_hi(w[j].y)};
    return r; }
__device__ __forceinline__ Row row_load_bf16(rsrc_t rs, unsigned soff, int lane) { u32x2 w[4]; row_load_bf16_raw(rs, soff, lane, w); return row_unpack_bf16(w); }
__device__ __forceinline__ void row_store_f32(rsrc_t rs, unsigned soff, int lane, const Row& r) {
#pragma unroll
    for (int j = 0; j < 4; ++j) __builtin_amdgcn_raw_buffer_store_b128(__builtin_bit_cast(u32x4, r.v[j]), rs, 16 * lane, soff + 1024 * j, 0); }
__device__ __forceinline__ void row_store_bf16(rsrc_t rs, unsigned soff, int lane, const Row& r) {
#pragma unroll
    for (int j = 0; j < 4; ++j) { u32x2 w; w.x = cvt_pk_bf16(r.v[j][0], r.v[j][1]); w.y = cvt_pk_bf16(r.v[j][2], r.v[j][3]); __builtin_amdgcn_raw_buffer_store_b64(w, rs, 8 * lane, soff + 512 * j, 0); } }
__device__ __forceinline__ void row_store_fp8(rsrc_t rs, unsigned soff, int lane, const Row& r) {
#pragma unroll
    for (int j = 0; j < 4; ++j) __builtin_amdgcn_raw_buffer_store_b32(cvt_pk4_fp8_sat(r.v[j][0], r.v[j][1], r.v[j][2], r.v[j][3]), rs, 4 * lane, soff + 256 * j, 0); }
__device__ __forceinline__ float row_sumsq(const Row& r) { float s = 0.f;
#pragma unroll
    for (int j = 0; j < 4; ++j) s += (r.v[j][0] * r.v[j][0] + r.v[j][1] * r.v[j][1]) + (r.v[j][2] * r.v[j][2] + r.v[j][3] * r.v[j][3]);
    return wave_sum(s); }
__device__ __forceinline__ float rstd_of(float ss) { return 1.0f / sqrtf(ss * (1.0f / D) + RMS_EPS); }

__device__ __forceinline__ float silu_f(float v) { return v / (1.0f + __expf(-v)); }
__device__ __forceinline__ void p0_adaln(const Frame& F, const Args& a) {
    LAS f32x4* red = (LAS f32x4*)F.lds;
    float* mod = (float*)(a.ws + WS_MOD);
    for (int it = blockIdx.x; it < 256; it += F.G) {
        const int layer = it >> 7, cb = it & 127, cl = F.tid & 15, ks = F.tid >> 4;
        f32x4 a0 = {0.f, 0.f, 0.f, 0.f}, a1 = {0.f, 0.f, 0.f, 0.f};
        if (cl < 12) {
            const float* wp = a.ada_w + ((size_t)layer * D + ks * 32) * 6144 + cb * 48 + cl * 4;
#pragma unroll 8
            for (int kk = 0; kk < 32; ++kk) { const f32x4 w = *(const f32x4*)(wp + (size_t)kk * 6144); const float s0 = silu_f(a.c[ks * 32 + kk]), s1 = silu_f(a.c_ctx[ks * 32 + kk]); a0 += w * s0; a1 += w * s1; }
        }
        red[ks * 16 + cl] = a0; red[512 + ks * 16 + cl] = a1;
        __syncthreads();
        if (F.tid < 32) { const int which = F.tid >> 4, c4 = F.tid & 15;
            if (c4 < 12) { f32x4 s = {0.f, 0.f, 0.f, 0.f};
                for (int k2 = 0; k2 < 32; ++k2) s += red[which * 512 + k2 * 16 + c4];
                const int col = cb * 48 + c4 * 4; s += *(const f32x4*)(a.ada_b + layer * 6144 + col);
                if (which == 0) *(f32x4*)(mod + (layer == 0 ? 0 : 2) * 6144 + col) = s;
                else if (layer == 0) *(f32x4*)(mod + 6144 + col) = s; } }
        __syncthreads();
    }
}
struct TItem { const float* src; bf16_t* dst; int N, ldwt; };
__device__ __forceinline__ void titem_load(const TItem& t, f32x4 (&v)[16], int lane) {
    const float* src = t.src + (size_t)(lane >> 4) * t.N + 4 * (lane & 15);
#pragma unroll
    for (int i = 0; i < 16; ++i) v[i] = __builtin_nontemporal_load((const f32x4*)(src + (size_t)(4 * i) * t.N));
}
__device__ __forceinline__ void titem_finish(const TItem& t, const f32x4 (&v)[16], LAS float* scr, int lane) {
    const int lk = lane >> 4, n4 = lane & 15;
#pragma unroll
    for (int i = 0; i < 16; ++i) { const int k = 4 * i + lk; *(LAS f32x4*)(scr + k * 64 + ((4 * n4) ^ (4 * (k >> 3)))) = v[i]; }
    LDS_WAIT(); asm volatile("" ::: "memory");
    const int c = lane & 7;
#pragma unroll
    for (int j = 0; j < 8; ++j) { const int n = (lane >> 3) + 8 * j; const LAS float* sp = scr + (8 * c) * 64 + (n ^ (4 * c));
        u32x4 o; o.x = cvt_pk_bf16(sp[0 * 64], sp[1 * 64]); o.y = cvt_pk_bf16(sp[2 * 64], sp[3 * 64]); o.z = cvt_pk_bf16(sp[4 * 64], sp[5 * 64]); o.w = cvt_pk_bf16(sp[6 * 64], sp[7 * 64]);
        *(u32x4*)(t.dst + (size_t)n * t.ldwt + 8 * c) = o; }
    LDS_WAIT(); asm volatile("" ::: "memory");
}
struct TItem8 { const float* src; unsigned char* dst; int N, ldwt; };
__device__ __forceinline__ void titem8_load(const TItem8& t, f32x4 (&v)[16], int lane) {
    const float* src = t.src + (size_t)(lane >> 4) * t.N + 4 * (lane & 15);
#pragma unroll
    for (int i = 0; i < 16; ++i) v[i] = __builtin_nontemporal_load((const f32x4*)(src + (size_t)(4 * i) * t.N));
}
__device__ __forceinline__ void titem8_finish(const TItem8& t, const f32x4 (&v)[16], LAS float* scr, int lane) {
    const int lk = lane >> 4, n4 = lane & 15;
#pragma unroll
    for (int i = 0; i < 16; ++i) { const int k = 4 * i + lk; *(LAS f32x4*)(scr + k * 64 + ((4 * n4) ^ (8 * (k >> 4)))) = v[i] * 64.0f; }
    LDS_WAIT(); asm volatile("" ::: "memory");
    const int c = lane & 3;
#pragma unroll
    for (int j = 0; j < 4; ++j) { const int n = (lane >> 2) + 16 * j; const LAS float* sp = scr + (16 * c) * 64 + (n ^ (8 * c));
        u32x4 o; o.x = cvt_pk4_fp8(sp[0 * 64], sp[1 * 64], sp[2 * 64], sp[3 * 64]); o.y = cvt_pk4_fp8(sp[4 * 64], sp[5 * 64], sp[6 * 64], sp[7 * 64]);
        o.z = cvt_pk4_fp8(sp[8 * 64], sp[9 * 64], sp[10 * 64], sp[11 * 64]); o.w = cvt_pk4_fp8(sp[12 * 64], sp[13 * 64], sp[14 * 64], sp[15 * 64]);
        *(u32x4*)(t.dst + (size_t)n * t.ldwt + 16 * c) = o; }
    LDS_WAIT(); asm volatile("" ::: "memory");
}
__device__ __forceinline__ void transpose_item(const float* W, int N, bf16_t* WT, int ldwt, int k0, int n0, int drow0, LAS float* scr, int lane) {
    const TItem t{W + (size_t)k0 * N + n0, WT + (size_t)drow0 * ldwt + k0, N, ldwt};
    f32x4 v[16]; titem_load(t, v, lane); titem_finish(t, v, scr, lane);
}
__device__ __forceinline__ void p0_router_weights(const Frame& F, const Args& a) {
    bf16_t* wrt = (bf16_t*)(a.ws + WS_WRT);
    for (int i = blockIdx.x * NT + F.tid; i < 2 * NE * D; i += F.G * NT) { const int l = i / (NE * D), r = i % (NE * D), e = r / D, k = r % D;
        const float w = a.w_router[((size_t)l * D + k) * NE + e]; const unsigned hb = cvt_pk_bf16(w, 0.f) & 0xffffu; const float lo = w - __uint_as_float(hb << 16);
        wrt[((size_t)(l * 2 + 0) * NE + e) * D + k] = (bf16_t)hb; wrt[((size_t)(l * 2 + 1) * NE + e) * D + k] = (bf16_t)(cvt_pk_bf16(lo, 0.f) & 0xffffu); }
}
__device__ __forceinline__ void p0_convert_small(const Frame& F, const Args& a) {
    LAS float* scr = (LAS float*)(F.lds + F.wave * 16384);
    const int gw = F.vcu * NWAVES + F.wave, NGW = F.G * NWAVES;
    constexpr int I_QKV = 16 * 48, I_O = 16 * 16, I_POOL = 4 * 4 * 4, NITEMS = I_QKV + I_O + I_POOL;
    bf16_t* wqkv = (bf16_t*)(a.ws + WS_WQKV); bf16_t* wo = (bf16_t*)(a.ws + WS_WO); bf16_t* wpool = (bf16_t*)(a.ws + WS_WPOOL);
    for (int it = gw; it < NITEMS; it += NGW) {
        int r = it;
#if QKV_FP8
        if (r < I_QKV) { const int kb = r / 48, nb = r % 48; const TItem8 t{a.w_qkv + (size_t)(kb * 64) * 3072 + nb * 64, (unsigned char*)wqkv + (size_t)(nb * 64) * 1024 + kb * 64, 3072, 1024};
            f32x4 v[16]; titem8_load(t, v, F.lane); titem8_finish(t, v, scr, F.lane); continue; } r -= I_QKV;
#else
        if (r < I_QKV) { const int kb = r / 48, nb = r % 48; transpose_item(a.w_qkv, 3072, wqkv, 1024, kb * 64, nb * 64, nb * 64, scr, F.lane); continue; } r -= I_QKV;
#endif
        if (r < I_O) { const int kb = r / 16, nb = r % 16; transpose_item(a.w_o, 1024, wo, 1024, kb * 64, nb * 64, nb * 64, scr, F.lane); continue; } r -= I_O;
        { const int g = r / 16, q = r % 16, kb = q / 4, nb = q % 4; transpose_item(a.pool_w + (size_t)g * 65536, 256, wpool + (size_t)g * 65536, 256, kb * 64, nb * 64, nb * 64, scr, F.lane); }
    }
}
constexpr int CV_UP1 = 16 * 32, CV_UP = 32 * CV_UP1, CV_DN1 = 16 * 16, CV_DN = 32 * CV_DN1, CV_ITEMS = CV_UP + CV_DN, CV_CHUNK = 8, CV_NCHUNK = CV_ITEMS / CV_CHUNK;
__device__ __forceinline__ TItem8 cv_item(const Args& a, int layer, int r) {
    unsigned char* wup = a.ws + WS_WUP + (size_t)layer * 32 * 2048 * 1024; unsigned char* wdn = a.ws + WS_WDN + (size_t)layer * 32 * 1024 * 1024;
    const float* sup = a.w_up + (size_t)layer * 32 * 1024 * 2048; const float* sdn = a.w_down + (size_t)layer * 32 * 1024 * 1024;
    if (r < CV_UP) { const int mat = r / CV_UP1, q = r % CV_UP1, kb = q / 32, nb = q % 32, n0 = nb * 64;
        const int drow = (n0 < 1024) ? ((n0 >> 7) * 256 + (n0 & 127)) : (((n0 - 1024) >> 7) * 256 + 128 + ((n0 - 1024) & 127));
        return TItem8{sup + (size_t)mat * 1024 * 2048 + (size_t)(kb * 64) * 2048 + n0, wup + (size_t)mat * 2048 * 1024 + (size_t)drow * 1024 + kb * 64, 2048, 1024}; }
    r -= CV_UP; const int mat = r / CV_DN1, q = r % CV_DN1, kb = q / 16, nb = q % 16;
    return TItem8{sdn + (size_t)mat * 1024 * 1024 + (size_t)(kb * 64) * 1024 + nb * 64, wdn + (size_t)mat * 1024 * 1024 + (size_t)(nb * 64) * 1024 + kb * 64, 1024, 1024};
}
__device__ __forceinline__ void bg_convert(const Frame& F, const Args& a, int layer, int phase, unsigned Gf, bool fg) {
    unsigned* ctl = (unsigned*)(a.ws + WS_CTL); unsigned* q = ctl + CW_Q + 64 * layer; unsigned* done = ctl + CW_DONE + 64 * phase;
    volatile LAS unsigned* sh = (volatile LAS unsigned*)(F.lds + MISC_OFF + 64);
    LAS float* scr = (LAS float*)(F.lds + F.wave * 16384);
    const unsigned NC = (unsigned)CV_NCHUNK;
    __syncthreads();
    if (fg && F.tid == 0) __hip_atomic_fetch_add(done, 1u, __ATOMIC_RELAXED, __HIP_MEMORY_SCOPE_AGENT);
    unsigned ia = NC, ib = NC, dn = 0u;
    if (F.tid == 0) { if (Gf != 0u) dn = __hip_atomic_load(done, __ATOMIC_RELAXED, __HIP_MEMORY_SCOPE_AGENT);
        if (Gf == 0u || dn < Gf) { ia = __hip_atomic_fetch_add(q, 1u, __ATOMIC_RELAXED, __HIP_MEMORY_SCOPE_AGENT); ib = __hip_atomic_fetch_add(q, 1u, __ATOMIC_RELAXED, __HIP_MEMORY_SCOPE_AGENT); }
        sh[0] = ia; sh[1] = ib; }
    __syncthreads();
    unsigned c0 = sh[0], c1 = sh[1];
    __syncthreads();
    if (c0 >= NC) return;
    f32x4 va[16], vb[16];
    TItem8 ta = cv_item(a, layer, (int)c0 * CV_CHUNK + F.wave), tb = ta;
    titem8_load(ta, va, F.lane);
    for (;;) {
        if (c1 < NC) { tb = cv_item(a, layer, (int)c1 * CV_CHUNK + F.wave); titem8_load(tb, vb, F.lane); }
        unsigned nx = NC;
        if (F.tid == 0) { const bool stop = (Gf != 0u) && (dn >= Gf); if (!stop) nx = __hip_atomic_fetch_add(q, 1u, __ATOMIC_RELAXED, __HIP_MEMORY_SCOPE_AGENT);
            if (Gf != 0u) dn = __hip_atomic_load(done, __ATOMIC_RELAXED, __HIP_MEMORY_SCOPE_AGENT); }
        titem8_finish(ta, va, scr, F.lane);
        if (c1 >= NC) break;
        if (F.tid == 0) sh[0] = nx;
        __syncthreads();
        c0 = sh[0];
        __syncthreads();
        if (c0 < NC) { ta = cv_item(a, layer, (int)c0 * CV_CHUNK + F.wave); titem8_load(ta, va, F.lane); }
        nx = NC;
        if (F.tid == 0) { const bool stop = (Gf != 0u) && (dn >= Gf); if (!stop) nx = __hip_atomic_fetch_add(q, 1u, __ATOMIC_RELAXED, __HIP_MEMORY_SCOPE_AGENT);
            if (Gf != 0u) dn = __hip_atomic_load(done, __ATOMIC_RELAXED, __HIP_MEMORY_SCOPE_AGENT); }
        titem8_finish(tb, vb, scr, F.lane);
        if (c0 >= NC) break;
        if (F.tid == 0) sh[0] = nx;
        __syncthreads();
        c1 = sh[0];
        __syncthreads();
    }
    __syncthreads();
}

template <bool OUT8 = false>
__device__ __forceinline__ void modulate_rows(const Frame& F, const float* x, int nrows, const float* g, const float* shift, const float* scale, void* out, int gw, int NGW) {
    const int lane = F.lane;
    const rsrc_t rx = mk_rsrc(x, (unsigned)nrows * D * 4), ro = mk_rsrc(out, (unsigned)nrows * D * (OUT8 ? 1 : 2));
    Row gs = row_load_f32(mk_rsrc(g, D * 4), 0, lane), sh = row_load_f32(mk_rsrc(shift, D * 4), 0, lane); { const Row sc = row_load_f32(mk_rsrc(scale, D * 4), 0, lane);
#pragma unroll
        for (int j = 0; j < 4; ++j) gs.v[j] = gs.v[j] * (sc.v[j] + 1.0f); }
    for (int m = gw; m < nrows; m += NGW) {
        Row r = row_load_f32(rx, (unsigned)m * D * 4, lane);
        const float rs = rstd_of(row_sumsq(r));
#pragma unroll
        for (int j = 0; j < 4; ++j) r.v[j] = r.v[j] * rs * gs.v[j] + sh.v[j];
        if (OUT8) row_store_fp8(ro, (unsigned)m * D, lane, r); else row_store_bf16(ro, (unsigned)m * D * 2, lane, r);
    }
}

namespace na {
constexpr int LDS_CK = 0, LDS_CV = 32768, LDS_RING = 65536, SLOT = 16384, LDS_BIAS = LDS_RING + 3 * SLOT;
__device__ __forceinline__ unsigned kaddr(int key, int c) { return (unsigned)(key * 128 + ((c ^ ((key >> 1) & 7)) << 4)); }
__device__ __forceinline__ s16x4 vtr(const LAS unsigned char* p) { typedef short v4i16_t __attribute__((ext_vector_type(4)));
    return __builtin_bit_cast(s16x4, __builtin_amdgcn_ds_read_tr16_b64_v4i16((LAS v4i16_t*)p)); }

template <bool LOCAL>
__device__ __forceinline__ void tile(const LAS unsigned char* kimg, int key0, const LAS unsigned char* vimg, int vstride, const bf16x8 (&qf)[2], float& m, float& l, f32x4 (&o)[4],
                                     const LAS float* brow, unsigned valid, int lane) {
    const int fr = lane & 15, fq = lane >> 4;
    f32x4 s[2];
#pragma unroll
    for (int kb = 0; kb < 2; ++kb) {
        const int key = key0 + kb * 16 + fr;
        const bf16x8 k0 = *(const LAS bf16x8*)(kimg + kaddr(key, fq)), k1 = *(const LAS bf16x8*)(kimg + kaddr(key, 4 + fq));
        s[kb] = __builtin_amdgcn_mfma_f32_16x16x32_bf16(k0, qf[0], (f32x4){0.f, 0.f, 0.f, 0.f}, 0, 0, 0);
        s[kb] = __builtin_amdgcn_mfma_f32_16x16x32_bf16(k1, qf[1], s[kb], 0, 0, 0);
    }
    if (LOCAL) {
#pragma unroll
        for (int kb = 0; kb < 2; ++kb)
#pragma unroll
            for (int r = 0; r < 4; ++r) { const float b = brow[kb * 16 + r]; s[kb][r] = ((valid >> (kb * 4 + r)) & 1u) ? s[kb][r] + b : -1e30f; }
    }
    float mt = fmaxf(fmaxf(fmaxf(s[0][0], s[0][1]), fmaxf(s[0][2], s[0][3])), fmaxf(fmaxf(s[1][0], s[1][1]), fmaxf(s[1][2], s[1][3])));
    mt = fmaxf(mt, __shfl_xor(mt, 16)); mt = fmaxf(mt, __shfl_xor(mt, 32));
    const float mn = fmaxf(m, mt), alpha = __builtin_amdgcn_exp2f(m - mn);
    m = mn;
    float p[8]; float ps = 0.f;
#pragma unroll
    for (int kb = 0; kb < 2; ++kb)
#pragma unroll
        for (int r = 0; r < 4; ++r) { p[kb * 4 + r] = __builtin_amdgcn_exp2f(s[kb][r] - mn); ps += p[kb * 4 + r]; }
    l = l * alpha + ps;
    u32x4 pw; pw.x = cvt_pk_bf16(p[0], p[1]); pw.y = cvt_pk_bf16(p[2], p[3]); pw.z = cvt_pk_bf16(p[4], p[5]); pw.w = cvt_pk_bf16(p[6], p[7]);
    const bf16x8 pb = __builtin_bit_cast(bf16x8, pw);
    const int q = fr >> 2, pp = fr & 3;
#pragma unroll
    for (int db = 0; db < 4; ++db) {
        const LAS unsigned char* vb = vimg + db * vstride + (key0 + 4 * fq + q) * 32 + pp * 8;
        const s16x4 lo = vtr(vb), hi = vtr(vb + 16 * 32);
        const bf16x8 vf = (bf16x8){lo[0], lo[1], lo[2], lo[3], hi[0], hi[1], hi[2], hi[3]};
        o[db] = o[db] * alpha;
        o[db] = __builtin_amdgcn_mfma_f32_16x16x32_bf16(vf, pb, o[db], 0, 0, 0);
    }
}

__device__ __forceinline__ void tile2(const LAS unsigned char* kloc, int key0, const LAS unsigned char* vloc, const LAS unsigned char* kctx, int ckey0, const LAS unsigned char* vctx,
                                      const bf16x8 (&qf)[2], float& m, f32x4& l, f32x4 (&o)[4], const LAS float* brow, unsigned valid, int lane) {
    const int fr = lane & 15, fq = lane >> 4;
    f32x4 s[4];
#pragma unroll
    for (int kb = 0; kb < 2; ++kb) {
        const int key = key0 + kb * 16 + fr, ck = ckey0 + kb * 16 + fr;
        const bf16x8 k0 = *(const LAS bf16x8*)(kloc + kaddr(key, fq)), k1 = *(const LAS bf16x8*)(kloc + kaddr(key, 4 + fq));
        const bf16x8 c0 = *(const LAS bf16x8*)(kctx + kaddr(ck, fq)), c1 = *(const LAS bf16x8*)(kctx + kaddr(ck, 4 + fq));
        s[kb] = __builtin_amdgcn_mfma_f32_16x16x32_bf16(k0, qf[0], (f32x4){0.f, 0.f, 0.f, 0.f}, 0, 0, 0);
        s[kb] = __builtin_amdgcn_mfma_f32_16x16x32_bf16(k1, qf[1], s[kb], 0, 0, 0);
        s[2 + kb] = __builtin_amdgcn_mfma_f32_16x16x32_bf16(c0, qf[0], (f32x4){0.f, 0.f, 0.f, 0.f}, 0, 0, 0);
        s[2 + kb] = __builtin_amdgcn_mfma_f32_16x16x32_bf16(c1, qf[1], s[2 + kb], 0, 0, 0);
    }
#pragma unroll
    for (int kb = 0; kb < 2; ++kb)
#pragma unroll
        for (int r = 0; r < 4; ++r) { const float b = brow[kb * 16 + r]; s[kb][r] = ((valid >> (kb * 4 + r)) & 1u) ? s[kb][r] + b : -1e30f; }
    float mt = fmaxf(fmaxf(fmaxf(s[0][0], s[0][1]), fmaxf(s[0][2], s[0][3])), fmaxf(fmaxf(s[1][0], s[1][1]), fmaxf(s[1][2], s[1][3])));
    mt = fmaxf(mt, fmaxf(fmaxf(fmaxf(s[2][0], s[2][1]), fmaxf(s[2][2], s[2][3])), fmaxf(fmaxf(s[3][0], s[3][1]), fmaxf(s[3][2], s[3][3]))));
    mt = fmaxf(mt, __shfl_xor(mt, 16)); mt = fmaxf(mt, __shfl_xor(mt, 32));
    if (__builtin_amdgcn_ballot_w64(mt > m + 8.0f) != 0ull) {
        const float mn = fmaxf(m, mt), alpha = __builtin_amdgcn_exp2f(m - mn);
        m = mn; l = l * alpha;
#pragma unroll
        for (int db = 0; db < 4; ++db) o[db] = o[db] * alpha;
    }
    float p[16];
#pragma unroll
    for (int t = 0; t < 4; ++t)
#pragma unroll
        for (int r = 0; r < 4; ++r) p[t * 4 + r] = __builtin_amdgcn_exp2f(s[t][r] - m);
    u32x4 pw; pw.x = cvt_pk_bf16(p[0], p[1]); pw.y = cvt_pk_bf16(p[2], p[3]); pw.z = cvt_pk_bf16(p[4], p[5]); pw.w = cvt_pk_bf16(p[6], p[7]);
    u32x4 pc; pc.x = cvt_pk_bf16(p[8], p[9]); pc.y = cvt_pk_bf16(p[10], p[11]); pc.z = cvt_pk_bf16(p[12], p[13]); pc.w = cvt_pk_bf16(p[14], p[15]);
    const bf16x8 pb = __builtin_bit_cast(bf16x8, pw), pcb = __builtin_bit_cast(bf16x8, pc);
    { const bf16x8 ones = (bf16x8){0x3F80, 0x3F80, 0x3F80, 0x3F80, 0x3F80, 0x3F80, 0x3F80, 0x3F80};
      l = __builtin_amdgcn_mfma_f32_16x16x32_bf16(ones, pb, l, 0, 0, 0); l = __builtin_amdgcn_mfma_f32_16x16x32_bf16(ones, pcb, l, 0, 0, 0); }
    const int q = fr >> 2, pp = fr & 3;
#pragma unroll
    for (int db = 0; db < 4; ++db) {
        const LAS unsigned char* vb = vloc + db * (64 * 32) + (key0 + 4 * fq + q) * 32 + pp * 8;
        const LAS unsigned char* vc = vctx + db * (256 * 32) + (ckey0 + 4 * fq + q) * 32 + pp * 8;
        const s16x4 lo = vtr(vb), hi = vtr(vb + 16 * 32), clo = vtr(vc), chi = vtr(vc + 16 * 32);
        const bf16x8 vf = (bf16x8){lo[0], lo[1], lo[2], lo[3], hi[0], hi[1], hi[2], hi[3]}, cf = (bf16x8){clo[0], clo[1], clo[2], clo[3], chi[0], chi[1], chi[2], chi[3]};
        o[db] = __builtin_amdgcn_mfma_f32_16x16x32_bf16(vf, pb, o[db], 0, 0, 0);
        o[db] = __builtin_amdgcn_mfma_f32_16x16x32_bf16(cf, pcb, o[db], 0, 0, 0);
    }
}

struct BandSel { unsigned fm[4]; int boff[4]; unsigned pm01, pm23; };
__device__ __forceinline__ void tile3(const LAS unsigned char* kloc, int key0, const LAS unsigned char* vloc, const LAS unsigned char* kctx, int ckey0, const LAS unsigned char* vctx,
                                      const bf16x8 (&qf)[2], float& m, f32x4& l, f32x4 (&o)[4], const LAS float* brow, const BandSel& bs, int lane, bool first) {
    const int fr = lane & 15, fq = lane >> 4;
    f32x4 s[4];
#pragma unroll
    for (int kb = 0; kb < 2; ++kb) {
        const int key = key0 + kb * 16 + fr, ck = ckey0 + kb * 16 + fr;
        const bf16x8 k0 = *(const LAS bf16x8*)(kloc + kaddr(key, fq)), k1 = *(const LAS bf16x8*)(kloc + kaddr(key, 4 + fq));
        const bf16x8 c0 = *(const LAS bf16x8*)(kctx + kaddr(ck, fq)), c1 = *(const LAS bf16x8*)(kctx + kaddr(ck, 4 + fq));
        s[kb] = __builtin_amdgcn_mfma_f32_16x16x32_bf16(k0, qf[0], (f32x4){0.f, 0.f, 0.f, 0.f}, 0, 0, 0);
        s[kb] = __builtin_amdgcn_mfma_f32_16x16x32_bf16(k1, qf[1], s[kb], 0, 0, 0);
        s[2 + kb] = __builtin_amdgcn_mfma_f32_16x16x32_bf16(c0, qf[0], (f32x4){0.f, 0.f, 0.f, 0.f}, 0, 0, 0);
        s[2 + kb] = __builtin_amdgcn_mfma_f32_16x16x32_bf16(c1, qf[1], s[2 + kb], 0, 0, 0);
    }
    float sl[4];
#pragma unroll
    for (int r = 0; r < 4; ++r) { const unsigned a_ = __float_as_uint(s[0][r]), b_ = __float_as_uint(s[1][r]); sl[r] = __uint_as_float((a_ & bs.fm[r]) | (b_ & ~bs.fm[r])) + brow[bs.boff[r]]; }
    if (first) {
        float mt = fmaxf(fmaxf(sl[0], sl[1]), fmaxf(sl[2], sl[3]));
        mt = fmaxf(mt, fmaxf(fmaxf(fmaxf(s[2][0], s[2][1]), fmaxf(s[2][2], s[2][3])), fmaxf(fmaxf(s[3][0], s[3][1]), fmaxf(s[3][2], s[3][3]))));
        mt = fmaxf(mt, __shfl_xor(mt, 16)); mt = fmaxf(mt, __shfl_xor(mt, 32));
        m = mt;
    }
    float pl[4], pcx[8];
#pragma unroll
    for (int r = 0; r < 4; ++r) pl[r] = __builtin_amdgcn_exp2f(sl[r] - m);
#pragma unroll
    for (int t = 0; t < 2; ++t)
#pragma unroll
        for (int r = 0; r < 4; ++r) pcx[t * 4 + r] = __builtin_amdgcn_exp2f(s[2 + t][r] - m);
    const unsigned pk01 = cvt_pk_bf16(pl[0], pl[1]), pk23 = cvt_pk_bf16(pl[2], pl[3]);
    u32x4 pw; pw.x = pk01 & bs.pm01; pw.y = pk23 & bs.pm23; pw.z = pk01 & ~bs.pm01; pw.w = pk23 & ~bs.pm23;
    u32x4 pc; pc.x = cvt_pk_bf16(pcx[0], pcx[1]); pc.y = cvt_pk_bf16(pcx[2], pcx[3]); pc.z = cvt_pk_bf16(pcx[4], pcx[5]); pc.w = cvt_pk_bf16(pcx[6], pcx[7]);
    const bf16x8 pb = __builtin_bit_cast(bf16x8, pw), pcb = __builtin_bit_cast(bf16x8, pc);
    { const bf16x8 ones = (bf16x8){0x3F80, 0x3F80, 0x3F80, 0x3F80, 0x3F80, 0x3F80, 0x3F80, 0x3F80};
      l = __builtin_amdgcn_mfma_f32_16x16x32_bf16(ones, pb, l, 0, 0, 0); l = __builtin_amdgcn_mfma_f32_16x16x32_bf16(ones, pcb, l, 0, 0, 0); }
    const int q = fr >> 2, pp = fr & 3;
#pragma unroll
    for (int db = 0; db < 4; ++db) {
        const LAS unsigned char* vb = vloc + db * (64 * 32) + (key0 + 4 * fq + q) * 32 + pp * 8;
        const LAS unsigned char* vc = vctx + db * (256 * 32) + (ckey0 + 4 * fq + q) * 32 + pp * 8;
        const s16x4 lo = vtr(vb), hi = vtr(vb + 16 * 32), clo = vtr(vc), chi = vtr(vc + 16 * 32);
        const bf16x8 vf = (bf16x8){lo[0], lo[1], lo[2], lo[3], hi[0], hi[1], hi[2], hi[3]}, cf = (bf16x8){clo[0], clo[1], clo[2], clo[3], chi[0], chi[1], chi[2], chi[3]};
        o[db] = __builtin_amdgcn_mfma_f32_16x16x32_bf16(vf, pb, o[db], 0, 0, 0);
        o[db] = __builtin_amdgcn_mfma_f32_16x16x32_bf16(cf, pcb, o[db], 0, 0, 0);
    }
}

__device__ __forceinline__ void attn_unit(const Frame& F, const Args& a, int h, int rlo, int rhi, bool border) {
    const bf16_t* Q = (const bf16_t*)(a.ws + WS_Q); const bf16_t* Kg = (const bf16_t*)(a.ws + WS_K); const bf16_t* Vg = (const bf16_t*)(a.ws + WS_V); bf16_t* O = (bf16_t*)(a.ws + WS_O);
    const int tid = F.tid, lane = F.lane, wid = F.wave, fr = lane & 15, fq = lane >> 4, g = wid & 3;
    LAS unsigned char* lds = F.lds;
    LAS float* bias = (LAS float*)(lds + LDS_BIAS) + 32;
    const int kb = border ? (rlo < 128 ? 0 : 248) : rlo - 4, ke = border ? kb + 7 : rhi + 3;
    int row0[4], ws0[4], nj[4];
#pragma unroll
    for (int j = 0; j < 4; ++j) { const int s = (wid >> 2) + 2 * j;
        if (border) { row0[j] = rlo + s; ws0[j] = kb; nj[j] = (s < 4) ? 1 : 0; }
        else { const int rA = rlo + ((s - rlo) & 7); row0[j] = rA; ws0[j] = rA - 4; nj[j] = (rA > rhi) ? 0 : ((rhi - rA) >> 3) + 1; } }
    const int sg = (g == 0) ? 0 : (g == 1) ? 8 : (g == 2) ? 24 : 32;
    const int cq = 16 * g + fr, c0 = min(max(cq - 8, 0), 48);
    const int dc0 = sg + 4 * fq - cq + 15;
    BandSel bs;
    { const int lo = c0 - sg; bool v0[4];
#pragma unroll
      for (int r = 0; r < 4; ++r) { v0[r] = (4 * fq + r) >= lo; bs.fm[r] = v0[r] ? 0xFFFFFFFFu : 0u; bs.boff[r] = r + (v0[r] ? 0 : 16); }
      bs.pm01 = (v0[0] ? 0xFFFFu : 0u) | (v0[1] ? 0xFFFF0000u : 0u); bs.pm23 = (v0[2] ? 0xFFFFu : 0u) | (v0[3] ? 0xFFFF0000u : 0u); }
    const unsigned qoff = (unsigned)cq * D + h * HD + 8 * fq, ooff = (unsigned)cq * D + h * HD + 4 * fq;
    float m[4]; f32x4 l[4]; f32x4 o[4][4]; bf16x8 qf[4][2], qn[2];
    __syncthreads();
#pragma unroll
    for (int n = 0; n < 4; ++n) { const int ch = tid + NT * n, key = ch >> 3, c = ch & 7;
        const u32x4 kv = *(const u32x4*)(Kg + (size_t)(L + key) * D + h * HD + c * 8), vv = *(const u32x4*)(Vg + (size_t)(L + key) * D + h * HD + c * 8);
        *(LAS u32x4*)(lds + LDS_CK + kaddr(key, c)) = kv;
        *(LAS u32x4*)(lds + LDS_CV + (c >> 1) * (256 * 32) + key * 32 + (c & 1) * 16) = vv; }
    if (tid < 465) bias[tid] = a.rpb[h * 465 + tid] * LOG2E;
    const int key = tid >> 3, c = tid & 7;
    const unsigned kvoff = (unsigned)key * D + h * HD + c * 8;
    const unsigned ksl = kaddr(key, c), vsl = 8192 + (c >> 1) * (64 * 32) + key * 32 + (c & 1) * 16;
#pragma unroll
    for (int n = 0; n < 2; ++n) { const size_t go = (size_t)(kb + n) * GW * D + kvoff; const u32x4 kv = *(const u32x4*)(Kg + go), vv = *(const u32x4*)(Vg + go);
        *(LAS u32x4*)(lds + LDS_RING + n * SLOT + ksl) = kv; *(LAS u32x4*)(lds + LDS_RING + n * SLOT + vsl) = vv; }
#pragma unroll
    for (int j = 0; j < 4; ++j) if (nj[j] > 0 && ws0[j] == kb) { const bf16_t* qp = Q + (size_t)row0[j] * GW * D + qoff; qf[j][0] = *(const bf16x8*)qp; qf[j][1] = *(const bf16x8*)(qp + 32); }
    __syncthreads();
    int rs = 0;
    for (int kr = kb; kr <= ke; ++kr) {
        u32x4 kreg, vreg; const bool pf = kr + 2 <= ke;
        if (pf) { const size_t go = (size_t)(kr + 2) * GW * D + kvoff; kreg = *(const u32x4*)(Kg + go); vreg = *(const u32x4*)(Vg + go); }
#pragma unroll
        for (int j = 0; j < 4; ++j) { const int d = kr + 1 - ws0[j]; if (d >= 0 && d < 8 * nj[j] && (d & 7) == 0) { const bf16_t* qp = Q + (size_t)(row0[j] + d) * GW * D + qoff; qn[0] = *(const bf16x8*)qp; qn[1] = *(const bf16x8*)(qp + 32); } }
        const LAS unsigned char* slot = lds + LDS_RING + rs * SLOT;
#pragma unroll
        for (int j = 0; j < 4; ++j) { const int d = kr - ws0[j];
            if (d >= 0 && d < 8 * nj[j]) { const int i = d & 7, row = row0[j] + (d & ~7);
                if (i == 0) { m[j] = -1e30f; l[j] = (f32x4){0.f, 0.f, 0.f, 0.f};
#pragma unroll
                    for (int db = 0; db < 4; ++db) o[j][db] = (f32x4){0.f, 0.f, 0.f, 0.f};
                    if (kr != kb) { qf[j][0] = qn[0]; qf[j][1] = qn[1]; } }
                tile3(slot, sg, slot + 8192, lds + LDS_CK, i * 32, lds + LDS_CV, qf[j], m[j], l[j], o[j], bias + (kr - row + 7) * 31 + dc0, bs, lane, i == 0);
                if (i == 7) { const float inv = 1.0f / l[j][0];
                    bf16_t* orow = O + (size_t)row * GW * D;
#pragma unroll
                    for (int db = 0; db < 4; ++db) { u32x2 w; w.x = cvt_pk_bf16(o[j][db][0] * inv, o[j][db][1] * inv); w.y = cvt_pk_bf16(o[j][db][2] * inv, o[j][db][3] * inv); st8(orow + (ooff + db * 16), w); } }
            } }
        if (pf) { const int ws_ = (rs + 2 >= 3) ? rs - 1 : rs + 2; *(LAS u32x4*)(lds + LDS_RING + ws_ * SLOT + ksl) = kreg; *(LAS u32x4*)(lds + LDS_RING + ws_ * SLOT + vsl) = vreg; }
        rs = (rs == 2) ? 0 : rs + 1;
        __syncthreads();
    }
}
#ifndef ATT_STRIPS
#define ATT_STRIPS 14
#endif
__device__ __forceinline__ void attn_phase(const Frame& F, const Args& a) {
    constexpr int NS = ATT_STRIPS, NFG = 16 * NS, BASE = 248 / NS, REM = 248 % NS;
    const int u = blockIdx.x;
    if (F.G == 256 && u >= NFG) {
        const int b = u - NFG;
        if (b < 32) attn_unit(F, a, b & 15, b < 16 ? 0 : 252, b < 16 ? 3 : 255, true);
        return;
    }
    for (int unit = u; unit < NFG; unit += (F.G == 256 ? 256 : F.G)) {
        const int h = unit & 15, strip = unit >> 4;
        const int rlo = 4 + strip * BASE + (strip < REM ? strip : REM), rhi = rlo + BASE + (strip < REM ? 1 : 0) - 1;
        attn_unit(F, a, h, rlo, rhi, false);
    }
    if (F.G != 256) for (int b = u; b < 32; b += F.G) attn_unit(F, a, b & 15, b < 16 ? 0 : 252, b < 16 ? 3 : 255, true);
}
}

__device__ __forceinline__ void vec_phase(const Frame& F, const Args& a) {
    float* V = (float*)(a.ws + WS_VEC); const float* modb = (const float*)(a.ws + WS_MOD);
    for (int c = F.tid; c < D; c += NT) {
#pragma unroll
        for (int l = 0; l < 2; ++l) { const float* mod = modb + (l == 0 ? 0 : 2) * 6144; const float* ng = a.norm_g + l * 4 * D;
            V[(4 + 4 * l) * D + c] = mod[2 * D + c] * ng[D + c]; V[(5 + 4 * l) * D + c] = ng[2 * D + c] * (1.0f + mod[4 * D + c]);
            V[(6 + 4 * l) * D + c] = mod[3 * D + c]; V[(7 + 4 * l) * D + c] = mod[5 * D + c] * ng[3 * D + c]; }
        const float* mod1 = modb + 2 * 6144;
        V[12 * D + c] = a.norm_g[4 * D + c] * (1.0f + mod1[D + c]); V[13 * D + c] = mod1[c];
    }
}

namespace post {
constexpr int LDS_WR = 0;
constexpr int M_TKE = MISC_OFF + 2048;
constexpr int M_TKW = MISC_OFF + 3072;
constexpr int M_RANK = MISC_OFF + 4096;
constexpr int M_LCNT = MISC_OFF + 5120;
constexpr int M_BASE = MISC_OFF + 5248;
__device__ __forceinline__ float reduce32(float (&acc)[32], int lane) {
    float a16[16], a8[8], a4[4], a2[2];
    { const bool hi = lane & 32;
#pragma unroll
      for (int i = 0; i < 16; ++i) { const float send = hi ? acc[i] : acc[i + 16], keep = hi ? acc[i + 16] : acc[i]; a16[i] = keep + __shfl_xor(send, 32); } }
    { const bool hi = lane & 16;
#pragma unroll
      for (int i = 0; i < 8; ++i) { const float send = hi ? a16[i] : a16[i + 8], keep = hi ? a16[i + 8] : a16[i]; a8[i] = keep + __shfl_xor(send, 16); } }
    { const bool hi = lane & 8;
#pragma unroll
      for (int i = 0; i < 4; ++i) { const float send = hi ? a8[i] : a8[i + 4], keep = hi ? a8[i + 4] : a8[i]; a4[i] = keep + __shfl_xor(send, 8); } }
    { const bool hi = lane & 4;
#pragma unroll
      for (int i = 0; i < 2; ++i) { const float send = hi ? a4[i] : a4[i + 2], keep = hi ? a4[i + 2] : a4[i]; a2[i] = keep + __shfl_xor(send, 4); } }
    float v; { const bool hi = lane & 2; const float send = hi ? a2[0] : a2[1], keep = hi ? a2[1] : a2[0]; v = keep + __shfl_xor(send, 2); }
    v += __shfl_xor(v, 1);
    return v;
}
__device__ __forceinline__ float reduce16(float (&acc)[16], int lane) {
    float a8[8], a4[4], a2[2];
    { const bool hi = lane & 16;
#pragma unroll
      for (int i = 0; i < 8; ++i) { const float send = hi ? acc[i] : acc[i + 8], keep = hi ? acc[i + 8] : acc[i]; a8[i] = keep + __shfl_xor(send, 16); } }
    { const bool hi = lane & 8;
#pragma unroll
      for (int i = 0; i < 4; ++i) { const float send = hi ? a8[i] : a8[i + 4], keep = hi ? a8[i + 4] : a8[i]; a4[i] = keep + __shfl_xor(send, 8); } }
    { const bool hi = lane & 4;
#pragma unroll
      for (int i = 0; i < 2; ++i) { const float send = hi ? a4[i] : a4[i + 2], keep = hi ? a4[i + 2] : a4[i]; a2[i] = keep + __shfl_xor(send, 4); } }
    float v; { const bool hi = lane & 2; const float send = hi ? a2[0] : a2[1], keep = hi ? a2[1] : a2[0]; v = keep + __shfl_xor(send, 2); }
    v += __shfl_xor(v, 1); v += __shfl_xor(v, 32);
    return v;
}
__device__ __forceinline__ unsigned wave_max_u32(unsigned v) {
    v = max(v, (unsigned)__builtin_amdgcn_update_dpp(0, (int)v, 0xB1, 0xf, 0xf, true));
    v = max(v, (unsigned)__builtin_amdgcn_update_dpp(0, (int)v, 0x4E, 0xf, 0xf, true));
    v = max(v, (unsigned)__builtin_amdgcn_update_dpp(0, (int)v, 0x124, 0xf, 0xf, true));
    v = max(v, (unsigned)__builtin_amdgcn_update_dpp(0, (int)v, 0x128, 0xf, 0xf, true));
    v = max(v, (unsigned)__builtin_amdgcn_ds_swizzle((int)v, 0x401F));
    return max((unsigned)__builtin_amdgcn_readlane((int)v, 0), (unsigned)__builtin_amdgcn_readlane((int)v, 32));
}
__device__ __forceinline__ void top4(float v, int lane, int (&ei)[4], float (&wv)[4]) {
    const int e = ((lane >> 5) << 4) | ((lane >> 1) & 15); float val[4];
    const unsigned u = __float_as_uint(v);
    unsigned key = ((u ^ ((u >> 31) ? 0xFFFFFFFFu : 0x80000000u)) & ~31u) | (unsigned)(31 - e);
#pragma unroll
    for (int k = 0; k < 4; ++k) {
        const unsigned best = wave_max_u32(key);
        ei[k] = 31 - (int)(best & 31u);
        const unsigned kb = best & ~31u; val[k] = __uint_as_float((kb & 0x80000000u) ? (kb ^ 0x80000000u) : ~kb);
        if (key == best) key = 0u;
    }
    float s = 0.f;
#pragma unroll
    for (int k = 0; k < 4; ++k) { wv[k] = __expf(val[k] - val[0]); s += wv[k]; }
    const float inv = 1.0f / s;
#pragma unroll
    for (int k = 0; k < 4; ++k) wv[k] *= inv;
}
__device__ __forceinline__ void post_phase(const Frame& F, const Args& a, int layer, const float* xin, int nfg, bool do_lists = true) {
    const float* V = (const float*)(a.ws + WS_VEC) + (size_t)(4 + 4 * layer) * D;
    const float* wrt = a.w_router + (size_t)layer * D * NE; const float* brt = a.b_router + layer * NE;
    const rsrc_t rMX = mk_rsrc(a.ws + WS_MX, L * D * 2), rX = mk_rsrc(xin, L * D * 4), rXR = mk_rsrc(a.ws + WS_XR, L * D * 2), rH = mk_rsrc(a.ws + WS_HX2, L * D), rV = mk_rsrc(V, 3 * D * 4);
    int* list = (int*)(a.ws + WS_LIST); float* gate = (float*)(a.ws + WS_GATE); unsigned* gcnt = (unsigned*)(a.ws + WS_CTL) + CW_CNT + 64 * layer;
    LAS unsigned char* lds = F.lds; const int tid = F.tid, lane = F.lane;
    LAS int* tke = (LAS int*)(lds + M_TKE); LAS float* tkw = (LAS float*)(lds + M_TKW); LAS int* rank = (LAS int*)(lds + M_RANK); LAS int* lcnt = (LAS int*)(lds + M_LCNT); LAS int* lbase = (LAS int*)(lds + M_BASE);
    __syncthreads();
    constexpr int XT_HI = 0, XT_LO = 32768, PART = 65536;
    const int wid = F.wave, fr = lane & 15, fq = lane >> 4, et = wid & 1, kq = wid >> 1;
    bf16x8 wh[8], wl[8];
    { const bf16_t* wrt = (const bf16_t*)(a.ws + WS_WRT) + (size_t)(layer * 2) * NE * D + (size_t)(16 * et + fr) * D + kq * 256 + 8 * fq;
#pragma unroll
      for (int s_ = 0; s_ < 8; ++s_) { wh[s_] = *(const bf16x8*)(wrt + 32 * s_); wl[s_] = *(const bf16x8*)(wrt + (size_t)NE * D + 32 * s_); } }
    const int el = ((lane >> 5) << 4) | ((lane >> 1) & 15);
    const float bre = brt[el];
    constexpr int CST = 73728;
    for (int i = tid; i < 3 * D / 4; i += NT) *(LAS f32x4*)(lds + CST + i * 16) = *(const f32x4*)(V + 4 * i);
    __syncthreads();
    auto cst_row = [&](int v) { Row r;
#pragma unroll
        for (int j = 0; j < 4; ++j) r.v[j] = *(const LAS f32x4*)(lds + CST + v * 4096 + j * 1024 + lane * 16);
        return r; };
    for (int tile = blockIdx.x; tile < L / 64; tile += nfg) {
        { unsigned l_; asm volatile("v_mbcnt_lo_u32_b32 %0, -1, 0\n\tv_mbcnt_hi_u32_b32 %0, -1, %0" : "=v"(l_)); if (F.wave == 0 && l_ < 32u) lcnt[l_] = 0; }
        __syncthreads();
        u32x2 mra[4], mrb[4]; Row xna, xnb; u32x2 xra[4], xrb[4];
        { const unsigned t0 = (unsigned)(tile * 64 + 2 * wid);
          row_load_bf16_raw(rMX, t0 * D * 2, lane, mra); row_load_bf16_raw(rMX, (t0 + 1) * D * 2, lane, mrb);
          if (layer == 0) { xna = row_load_f32(rX, t0 * D * 4, lane); xnb = row_load_f32(rX, (t0 + 1) * D * 4, lane); }
          else { row_load_bf16_raw(rXR, t0 * D * 2, lane, xra); row_load_bf16_raw(rXR, (t0 + 1) * D * 2, lane, xrb); } }
        for (int b = 0; b < 4; ++b) {
            const int lr = 16 * b + 2 * wid; const unsigned t0 = (unsigned)(tile * 64 + lr);
            Row xa, xb;
            {   const Row ma = row_unpack_bf16(mra), mb = row_unpack_bf16(mrb);
                if (layer == 0) { xa = xna; xb = xnb; } else { xa = row_unpack_bf16(xra); xb = row_unpack_bf16(xrb); }
                if (b < 3) { const unsigned t1 = t0 + 16;
                    row_load_bf16_raw(rMX, t1 * D * 2, lane, mra); row_load_bf16_raw(rMX, (t1 + 1) * D * 2, lane, mrb);
                    if (layer == 0) { xna = row_load_f32(rX, t1 * D * 4, lane); xnb = row_load_f32(rX, (t1 + 1) * D * 4, lane); }
                    else { row_load_bf16_raw(rXR, t1 * D * 2, lane, xra); row_load_bf16_raw(rXR, (t1 + 1) * D * 2, lane, xrb); } }
                const float ra = rstd_of(row_sumsq(ma)), rb = rstd_of(row_sumsq(mb));
                const Row cA = cst_row(0);
#pragma unroll
                for (int j = 0; j < 4; ++j) { xa.v[j] += cA.v[j] * (ma.v[j] * ra); xb.v[j] += cA.v[j] * (mb.v[j] * rb); } }
            row_store_bf16(rXR, t0 * D * 2, lane, xa); row_store_bf16(rXR, (t0 + 1) * D * 2, lane, xb);
            { const float ra = rstd_of(row_sumsq(xa)), rb = rstd_of(row_sumsq(xb));
              const Row cB = cst_row(1), cC = cst_row(2);
#pragma unroll
              for (int j = 0; j < 4; ++j) { xa.v[j] = xa.v[j] * ra * cB.v[j] + cC.v[j]; xb.v[j] = xb.v[j] * rb * cB.v[j] + cC.v[j]; } }
            row_store_fp8(rH, t0 * D, lane, xa); row_store_fp8(rH, (t0 + 1) * D, lane, xb);
#pragma unroll
            for (int rr = 0; rr < 2; ++rr) { const Row& xr = rr ? xb : xa; const int row = 2 * wid + rr;
#pragma unroll
                for (int j = 0; j < 4; ++j) { const f32x4 v = xr.v[j];
                    u32x2 h; h.x = cvt_pk_bf16(v[0], v[1]); h.y = cvt_pk_bf16(v[2], v[3]);
                    u32x2 lo; lo.x = cvt_pk_bf16(v[0] - bf_lo(h.x), v[1] - bf_hi(h.x)); lo.y = cvt_pk_bf16(v[2] - bf_lo(h.y), v[3] - bf_hi(h.y));
                    const unsigned ad = (unsigned)row * 2048u + ((((unsigned)(lane >> 1) + 32u * j) ^ (unsigned)row) << 4) + ((unsigned)(lane & 1) << 3);
                    *(LAS u32x2*)(lds + XT_HI + ad) = h; *(LAS u32x2*)(lds + XT_LO + ad) = lo; } }
            __syncthreads();
            {   f32x4 acc = {0.f, 0.f, 0.f, 0.f};
#pragma unroll
                for (int s_ = 0; s_ < 8; ++s_) { const unsigned ad = (unsigned)fr * 2048u + ((((unsigned)(4 * (kq * 8 + s_) + fq)) ^ (unsigned)fr) << 4);
                    const bf16x8 xh = *(const LAS bf16x8*)(lds + XT_HI + ad), xl = *(const LAS bf16x8*)(lds + XT_LO + ad);
                    acc = __builtin_amdgcn_mfma_f32_16x16x32_bf16(wh[s_], xh, acc, 0, 0, 0);
                    acc = __builtin_amdgcn_mfma_f32_16x16x32_bf16(wh[s_], xl, acc, 0, 0, 0);
                    acc = __builtin_amdgcn_mfma_f32_16x16x32_bf16(wl[s_], xh, acc, 0, 0, 0); }
                LAS float* pp = (LAS float*)(lds + PART) + (kq * 2 + et) * 256 + (4 * fq) * 16 + fr;
#pragma unroll
                for (int r_ = 0; r_ < 4; ++r_) pp[r_ * 16] = acc[r_]; }
            __syncthreads();
            {   const LAS float* pp = (const LAS float*)(lds + PART) + (lane >> 5) * 256 + ((lane >> 1) & 15) * 16 + 2 * wid;
                float la = bre, lb = bre;
#pragma unroll
                for (int q_ = 0; q_ < 4; ++q_) { la += pp[q_ * 512]; lb += pp[q_ * 512 + 1]; }
                int ea[4], eb[4]; float wa[4], wb[4];
                top4(la, lane, ea, wa); top4(lb, lane, eb, wb);
                if (lane == 0) {
#pragma unroll
                    for (int k = 0; k < 4; ++k) { tke[lr * 4 + k] = ea[k]; tkw[lr * 4 + k] = wa[k]; tke[(lr + 1) * 4 + k] = eb[k]; tkw[(lr + 1) * 4 + k] = wb[k]; } } }
        }
        __syncthreads();
        if (do_lists) {
            unsigned l_; asm volatile("v_mbcnt_lo_u32_b32 %0, -1, 0\n\tv_mbcnt_hi_u32_b32 %0, -1, %0" : "=v"(l_)); const int t2 = F.wave * 64 + (int)l_;
            int e = 0;
            if (t2 < 256) { e = tke[t2]; rank[t2] = atomicAdd((int*)&lcnt[e], 1); }
            __syncthreads();
            if (t2 < 32) { const int n = lcnt[t2]; lbase[t2] = n ? (int)atomicAdd(gcnt + t2, (unsigned)n) : 0; }
            __syncthreads();
            if (t2 < 256) { const int pos = lbase[e] + rank[t2], slot = tile * 256 + t2; list[e * LIST_CAP + pos] = slot; gate[e * LIST_CAP + pos] = tkw[t2];
                if (Y_SORTED) ((int*)(a.ws + WS_POS))[slot] = (e << 16) | pos; }
            __syncthreads();
        }
    }
}
}

constexpr int M_TSTART = MISC_OFF + 256, M_CNT = MISC_OFF + 512, M_TILEE = MISC_OFF + 768;
__device__ __forceinline__ gm::MoeTab moe_tables(const Frame& F, const Args& a, int layer) {
    LAS int* tstart = (LAS int*)(F.lds + M_TSTART); LAS int* cnt = (LAS int*)(F.lds + M_CNT); LAS unsigned char* tile_e = F.lds + M_TILEE;
    const unsigned* gcnt = (const unsigned*)(a.ws + WS_CTL) + CW_CNT + 64 * layer;
    __syncthreads();
    if (F.wave == 0) {
        const int e = F.lane & 31;
        const int n = (int)__hip_atomic_load(gcnt + e, __ATOMIC_RELAXED, __HIP_MEMORY_SCOPE_AGENT), nt = (n + 255) >> 8;
        int ts = 0, tot = 0;
#pragma unroll
        for (int j = 0; j < 32; ++j) { const int v = __builtin_amdgcn_readlane(nt, j); if (j < e) ts += v; tot += v; }
        if (F.lane < 32) { cnt[e] = n; tstart[e] = ts; if (e == 31) tstart[32] = tot;
            for (int t = 0; t < nt; ++t) tile_e[ts + t] = (unsigned char)e; }
    }
    __syncthreads();
    const int T = __builtin_amdgcn_readfirstlane(tstart[32]);
    gm::MoeTab tb; tb.tstart = tstart; tb.cnt = cnt; tb.tile_e = tile_e; tb.T = T; return tb;
}

template <int layer> __device__ __forceinline__ void combine_phase(const Frame& F, const Args& a) {
    const float* V = (const float*)(a.ws + WS_VEC);
    const rsrc_t rY = mk_rsrc(a.ws + WS_Y, Y_SORTED ? (unsigned)ACT_ROWS * D : (unsigned)L * 4 * D * (Y_FP8 ? 1 : 2)), rO = mk_rsrc(a.out, L * D * 4), rXR = mk_rsrc(a.ws + WS_XR, L * D * 2), rHX = mk_rsrc(a.ws + WS_HX, L * D * 2), rV = mk_rsrc(V, 16 * D * 4);
    const int lane = F.lane, gw = F.vcu * NWAVES + F.wave, NGW = F.G * NWAVES;
    const Row cD = row_load_f32(rV, (7 + 4 * layer) * D * 4, lane);
    Row cE, cF;
    if (layer == 0) { cE = row_load_f32(rV, 12 * D * 4, lane); cF = row_load_f32(rV, 13 * D * 4, lane); }
#if Y_FP8 && Y_SORTED
    struct Raw { unsigned y[4][4]; u32x2 x[4]; };
    auto load_raw = [&](int rowv, int ii, int t, Raw& r) {
#pragma unroll
        for (int k = 0; k < 4; ++k) { const unsigned row = (unsigned)__builtin_amdgcn_readlane(rowv, 4 * ii + k);
#pragma unroll
            for (int j = 0; j < 4; ++j) r.y[k][j] = (unsigned)__builtin_amdgcn_raw_buffer_load_b32(rY, 4 * lane, ((((row >> 8) << 2) + j) << 16) + ((row & 255u) << 8), 0); }
#elif Y_FP8
    struct Raw { unsigned y[4][4]; u32x2 x[4]; };
    auto load_raw = [&](int t, Raw& r) {
#pragma unroll
        for (int k = 0; k < 4; ++k)
#pragma unroll
            for (int j = 0; j < 4; ++j) r.y[k][j] = (unsigned)__builtin_amdgcn_raw_buffer_load_b32(rY, 4 * lane, ((unsigned)t * 4 + k) * D + 256 * j, 0);
#else
    struct Raw { u32x2 y[4][4]; u32x2 x[4]; };
    auto load_raw = [&](int t, Raw& r) {
#pragma unroll
        for (int k = 0; k < 4; ++k) row_load_bf16_raw(rY, ((unsigned)t * 4 + k) * D * 2, lane, r.y[k]);
#endif
        row_load_bf16_raw(rXR, (unsigned)t * D * 2, lane, r.x);
    };
    auto finish = [&](int t, const Raw& r) {
        Row f, x = row_unpack_bf16(r.x);
#pragma unroll
        for (int j = 0; j < 4; ++j) { f.v[j] = (f32x4){0.f, 0.f, 0.f, 0.f};
#pragma unroll
            for (int k = 0; k < 4; ++k) {
#if Y_FP8
                const f32x2 a_ = __builtin_amdgcn_cvt_pk_f32_fp8((int)r.y[k][j], false), b_ = __builtin_amdgcn_cvt_pk_f32_fp8((int)r.y[k][j], true); f.v[j] += (f32x4){a_[0], a_[1], b_[0], b_[1]};
#else
                const u32x2 w = r.y[k][j]; f.v[j] += (f32x4){bf_lo(w.x), bf_hi(w.x), bf_lo(w.y), bf_hi(w.y)};
#endif
            } }
#if Y_FP8
#pragma unroll
        for (int j = 0; j < 4; ++j) f.v[j] = f.v[j] * 0.25f;
#endif
        const float rs = rstd_of(row_sumsq(f));
#pragma unroll
        for (int j = 0; j < 4; ++j) x.v[j] += cD.v[j] * (f.v[j] * rs);
        if (layer == 0) row_store_bf16(rXR, (unsigned)t * D * 2, lane, x); else row_store_f32(rO, (unsigned)t * D * 4, lane, x);
        if (layer == 0) { const float r2 = rstd_of(row_sumsq(x));
#pragma unroll
            for (int j = 0; j < 4; ++j) x.v[j] = x.v[j] * r2 * cE.v[j] + cF.v[j];
            row_store_bf16(rHX, (unsigned)t * D * 2, lane, x); }
    };
#if Y_FP8 && Y_SORTED
    const int* posp = (const int*)(a.ws + WS_POS); const LAS int* tstart = (const LAS int*)(F.lds + M_TSTART);
#pragma unroll 1
    for (int i0 = 0; gw + i0 * NGW < L; i0 += 16) {
        int rowv = 0; { const int t_ = gw + (i0 + (lane >> 2)) * NGW; if (t_ < L) { const int pv = posp[4 * t_ + (lane & 3)]; rowv = (tstart[pv >> 16] << 8) + (pv & 0xffff); } }
#pragma unroll 1
        for (int ii = 0; ii < 16; ii += 2) { const int t0 = gw + (i0 + ii) * NGW, t1 = t0 + NGW; if (t0 >= L) break;
            Raw ra, rb; load_raw(rowv, ii, t0, ra); if (t1 < L) load_raw(rowv, ii + 1, t1, rb); finish(t0, ra); if (t1 < L) finish(t1, rb); }
    }
#else
    int t = gw;
    for (; t + NGW < L; t += 2 * NGW) { Raw ra, rb; load_raw(t, ra); load_raw(t + NGW, rb); finish(t, ra); finish(t + NGW, rb); }
    for (; t < L; t += NGW) { Raw ra; load_raw(t, ra); finish(t, ra); }
#endif
}

__device__ __forceinline__ void diff_phase(const Frame& F, const Args& a) {
    const bf16_t* HX = (const bf16_t*)(a.ws + WS_HX); bf16_t* DF = (bf16_t*)(a.ws + WS_O);
    const int cg = F.tid & 127, rg = F.tid >> 7, g = cg >> 5, hs = 1 << g;
    for (int tile = blockIdx.x; tile < L / 64; tile += F.G) {
        const int t0 = tile * 64 + rg * 16;
        float sum[8];
#pragma unroll
        for (int i = 0; i < 8; ++i) sum[i] = 0.f;
        const int lo0 = max(t0 - hs, 0), hi0 = min(t0 + hs, L);
        for (int u = lo0; u < hi0; ++u) { const u32x4 w = *(const u32x4*)(HX + (size_t)u * D + cg * 8);
            sum[0] += bf_lo(w.x); sum[1] += bf_hi(w.x); sum[2] += bf_lo(w.y); sum[3] += bf_hi(w.y); sum[4] += bf_lo(w.z); sum[5] += bf_hi(w.z); sum[6] += bf_lo(w.w); sum[7] += bf_hi(w.w); }
        for (int t = t0; t < t0 + 16; ++t) {
            const int lo = max(t - hs, 0), hi = min(t + hs, L); const float ic = 1.0f / (float)(hi - lo);
            const u32x4 w = *(const u32x4*)(HX + (size_t)t * D + cg * 8);
            const float cv[8] = {bf_lo(w.x), bf_hi(w.x), bf_lo(w.y), bf_hi(w.y), bf_lo(w.z), bf_hi(w.z), bf_lo(w.w), bf_hi(w.w)};
            u32x4 o; o.x = cvt_pk_bf16(sum[0] * ic - cv[0], sum[1] * ic - cv[1]); o.y = cvt_pk_bf16(sum[2] * ic - cv[2], sum[3] * ic - cv[3]);
            o.z = cvt_pk_bf16(sum[4] * ic - cv[4], sum[5] * ic - cv[5]); o.w = cvt_pk_bf16(sum[6] * ic - cv[6], sum[7] * ic - cv[7]);
            st16(DF + (size_t)t * D + cg * 8, o);
            if (t + hs < L) { const u32x4 e = *(const u32x4*)(HX + (size_t)(t + hs) * D + cg * 8);
                sum[0] += bf_lo(e.x); sum[1] += bf_hi(e.x); sum[2] += bf_lo(e.y); sum[3] += bf_hi(e.y); sum[4] += bf_lo(e.z); sum[5] += bf_hi(e.z); sum[6] += bf_lo(e.w); sum[7] += bf_hi(e.w); }
            if (t - hs >= 0) { const u32x4 e = *(const u32x4*)(HX + (size_t)(t - hs) * D + cg * 8);
                sum[0] -= bf_lo(e.x); sum[1] -= bf_hi(e.x); sum[2] -= bf_lo(e.y); sum[3] -= bf_hi(e.y); sum[4] -= bf_lo(e.z); sum[5] -= bf_hi(e.z); sum[6] -= bf_lo(e.w); sum[7] -= bf_hi(e.w); }
        }
    }
}

__device__ __forceinline__ void diff_tile(const Frame& F, const Args& a, int pm, int g) {
    const bf16_t* HX = (const bf16_t*)(a.ws + WS_HX); bf16_t* DF = (bf16_t*)(a.ws + WS_O);
    const int col = g * 256 + (F.tid & 31) * 8, hs = 1 << g, t0 = pm * 256 + (F.tid >> 5) * 16;
    float sum[8];
#pragma unroll
    for (int i = 0; i < 8; ++i) sum[i] = 0.f;
    const int lo0 = max(t0 - hs, 0), hi0 = min(t0 + hs, L);
    for (int u = lo0; u < hi0; ++u) { const u32x4 w = *(const u32x4*)(HX + (size_t)u * D + col);
        sum[0] += bf_lo(w.x); sum[1] += bf_hi(w.x); sum[2] += bf_lo(w.y); sum[3] += bf_hi(w.y); sum[4] += bf_lo(w.z); sum[5] += bf_hi(w.z); sum[6] += bf_lo(w.w); sum[7] += bf_hi(w.w); }
    for (int t = t0; t < t0 + 16; ++t) {
        const int lo = max(t - hs, 0), hi = min(t + hs, L); const float ic = 1.0f / (float)(hi - lo);
        const u32x4 w = *(const u32x4*)(HX + (size_t)t * D + col);
        const float cv[8] = {bf_lo(w.x), bf_hi(w.x), bf_lo(w.y), bf_hi(w.y), bf_lo(w.z), bf_hi(w.z), bf_lo(w.w), bf_hi(w.w)};
        u32x4 o; o.x = cvt_pk_bf16(sum[0] * ic - cv[0], sum[1] * ic - cv[1]); o.y = cvt_pk_bf16(sum[2] * ic - cv[2], sum[3] * ic - cv[3]);
        o.z = cvt_pk_bf16(sum[4] * ic - cv[4], sum[5] * ic - cv[5]); o.w = cvt_pk_bf16(sum[6] * ic - cv[6], sum[7] * ic - cv[7]);
        st16(DF + (size_t)t * D + col, o);
        if (t + hs < L) { const u32x4 e = *(const u32x4*)(HX + (size_t)(t + hs) * D + col);
            sum[0] += bf_lo(e.x); sum[1] += bf_hi(e.x); sum[2] += bf_lo(e.y); sum[3] += bf_hi(e.y); sum[4] += bf_lo(e.z); sum[5] += bf_hi(e.z); sum[6] += bf_lo(e.w); sum[7] += bf_hi(e.w); }
        if (t - hs >= 0) { const u32x4 e = *(const u32x4*)(HX + (size_t)(t - hs) * D + col);
            sum[0] -= bf_lo(e.x); sum[1] -= bf_hi(e.x); sum[2] -= bf_lo(e.y); sum[3] -= bf_hi(e.y); sum[4] -= bf_lo(e.z); sum[5] -= bf_hi(e.z); sum[6] -= bf_lo(e.w); sum[7] -= bf_hi(e.w); }
    }
}

constexpr int N_PHASES = 15;
__global__ void __launch_bounds__(NT, 2) mk_fwd(Args args) {
    extern __shared__ __attribute__((aligned(16))) unsigned char lds_raw[];
    Frame F; F.lds = (LAS unsigned char*)lds_raw; F.tid = 0; F.lane = 0; F.wave = __builtin_amdgcn_readfirstlane(threadIdx.x >> 6);
    F.G = gridDim.x; { const int bx = blockIdx.x; F.vcu = (F.G % 8 == 0) ? (bx % 8) * (F.G / 8) + bx / 8 : bx; }
    volatile LAS unsigned* MISC = (volatile LAS unsigned*)(F.lds + MISC_OFF);
    if (threadIdx.x < 16) MISC[threadIdx.x] = 0u;
    __syncthreads();
    const int lo = args.ph_lo, hi = args.ph_hi;
    unsigned* ctl = (unsigned*)(args.ws + WS_CTL);
    XcdBarrier bar; bar.bar = ctl + CW_BAR; bar.x = 0; bar.st = nullptr;
    if (hi - lo > 1) bar = xcd_barrier_post(ctl + CW_BAR, MISC + 8, threadIdx.x == 0);
#ifndef P0_CONV_WGS
#define P0_CONV_WGS 0
#endif
#ifndef PROBE_BAR2
#define PROBE_BAR2 0
#endif
#ifndef POST_FG
#define POST_FG 256
#endif
#ifndef CTX_IN_P1
#define CTX_IN_P1 0
#endif
#ifndef MOE_EXTRA_ROUNDS
#define MOE_EXTRA_ROUNDS 0
#endif
#ifndef FUSE_DIFF
#define FUSE_DIFF 1
#endif
#ifndef BG_STOP_NUM
#define BG_STOP_NUM 1
#define BG_STOP_DEN 1
#endif
#ifndef BG_MASK
#define BG_MASK 0xffff
#endif
#ifndef PROBE_DUP
#define PROBE_DUP 0
#endif
#ifndef STAGGER
#define STAGGER 0
#endif

#define REPS(k) (((PROBE_DUP >> (k)) & 1) ? 2 : 1)
#ifndef PH_MASK
#define PH_MASK 0x7fff
#endif
#define IN(k) (((PH_MASK >> (k)) & 1) && lo <= (k) && (k) < hi)
#define PHASE_FRAME() Frame Fp = F; { unsigned l_; asm volatile("v_mbcnt_lo_u32_b32 %0, -1, 0\n\tv_mbcnt_hi_u32_b32 %0, -1, %0" : "=v"(l_)); Fp.lane = (int)l_; Fp.tid = F.wave * 64 + (int)l_; }
#define SEAM(k) do { if (IN(k) && IN((k) + 1)) { unsigned l_; asm volatile("v_mbcnt_lo_u32_b32 %0, -1, 0\n\tv_mbcnt_hi_u32_b32 %0, -1, %0" : "=v"(l_)); xcd_barrier(bar, F.wave == 0 && l_ == 0u); if (PROBE_BAR2) xcd_barrier(bar, F.wave == 0 && l_ == 0u); } } while (0)
    unsigned char* ws = args.ws;
    bf16_t* HX = (bf16_t*)(ws + WS_HX);
    const float* mod0 = (const float*)(ws + WS_MOD);

    if (IN(0)) for (int rep_ = 0; rep_ < REPS(0); ++rep_) { PHASE_FRAME(); p0_adaln(Fp, args); p0_router_weights(Fp, args); p0_convert_small(Fp, args); if ((int)blockIdx.x < P0_CONV_WGS) { bg_convert(Fp, args, 0, 0, 0u, false); bg_convert(Fp, args, 1, 0, 0u, false); } }
    SEAM(0);
    const bool ctx_p1 = CTX_IN_P1 && !QKV_FP8 && F.G == 256;
    if (IN(1)) for (int rep_ = 0; rep_ < REPS(1); ++rep_) { PHASE_FRAME();
        if (ctx_p1) {
            if (blockIdx.x >= 248) {
                modulate_rows(Fp, args.ctx, CTX, args.norm_g, mod0 + 6144, mod0 + 6144 + D, HX + (size_t)L * D, Fp.wave, NWAVES);
                asm volatile("s_waitcnt vmcnt(0)" ::: "memory"); __syncthreads();
                gm::OneProb P{(const char*)HX, (const char*)(ws + WS_WQKV), 2048u, 2048u, 1024, L / 256, 4 + ((int)blockIdx.x - 248), (size_t)256 * 2048};
                gm::EpiBf16 E{(bf16_t*)(ws + WS_Q), D, nullptr, nullptr, D, (size_t)(WS_K - WS_Q) / 2, QSCALE, 256, 1.f};
                gm::gemm_phase(Fp.lds, Fp.tid, P, E);
            } else {
                modulate_rows(Fp, args.x, L, args.norm_g, mod0, mod0 + D, HX, (int)blockIdx.x * NWAVES + Fp.wave, 248 * NWAVES);
                if (blockIdx.x == 247) vec_phase(Fp, args);
            }
        } else {
            modulate_rows<QKV_FP8 != 0>(Fp, args.x, L, args.norm_g, mod0, mod0 + D, HX, Fp.vcu * NWAVES + Fp.wave, (int)F.G * NWAVES);
            modulate_rows<QKV_FP8 != 0>(Fp, args.ctx, CTX, args.norm_g, mod0 + 6144, mod0 + 6144 + D, QKV_FP8 ? (void*)((unsigned char*)HX + (size_t)L * D) : (void*)(HX + (size_t)L * D), Fp.vcu * NWAVES + Fp.wave, (int)F.G * NWAVES);
            if (blockIdx.x == gridDim.x - 1) vec_phase(Fp, args);
        }
    }
    SEAM(1);
    if (IN(2)) for (int rep_ = 0; rep_ < REPS(2); ++rep_) { PHASE_FRAME();
        const int nMq = ctx_p1 ? L / 256 : MQ / 256, NU = nMq * 12; const int Gf = min((int)F.G, (NU + ((NU + F.G - 1) / F.G) - 1) / ((NU + F.G - 1) / F.G));
        if ((int)blockIdx.x < Gf) {
#if QKV_FP8
            gm::DenseProbT<true> P{(const char*)HX, (const char*)(ws + WS_WQKV), 1024u, 1024u, 1024, nMq, 12, Gf, (int)blockIdx.x, 0, (size_t)256 * 1024};
            gm::EpiBf16 E{(bf16_t*)(ws + WS_Q), D, nullptr, nullptr, D, (size_t)(WS_K - WS_Q) / 2, QSCALE, 256, 0.015625f};
#else
            gm::DenseProb P{(const char*)HX, (const char*)(ws + WS_WQKV), 2048u, 2048u, 1024, nMq, 12, Gf, (int)blockIdx.x, 0, (size_t)256 * 2048};
            gm::EpiBf16 E{(bf16_t*)(ws + WS_Q), D, nullptr, nullptr, D, (size_t)(WS_K - WS_Q) / 2, QSCALE, 256, 1.f};
#endif
            gm::gemm_phase(Fp.lds, Fp.tid, P, E);
        }
        if ((BG_MASK >> 2) & 1) { PHASE_FRAME(); bg_convert(Fp, args, 0, 2, (unsigned)max(1, Gf * BG_STOP_NUM / BG_STOP_DEN), (int)blockIdx.x < Gf); }
    }
    SEAM(2);
    if (IN(3)) for (int rep_ = 0; rep_ < REPS(3); ++rep_) { PHASE_FRAME(); na::attn_phase(Fp, args);
        if (F.G == 256 && ((BG_MASK >> 3) & 1)) { PHASE_FRAME(); bg_convert(Fp, args, 0, 3, (unsigned)max(1, 16 * ATT_STRIPS * BG_STOP_NUM / BG_STOP_DEN), (int)blockIdx.x < 16 * ATT_STRIPS); } }
    SEAM(3);
    if (IN(4)) for (int rep_ = 0; rep_ < REPS(4); ++rep_) { PHASE_FRAME();
        gm::DenseProb P{(const char*)(ws + WS_O), (const char*)(ws + WS_WO), 2048u, 2048u, 1024, L / 256, 4, F.G, (int)blockIdx.x, 0, (size_t)256 * 2048};
        gm::EpiBf16 E{(bf16_t*)(ws + WS_MX), D, nullptr, nullptr, 0, 0, 1.f, 256, 1.f};
        gm::gemm_phase(Fp.lds, Fp.tid, P, E);
    }
    SEAM(4);
    if (IN(5)) for (int rep_ = 0; rep_ < REPS(5); ++rep_) { const int nfg = (F.G == 256) ? POST_FG : (int)F.G;
        if ((int)blockIdx.x < nfg) { PHASE_FRAME(); post::post_phase(Fp, args, 0, args.x, nfg, rep_ == REPS(5) - 1); }
        { PHASE_FRAME(); bg_convert(Fp, args, 0, 5, 0u, false); } }
    SEAM(5);
    if (IN(6)) for (int rep_ = 0; rep_ < REPS(6); ++rep_) { PHASE_FRAME();
        const gm::MoeTab tb = moe_tables(Fp, args, 0);
        const int NU = tb.T * 8, rounds = (NU + F.G - 1) / F.G + MOE_EXTRA_ROUNDS, Gf = min((int)F.G, (NU + rounds - 1) / rounds);
        if ((int)blockIdx.x < Gf) {
            const bool hot_ = PROBE_HOT == 1 && REPS(6) == 2 && rep_ == 0; const unsigned ld_ = hot_ ? 0u : 1024u;
            gm::MoeProb<true> P{(const char*)(ws + WS_HX2), (const char*)(ws + WS_WUP), ld_, ld_, 1024, 8, Gf, (int)blockIdx.x, tb, (const int*)(ws + WS_LIST), hot_ ? (size_t)0 : (size_t)2048 * 1024, hot_ ? (size_t)0 : (size_t)256 * 1024};
            gm::EpiSwiglu E{ws + WS_ACT, args.b_up};
#if PROBE_NOEPI
            E.skip = REPS(6) == 2 && rep_ == 0;
#endif
            gm::gemm_phase(Fp.lds, Fp.tid, P, E);
        }
        if ((BG_MASK >> 6) & 1) { PHASE_FRAME(); bg_convert(Fp, args, 1, 6, (unsigned)max(1, Gf * BG_STOP_NUM / BG_STOP_DEN), (int)blockIdx.x < Gf); }
    }
    SEAM(6);
    if (IN(7)) for (int rep_ = 0; rep_ < REPS(7); ++rep_) { PHASE_FRAME();
        const gm::MoeTab tb = moe_tables(Fp, args, 0);
        const int NU = tb.T * 4, rounds = (NU + F.G - 1) / F.G + MOE_EXTRA_ROUNDS, Gf = min((int)F.G, (NU + rounds - 1) / rounds);
        if (STAGGER && (blockIdx.x & 1)) for (int i_ = 0; i_ < STAGGER; ++i_) __builtin_amdgcn_s_sleep(64);
        if ((int)blockIdx.x < Gf) {
            const bool hot_ = PROBE_HOT == 1 && REPS(7) == 2 && rep_ == 0; const unsigned ld_ = hot_ ? 0u : 1024u;
            gm::MoeProb<false> P{(const char*)(ws + WS_ACT), (const char*)(ws + WS_WDN), ld_, ld_, 1024, 4, Gf, (int)blockIdx.x, tb, (const int*)(ws + WS_LIST), hot_ ? (size_t)0 : (size_t)1024 * 1024, hot_ ? (size_t)0 : (size_t)256 * 1024};
#if PROBE_HOT == 2
            P.same = REPS(7) == 2 && rep_ == 0;
#endif
            gm::EpiDown E{ws + WS_Y, args.b_down, (const float*)(ws + WS_GATE), (const int*)(ws + WS_LIST), tb, Fp.lds};
#if PROBE_NOEPI
            E.skip = REPS(7) == 2 && rep_ == 0;
#endif
            gm::gemm_phase(Fp.lds, Fp.tid, P, E);
        }
        if ((BG_MASK >> 7) & 1) { PHASE_FRAME(); bg_convert(Fp, args, 1, 7, (unsigned)max(1, Gf * BG_STOP_NUM / BG_STOP_DEN), (int)blockIdx.x < Gf); }
    }
    SEAM(7);
    if (IN(8)) for (int rep_ = 0; rep_ < REPS(8); ++rep_) { PHASE_FRAME(); if (Y_SORTED) (void)moe_tables(Fp, args, 0); combine_phase<0>(Fp, args); }
    SEAM(8);
    if (!FUSE_DIFF) { if (IN(9)) for (int rep_ = 0; rep_ < REPS(9); ++rep_) { PHASE_FRAME(); diff_phase(Fp, args); }
        SEAM(9); }
    if (IN(10)) for (int rep_ = 0; rep_ < REPS(10); ++rep_) { PHASE_FRAME();
        gm::DenseProb P{(const char*)(ws + WS_O), (const char*)(ws + WS_WPOOL), 2048u, 512u, 256, L / 256, 4, F.G, (int)blockIdx.x, 512, (size_t)256 * 512};
        if (FUSE_DIFF) {
            gm::Unit u_; for (int i_ = 0; P.next(i_, u_); ++i_) diff_tile(Fp, args, u_.pm, u_.pn);
            asm volatile("s_waitcnt vmcnt(0)" ::: "memory"); __syncthreads();
        }
        gm::EpiBf16 E{(bf16_t*)(ws + WS_MX), D, args.pool_b, args.pool_scale, 0, 0, 1.f, 256, 1.f};
        gm::gemm_phase(Fp.lds, Fp.tid, P, E);
    }
    SEAM(10);
    if (IN(11)) for (int rep_ = 0; rep_ < REPS(11); ++rep_) { const int nfg = (F.G == 256) ? POST_FG : (int)F.G;
        if ((int)blockIdx.x < nfg) { PHASE_FRAME(); post::post_phase(Fp, args, 1, args.x, nfg); }
        { PHASE_FRAME(); bg_convert(Fp, args, 1, 11, 0u, false); } }
    SEAM(11);
    if (IN(12)) for (int rep_ = 0; rep_ < REPS(12); ++rep_) { PHASE_FRAME();
        const gm::MoeTab tb = moe_tables(Fp, args, 1);
        gm::MoeProb<true> P{(const char*)(ws + WS_HX2), (const char*)(ws + WS_WUP) + (size_t)32 * 2048 * 1024, 1024u, 1024u, 1024, 8, F.G, (int)blockIdx.x, tb, (const int*)(ws + WS_LIST), (size_t)2048 * 1024, (size_t)256 * 1024};
        gm::EpiSwiglu E{ws + WS_ACT, args.b_up + 32 * 2048};
        gm::gemm_phase(Fp.lds, Fp.tid, P, E);
    }
    SEAM(12);
    if (IN(13)) for (int rep_ = 0; rep_ < REPS(13); ++rep_) { PHASE_FRAME();
        const gm::MoeTab tb = moe_tables(Fp, args, 1);
        if (STAGGER && (blockIdx.x & 1)) for (int i_ = 0; i_ < STAGGER; ++i_) __builtin_amdgcn_s_sleep(64);
        gm::MoeProb<false> P{(const char*)(ws + WS_ACT), (const char*)(ws + WS_WDN) + (size_t)32 * 1024 * 1024, 1024u, 1024u, 1024, 4, F.G, (int)blockIdx.x, tb, (const int*)(ws + WS_LIST), (size_t)1024 * 1024, (size_t)256 * 1024};
        gm::EpiDown E{ws + WS_Y, args.b_down + 32 * D, (const float*)(ws + WS_GATE), (const int*)(ws + WS_LIST), tb, Fp.lds};
        gm::gemm_phase(Fp.lds, Fp.tid, P, E);
    }
    SEAM(13);
    if (IN(14)) for (int rep_ = 0; rep_ < REPS(14); ++rep_) { PHASE_FRAME(); if (Y_SORTED) (void)moe_tables(Fp, args, 1); combine_phase<1>(Fp, args); }
#undef IN
#undef SEAM
#undef PHASE_FRAME
}

extern "C" void kernel_launch(void* const* d_in, const int* in_sizes, int n_in, void* d_out, int out_size, void* d_ws, size_t ws_size, hipStream_t stream) {
    static int grid = 0;
    if (grid == 0) {
        if (n_in != 19 || in_sizes[0] != L * D || out_size != L * D || ws_size < WS_END) { fprintf(stderr, "kernel_launch: unexpected problem (n_in %d, in0 %d, out %d, ws %zu); nothing launched\n", n_in, n_in > 0 ? in_sizes[0] : -1, out_size, ws_size); grid = -1; return; }
        int dev = 0, cus = 0, per_cu = 0;
        if (hipGetDevice(&dev) != hipSuccess || hipDeviceGetAttribute(&cus, hipDeviceAttributeMultiprocessorCount, dev) != hipSuccess) { grid = -1; return; }
        if (hipFuncSetAttribute((const void*)mk_fwd, hipFuncAttributeMaxDynamicSharedMemorySize, LDS_BYTES) != hipSuccess) { fprintf(stderr, "kernel_launch: hipFuncSetAttribute failed\n"); grid = -1; return; }
        if (hipOccupancyMaxActiveBlocksPerMultiprocessor(&per_cu, (const void*)mk_fwd, NT, LDS_BYTES) != hipSuccess || per_cu < 1) fprintf(stderr, "kernel_launch: occupancy query reports %d workgroups per CU\n", per_cu);
        (void)hipGetLastError();
        grid = cus;
    }
    if (grid < 0) return;
    (void)hipMemsetAsync((char*)d_ws + WS_CTL, 0, CTL_ZERO_BYTES, stream);
    Args a{};
    a.x = (const float*)d_in[0]; a.c = (const float*)d_in[1]; a.ctx = (const float*)d_in[2]; a.c_ctx = (const float*)d_in[3]; a.ada_w = (const float*)d_in[4]; a.ada_b = (const float*)d_in[5];
    a.norm_g = (const float*)d_in[6]; a.w_qkv = (const float*)d_in[7]; a.w_o = (const float*)d_in[8]; a.rpb = (const float*)d_in[9]; a.pool_w = (const float*)d_in[10]; a.pool_b = (const float*)d_in[11];
    a.pool_scale = (const float*)d_in[12]; a.w_router = (const float*)d_in[13]; a.b_router = (const float*)d_in[14]; a.w_up = (const float*)d_in[15]; a.b_up = (const float*)d_in[16];
    a.w_down = (const float*)d_in[17]; a.b_down = (const float*)d_in[18];
    a.out = (float*)d_out; a.ws = (unsigned char*)d_ws;
#if MK_ONE_LAUNCH
    a.ph_lo = 0; a.ph_hi = N_PHASES;
    hipLaunchKernelGGL(mk_fwd, dim3(grid), dim3(NT), LDS_BYTES, stream, a);
#else
    for (int p = 0; p < N_PHASES; ++p) { a.ph_lo = p; a.ph_hi = p + 1; hipLaunchKernelGGL(mk_fwd, dim3(grid), dim3(NT), LDS_BYTES, stream, a); }
#endif
}
```

```cpp
#include <hip/hip_runtime.h>
#include <cstdio>
#include <cstdint>

#ifndef Y_FP8
#define Y_FP8 1
#endif
#ifndef MK_ONE_LAUNCH
#define MK_ONE_LAUNCH 1
#ifndef PROBE_HOT
#define PROBE_HOT 0
#endif
#ifndef PROBE_NT5
#define PROBE_NT5 0
#endif
#ifndef PROBE_NOEPI
#define PROBE_NOEPI 0
#endif
#ifndef QKV_FP8
#define QKV_FP8 1
#endif
#endif

#define GAS __attribute__((address_space(1)))
#define LAS __attribute__((address_space(3)))
typedef unsigned short bf16_t;
typedef short bf16x8 __attribute__((ext_vector_type(8)));
typedef short s16x4 __attribute__((ext_vector_type(4)));
typedef float f32x4 __attribute__((ext_vector_type(4)));
typedef float f32x2 __attribute__((ext_vector_type(2)));
typedef unsigned u32x4 __attribute__((ext_vector_type(4)));
typedef unsigned u32x2 __attribute__((ext_vector_type(2)));
typedef int v8i __attribute__((ext_vector_type(8)));
typedef int v4i __attribute__((ext_vector_type(4)));

constexpr int L = 16384, D = 1024, CTX = 256, NH = 16, HD = 64, NE = 32, GW = 64;
constexpr int MQ = L + CTX;
constexpr float RMS_EPS = 1e-6f;
constexpr float LOG2E = 1.4426950408889634f;
constexpr float QSCALE = 0.125f * LOG2E;
constexpr int NWAVES = 8, NT = 512;

constexpr size_t MiB = 1u << 20;
constexpr size_t WS_CTL = 0, CTL_ZERO_BYTES = 128 * 1024;
constexpr size_t WS_MOD = 1 * MiB;
constexpr size_t WS_POS = 1 * MiB + 256 * 1024;
constexpr size_t WS_VEC = 1 * MiB + 512 * 1024;
constexpr size_t WS_WRT = 1 * MiB + 768 * 1024;
constexpr size_t WS_WQKV = 2 * MiB;
constexpr size_t WS_WO = 8 * MiB;
constexpr size_t WS_WPOOL = 10 * MiB;
constexpr size_t WS_LIST = 12 * MiB;
constexpr size_t WS_GATE = 14 * MiB;
constexpr size_t WS_HX = 16 * MiB;
constexpr size_t WS_Q = 50 * MiB, WS_K = 83 * MiB, WS_V = 116 * MiB;
constexpr size_t WS_O = 150 * MiB;
constexpr size_t WS_MX = 182 * MiB;
constexpr size_t WS_HX2 = 214 * MiB;
constexpr size_t WS_ACT = 256 * MiB;
constexpr size_t WS_Y = 408 * MiB;
constexpr size_t WS_WUP = 544 * MiB;
constexpr size_t WS_WDN = 816 * MiB;
constexpr size_t WS_XR = 952 * MiB;
constexpr size_t WS_END = 984 * MiB;
constexpr int CW_BAR = 4096;
constexpr int CW_CNT = 16384;
constexpr int CW_Q = 20480;
constexpr int CW_DONE = 24576;
constexpr int ACT_ROWS = 73728, LIST_CAP = 16384;

constexpr int RING_BYTES = 131072;
constexpr int MISC_OFF = RING_BYTES;
constexpr int M_PRE = MISC_OFF + 8192;
#ifndef Y_SORTED
#define Y_SORTED 1
#endif
#ifndef EPI_STAGE
#define EPI_STAGE 1
#endif
constexpr int STG0 = 3 * 16384;
constexpr int STG1 = 147456;
constexpr int LDS_BYTES = EPI_STAGE ? 163840 : 147456;

#define LDS_WAIT() asm volatile("s_waitcnt lgkmcnt(0)" ::: "memory")
#define VM_WAIT() asm volatile("s_waitcnt vmcnt(0)" ::: "memory")

typedef __bf16 bf16x2_t __attribute__((ext_vector_type(2)));
__device__ __forceinline__ unsigned cvt_pk_bf16(float lo, float hi) { const f32x2 v = {lo, hi}; return __builtin_bit_cast(unsigned, __builtin_convertvector(v, bf16x2_t)); }
__device__ __forceinline__ float clamp448(float v) { return __builtin_amdgcn_fmed3f(v, -448.0f, 448.0f); }
__device__ __forceinline__ unsigned cvt_pk4_fp8(float a, float b, float c, float d) { int w = __builtin_amdgcn_cvt_pk_fp8_f32(a, b, 0, false); w = __builtin_amdgcn_cvt_pk_fp8_f32(c, d, w, true); return (unsigned)w; }
__device__ __forceinline__ unsigned cvt_pk4_fp8_sat(float a, float b, float c, float d) { return cvt_pk4_fp8(clamp448(a), clamp448(b), clamp448(c), clamp448(d)); }
__device__ __forceinline__ float bf_lo(unsigned u) { return __uint_as_float(u << 16); }
__device__ __forceinline__ float bf_hi(unsigned u) { return __uint_as_float(u & 0xffff0000u); }
#ifndef WT_STORES
#define WT_STORES 0
#endif
__device__ __forceinline__ void st16(void* p, u32x4 v) {
#if WT_STORES
    asm volatile("global_store_dwordx4 %0, %1, off sc1\n\ts_nop 1" :: "v"(p), "v"(v) : "memory");
#else
    *(u32x4*)p = v;
#endif
}
#ifndef STAGE_NT
#define STAGE_NT 1
#endif
#ifndef NT_DOWN
#define NT_DOWN 0
#endif
__device__ __forceinline__ void st16nt(void* p, u32x4 v) { __builtin_nontemporal_store(v, (u32x4*)p); }
__device__ __forceinline__ void st8(void* p, u32x2 v) {
#if 0
    asm volatile("global_store_dwordx2 %0, %1, off sc1\n\ts_nop 1" :: "v"(p), "v"(v) : "memory");
#else
    *(u32x2*)p = v;
#endif
}
__device__ __forceinline__ void st4(void* p, unsigned v) {
#if 0
    asm volatile("global_store_dword %0, %1, off sc1\n\ts_nop 1" :: "v"(p), "v"(v) : "memory");
#else
    *(unsigned*)p = v;
#endif
}
__device__ __forceinline__ float wave_sum(float v) {
    v += __builtin_bit_cast(float, __builtin_amdgcn_update_dpp(0, __builtin_bit_cast(int, v), 0xB1, 0xf, 0xf, true));
    v += __builtin_bit_cast(float, __builtin_amdgcn_update_dpp(0, __builtin_bit_cast(int, v), 0x4E, 0xf, 0xf, true));
    v += __builtin_bit_cast(float, __builtin_amdgcn_update_dpp(0, __builtin_bit_cast(int, v), 0x124, 0xf, 0xf, true));
    v += __builtin_bit_cast(float, __builtin_amdgcn_update_dpp(0, __builtin_bit_cast(int, v), 0x128, 0xf, 0xf, true));
    v += __builtin_bit_cast(float, __builtin_amdgcn_ds_swizzle(__builtin_bit_cast(int, v), 0x401F));
    return __builtin_bit_cast(float, __builtin_amdgcn_readlane(__builtin_bit_cast(int, v), 0)) + __builtin_bit_cast(float, __builtin_amdgcn_readlane(__builtin_bit_cast(int, v), 32));
}

#define XB_TMO      128
#define XB_XCNT(j)  (256  + 64 * (j))
#define XB_XSUB(j)  (1280 + 64 * (j))
#define XB_XGEN(j)  (2304 + 64 * (j))
#define XB_TOP      3328
#define XB_TOPGEN   3392
#define XCD_BAR_WORDS 3456
#define XB_SPIN_CAP (1u << 18)
__device__ __forceinline__ unsigned xb_ld(unsigned* p)              { return __hip_atomic_load(p, __ATOMIC_RELAXED, __HIP_MEMORY_SCOPE_AGENT); }
__device__ __forceinline__ unsigned xb_add(unsigned* p, unsigned v) { return __hip_atomic_fetch_add(p, v, __ATOMIC_RELAXED, __HIP_MEMORY_SCOPE_AGENT); }
__device__ __forceinline__ unsigned xb_xcc_id() { return (unsigned)__builtin_amdgcn_s_getreg((3 << 11) | 20) & 0xFu; }
#define XB_SPIN(cond, bar) do { unsigned _sp = 0; while (cond) { __builtin_amdgcn_s_sleep(1); \
    if ((++_sp & 255u) == 0u) { if (xb_ld(&(bar)[XB_TMO])) break; if (_sp > XB_SPIN_CAP) { atomicAdd(&(bar)[XB_TMO], 1u); break; } } } } while (0)
struct XcdBarrier { unsigned* bar; unsigned x; volatile LAS unsigned* st; };
__device__ __forceinline__ XcdBarrier xcd_barrier_post(unsigned* bar, volatile LAS unsigned* st, bool leader) {
    XcdBarrier b; b.bar = bar; b.x = xb_xcc_id(); b.st = st;
    if (leader) (void)xb_add(&bar[XB_XCNT(b.x)], 1u);
    return b;
}
__device__ __forceinline__ void xcd_barrier_complete(unsigned* bar, unsigned x, unsigned& nloc, unsigned& nx) {
    const unsigned G = gridDim.x * gridDim.y * gridDim.z;
    unsigned sum, cnt, mine, sp = 0u;
    for (;;) {
        sum = 0u; cnt = 0u; mine = 0u;
#pragma unroll
        for (unsigned j = 0; j < 16; ++j) { const unsigned c = xb_ld(&bar[XB_XCNT(j)]); sum += c; cnt += (c > 0u) ? 1u : 0u; mine = (j == x) ? c : mine; }
        if (sum == G) break;
        __builtin_amdgcn_s_sleep(1);
        if ((++sp & 255u) == 0u) { if (xb_ld(&bar[XB_TMO])) break; if (sp > XB_SPIN_CAP) { atomicAdd(&bar[XB_TMO], 1u); break; } }
    }
    nloc = mine > 0u ? mine : 1u; nx = cnt > 0u ? cnt : 1u;
}
__device__ __forceinline__ void xcd_barrier(const XcdBarrier& b, bool leader) {
    asm volatile("s_waitcnt vmcnt(0)" ::: "memory");
    __syncthreads();
    if (leader) {
        unsigned* bar = b.bar;
        __builtin_amdgcn_s_waitcnt(0);
        unsigned nloc = b.st[0], nx = b.st[1];
        if (nloc == 0u) { xcd_barrier_complete(bar, b.x, nloc, nx); b.st[0] = nloc; b.st[1] = nx; }
        const unsigned old = xb_add(&bar[XB_XSUB(b.x)], 1u);
        const unsigned gen = old / nloc;
        if (old + 1u == (gen + 1u) * nloc) {
            __builtin_amdgcn_fence(__ATOMIC_RELEASE, "agent");
            asm volatile("s_waitcnt vmcnt(0)" ::: "memory");
            const unsigned og = xb_add(&bar[XB_TOP], 1u);
            const unsigned tg = og / nx;
            if (og + 1u == (tg + 1u) * nx) xb_add(&bar[XB_TOPGEN], 1u);
            else XB_SPIN(xb_ld(&bar[XB_TOPGEN]) == tg, bar);
            __builtin_amdgcn_fence(__ATOMIC_ACQUIRE, "agent");
            xb_add(&bar[XB_XGEN(b.x)], 1u);
            asm volatile("s_waitcnt vmcnt(0)" ::: "memory");
        } else {
            XB_SPIN(xb_ld(&bar[XB_XGEN(b.x)]) == gen, bar);
            __builtin_amdgcn_fence(__ATOMIC_ACQUIRE, "agent");
            asm volatile("s_waitcnt vmcnt(0)" ::: "memory");
        }
    }
    __syncthreads();
}

#ifndef K_ROT
#define K_ROT 0
#endif
namespace gm {
constexpr int BM = 256, BK = 64, HALF = 128, HTB = HALF * BK * 2, STAGE_BYTES = 8 * HTB, NXCD = 8, WGM = 8;
__device__ __forceinline__ int lds_byte(int r, int c) { const int st = (r >> 4) * 2 + (c >> 5), rr = r & 15, cc = c & 31, ob = rr * 64 + cc * 2; return st * 1024 + (ob ^ (((ob >> 9) & 1) << 5)); }
__device__ __forceinline__ void stage_rc(int b, int& R, int& C) { const int st = b / 1024, sb = b % 1024, swz = sb ^ (((sb >> 9) & 1) << 5); R = (st >> 1) * 16 + swz / 64; C = (st & 1) * 32 + (swz % 64) / 2; }
__device__ __forceinline__ int perm32(int rho) { const int n = rho >> 4, i = rho & 15; return 8 * (i >> 2) + 4 * n + (i & 3); }

struct Unit { int pm, pn, e, aux, rot; const char* Ab; const char* Bb; };

__device__ __forceinline__ bool static_order(int i, int G, int c, int nM, int nN, int& pm, int& pn) {
    const int nwg = nM * nN; const int Lx = i * G + c; if (Lx >= nwg) return false;
    int wgid = Lx; { const int q = nwg / NXCD, r = nwg % NXCD, xcd = wgid % NXCD, off = wgid / NXCD; wgid = (xcd < r ? xcd * (q + 1) : r * (q + 1) + (xcd - r) * q) + off; }
    const int nig = WGM * nN, gid = wgid / nig, fm = gid * WGM, gsz = (nM - fm) < WGM ? (nM - fm) : WGM;
    pm = fm + ((wgid % nig) % gsz); pn = (wgid % nig) / gsz; return true;
}

template <class Prob, class Epi>
__device__ __forceinline__ void gemm_phase(LAS unsigned char* lds, const int tid, const Prob& P, const Epi& E) {
    const int wid = __builtin_amdgcn_readfirstlane(tid >> 6), lane = tid & 63, wr = wid >> 2, wc = wid & 3, fr = lane & 15, fq = lane >> 4;
    const int nt = Prob::FP8 ? P.K / 128 : P.K / BK;
    int Rl[2], Cl[2]; unsigned offB[2];
#pragma unroll
    for (int i = 0; i < 2; ++i) { int R, C; stage_rc(tid * 16 + i * 8192, R, C); const int Rb = (R & ~31) + perm32(R & 31); Rl[i] = R; Cl[i] = C; offB[i] = (unsigned)Rb * P.ldb + (unsigned)C * 2u; }
    const size_t hB = (size_t)HALF * P.ldb;
    const unsigned ldsw = (unsigned)wid * 1024u;
    const int aoff = lds_byte(wr * 64 + fr, fq * 8), boff = lds_byte(wc * 32 + fr, fq * 8);
#define GM_SA(b, h) (((b) * 2 + (h)) * HTB)
#define GM_SB(b, h) ((4 + (b) * 2 + (h)) * HTB)
#define GM_STAGE(bufoff, gbase, voff, kb) do { _Pragma("unroll") for (int _i = 0; _i < 2; ++_i)   \
        __builtin_amdgcn_global_load_lds((const unsigned*)((const char*)(gbase) + ((voff)[_i] + (unsigned)(kb))), (LAS unsigned*)(lds + (bufoff) + ldsw + _i * 8192), 16, 0, 0); } while (0)
#define GM_LD8(addr) __builtin_shufflevector(*(const LAS v4i*)(addr), *(const LAS v4i*)((addr) + 1024), 0, 1, 2, 3, 4, 5, 6, 7)
#define GM_LDA(dst, b, h) do { _Pragma("unroll") for (int m = 0; m < 4; ++m) dst[m] = GM_LD8(lds + GM_SA(b, h) + aoff + m * 2048); } while (0)
#define GM_LDB(dst, b, h) do { _Pragma("unroll") for (int n = 0; n < 2; ++n) dst[n] = GM_LD8(lds + GM_SB(b, h) + boff + n * 2048); } while (0)
#define GM_LO(x) __builtin_bit_cast(bf16x8, __builtin_shufflevector(x, x, 0, 1, 2, 3))
#define GM_HI(x) __builtin_bit_cast(bf16x8, __builtin_shufflevector(x, x, 4, 5, 6, 7))
#define GM_MMA(ai, bj, At, Bt) do { __builtin_amdgcn_s_setprio(1); _Pragma("unroll") for (int m = 0; m < 4; ++m) _Pragma("unroll") for (int n = 0; n < 2; ++n) { \
        if (Prob::FP8)   \
            acc[ai][bj][m][n] = __builtin_amdgcn_mfma_scale_f32_16x16x128_f8f6f4(Bt[n], At[m], acc[ai][bj][m][n], 0, 0, 0, 0, 0, 0); \
        else { acc[ai][bj][m][n] = __builtin_amdgcn_mfma_f32_16x16x32_bf16(GM_LO(Bt[n]), GM_LO(At[m]), acc[ai][bj][m][n], 0, 0, 0); \
               acc[ai][bj][m][n] = __builtin_amdgcn_mfma_f32_16x16x32_bf16(GM_HI(Bt[n]), GM_HI(At[m]), acc[ai][bj][m][n], 0, 0, 0); } } \
        __builtin_amdgcn_s_setprio(0); } while (0)
#define GM_WAIT_V(n) asm volatile("s_waitcnt vmcnt(" #n ")" ::: "memory")
#define GM_WAIT_L(n) asm volatile("s_waitcnt lgkmcnt(" #n ")" ::: "memory")
#define GM_BAR __builtin_amdgcn_s_barrier()
#define GM_SCHED __builtin_amdgcn_sched_barrier(0)
    Unit cur, nxt; int ui = 0;
    if (!P.next(0, cur)) return;
    unsigned offC[2][2];
    P.a_off(cur, Rl, Cl, offC);
    f32x4 acc[2][2][4][2];
#pragma unroll
    for (int a = 0; a < 2; ++a)
#pragma unroll
        for (int b = 0; b < 2; ++b)
#pragma unroll
            for (int m = 0; m < 4; ++m)
#pragma unroll
                for (int n = 0; n < 2; ++n) acc[a][b][m][n] = (f32x4){0.f, 0.f, 0.f, 0.f};
    v8i At[4], B0[2], B1[2];
    typename Epi::Pre pre;
    const char* cA = cur.Ab; const char* cB = cur.Bb;
    const int ntm = nt - 1;
#define GM_KB(t_, r_) ((((t_) + (r_)) & ntm) << 7)
    { const int p0 = GM_KB(0, cur.rot), p1 = GM_KB(1, cur.rot);
    GM_STAGE(GM_SB(0, 0), cB, offB, p0); GM_STAGE(GM_SB(0, 1), cB + hB, offB, p0); GM_STAGE(GM_SA(0, 0), cA, offC[0], p0); GM_STAGE(GM_SA(0, 1), cA, offC[1], p0);
    if (wr == 1) GM_BAR;
    GM_WAIT_V(2); GM_BAR;
    GM_STAGE(GM_SB(1, 0), cB, offB, p1); GM_STAGE(GM_SA(1, 0), cA, offC[0], p1); GM_STAGE(GM_SB(1, 1), cB + hB, offB, p1); }
    GM_WAIT_V(6); GM_BAR;
    for (;;) {
        const bool has_next = P.next(ui + 1, nxt);
        unsigned offN[2][2] = {{0u, 0u}, {0u, 0u}};
        if (Prob::GATHER) { if (has_next) P.a_raw(nxt, Rl, offN); }
        const char* nA = has_next ? nxt.Ab : cA; const char* nB = has_next ? nxt.Bb : cB; const int rc = cur.rot, rn = has_next ? nxt.rot : rc;
        for (int t = 0; t < nt; t += 2) {
            const bool last = (t == nt - 2);
            if (Epi::HAS_PRE) { if (last) { unsigned l_; asm volatile("v_mbcnt_lo_u32_b32 %0, -1, 0\n\tv_mbcnt_hi_u32_b32 %0, -1, %0" : "=v"(l_)); E.pre_load(pre, cur, wr, wc, (int)(l_ & 15u), (int)(l_ >> 4)); } }
            const char* ab = last ? nA : cA; const char* bb = last ? nB : cB;
            const int k1 = GM_KB(t + 1, rc), k2 = last ? GM_KB(0, rn) : GM_KB(t + 2, rc), k3 = last ? GM_KB(1, rn) : GM_KB(t + 3, rc);
            GM_LDB(B0, 0, 0); GM_LDB(B1, 0, 1); GM_SCHED; GM_LDA(At, 0, 0); GM_STAGE(GM_SA(1, 1), cA, offC[1], k1);
            if (Prob::GATHER) { if (last && has_next) {
#pragma unroll
                for (int h = 0; h < 2; ++h)
#pragma unroll
                    for (int i = 0; i < 2; ++i) offC[h][i] = (offN[h][i] >> 2) * P.lda + (unsigned)Cl[i] * 2u; } }
            GM_WAIT_V(8); GM_WAIT_L(0); GM_BAR; GM_MMA(0, 0, At, B0); GM_MMA(0, 1, At, B1); GM_BAR; GM_SCHED;
            GM_LDA(At, 0, 1); GM_STAGE(GM_SB(0, 0), bb, offB, k2); GM_STAGE(GM_SB(0, 1), bb + hB, offB, k2); GM_STAGE(GM_SA(0, 0), ab, offC[0], k2);
            GM_WAIT_V(8); GM_WAIT_L(0); GM_BAR; GM_MMA(1, 0, At, B0); GM_MMA(1, 1, At, B1); GM_BAR; GM_SCHED;
            GM_LDB(B0, 1, 0); GM_LDB(B1, 1, 1); GM_SCHED; GM_LDA(At, 1, 0); GM_STAGE(GM_SA(0, 1), ab, offC[1], k2);
            GM_WAIT_V(8); GM_WAIT_L(0); GM_BAR; GM_MMA(0, 0, At, B0); GM_MMA(0, 1, At, B1); GM_BAR; GM_SCHED;
            GM_LDA(At, 1, 1); GM_STAGE(GM_SB(1, 0), bb, offB, k3); GM_STAGE(GM_SB(1, 1), bb + hB, offB, k3); GM_STAGE(GM_SA(1, 0), ab, offC[0], k3);
            GM_WAIT_V(8); GM_WAIT_L(0); GM_BAR; GM_MMA(1, 0, At, B0); GM_MMA(1, 1, At, B1); GM_BAR; GM_SCHED;
        }
        if (wr == 0) GM_BAR;
        { unsigned l_; asm volatile("v_mbcnt_lo_u32_b32 %0, -1, 0\n\tv_mbcnt_hi_u32_b32 %0, -1, %0" : "=v"(l_));
          E(acc, cur, wr, wc, (int)(l_ & 15u), (int)(l_ >> 4), pre); }
        if (!has_next) break;
#pragma unroll
        for (int a = 0; a < 2; ++a)
#pragma unroll
            for (int b = 0; b < 2; ++b)
#pragma unroll
                for (int m = 0; m < 4; ++m)
#pragma unroll
                    for (int n = 0; n < 2; ++n) acc[a][b][m][n] = (f32x4){0.f, 0.f, 0.f, 0.f};
        cur = nxt; cA = nA; cB = nB; ++ui;
        if (wr == 1) GM_BAR;
    }
    GM_WAIT_V(0);
    GM_BAR;
#undef GM_SA
#undef GM_KB
#undef GM_SB
#undef GM_STAGE
#undef GM_LDA
#undef GM_LDB
#undef GM_LD8
#undef GM_LO
#undef GM_HI
#undef GM_MMA
#undef GM_WAIT_V
#undef GM_WAIT_L
#undef GM_BAR
#undef GM_SCHED
}

template <bool FP8_> struct DenseProbT {
    static constexpr bool GATHER = false, FP8 = FP8_;
    __device__ __forceinline__ void a_raw(const Unit&, const int (&)[2], unsigned (&)[2][2]) const {}
    const char* A; const char* B; unsigned lda, ldb; int K, nM, nN, G, c;
    int a_col_per_pn;
    size_t b_per_pn;
    __device__ __forceinline__ bool next(int i, Unit& u) const {
        int pm, pn; if (!static_order(i, G, c, nM, nN, pm, pn)) return false;
        u.pm = pm; u.pn = pn; u.e = 0; u.aux = 0; u.rot = K_ROT ? pm + 2 * pn : 0; u.Ab = A + (size_t)pm * BM * lda + (size_t)pn * a_col_per_pn; u.Bb = B + (size_t)pn * b_per_pn; return true;
    }
    __device__ __forceinline__ void a_off(const Unit&, const int (&Rl)[2], const int (&Cl)[2], unsigned (&off)[2][2]) const {
#pragma unroll
        for (int h = 0; h < 2; ++h)
#pragma unroll
            for (int i = 0; i < 2; ++i) off[h][i] = (unsigned)(h * HALF + Rl[i]) * lda + (unsigned)Cl[i] * 2u;
    }
};
using DenseProb = DenseProbT<false>;
struct OneProb {
    static constexpr bool GATHER = false, FP8 = false;
    __device__ __forceinline__ void a_raw(const Unit&, const int (&)[2], unsigned (&)[2][2]) const {}
    const char* A; const char* B; unsigned lda, ldb; int K, pm, pn; size_t b_per_pn;
    __device__ __forceinline__ bool next(int i, Unit& u) const { if (i != 0) return false; u.pm = pm; u.pn = pn; u.e = 0; u.aux = 0; u.rot = 0; u.Ab = A + (size_t)pm * BM * lda; u.Bb = B + (size_t)pn * b_per_pn; return true; }
    __device__ __forceinline__ void a_off(const Unit&, const int (&Rl)[2], const int (&Cl)[2], unsigned (&off)[2][2]) const {
#pragma unroll
        for (int h = 0; h < 2; ++h)
#pragma unroll
            for (int i = 0; i < 2; ++i) off[h][i] = (unsigned)(h * HALF + Rl[i]) * lda + (unsigned)Cl[i] * 2u;
    }
};
struct MoeTab { LAS int* tstart; LAS int* cnt; LAS unsigned char* tile_e; int T; };
template <bool GATHER_> struct MoeProb {
    static constexpr bool GATHER = GATHER_, gather = GATHER_, FP8 = true;
    const char* A; const char* B; unsigned lda, ldb; int K, nN, G, c; MoeTab tb; const int* list; size_t b_per_e, b_per_pn;
#if PROBE_HOT == 2
    bool same = false;
#endif
    __device__ __forceinline__ bool next(int i, Unit& u) const {
        int pm, pn; if (!static_order(i, G, c, tb.T, nN, pm, pn)) return false;
        const int e = __builtin_amdgcn_readfirstlane((int)tb.tile_e[pm]);
        u.pm = pm; u.pn = pn; u.e = e; u.rot = K_ROT ? pm + 2 * pn : 0; u.aux = (pm - __builtin_amdgcn_readfirstlane(tb.tstart[e])) * BM;
        u.Ab = gather ? A : A + (size_t)pm * BM * lda; u.Bb = B + (size_t)e * b_per_e + (size_t)pn * b_per_pn;
#if PROBE_HOT == 2
        if (same) { u.Ab = A; u.Bb = B; }
#endif
        return true;
    }
    __device__ __forceinline__ void a_raw(const Unit& u, const int (&Rl)[2], unsigned (&raw)[2][2]) const {
        const int n = __builtin_amdgcn_readfirstlane(tb.cnt[u.e]);
#pragma unroll
        for (int h = 0; h < 2; ++h)
#pragma unroll
            for (int i = 0; i < 2; ++i) { const int p = u.aux + h * HALF + Rl[i]; raw[h][i] = (p < n) ? (unsigned)list[u.e * LIST_CAP + p] : 0u; }
    }
    __device__ __forceinline__ void a_off(const Unit& u, const int (&Rl)[2], const int (&Cl)[2], unsigned (&off)[2][2]) const {
        if (gather) {
            const int n = __builtin_amdgcn_readfirstlane(tb.cnt[u.e]);
#pragma unroll
            for (int h = 0; h < 2; ++h)
#pragma unroll
                for (int i = 0; i < 2; ++i) { const int p = u.aux + h * HALF + Rl[i]; int tok = 0; if (p < n) tok = list[u.e * LIST_CAP + p] >> 2; off[h][i] = (unsigned)tok * lda + (unsigned)Cl[i] * 2u; }
        } else {
#pragma unroll
            for (int h = 0; h < 2; ++h)
#pragma unroll
                for (int i = 0; i < 2; ++i) off[h][i] = (unsigned)(h * HALF + Rl[i]) * lda + (unsigned)Cl[i] * 2u;
        }
    }
};

struct EpiBf16 {
    struct Pre {}; static constexpr bool HAS_PRE = false; __device__ __forceinline__ void pre_load(Pre&, const Unit&, int, int, int, int) const {}
    bf16_t* O; int ldc; const float* bias; const float* cscale; int split_cols; size_t split_stride; float scale0; int col_per_pn; float mul;
    __device__ __forceinline__ void operator()(const f32x4 (&acc)[2][2][4][2], const Unit& u, int wr, int wc, int fr, int fq, const Pre&) const {
        const int row0 = u.pm * BM + wr * 64 + fr; int colt = u.pn * col_per_pn; bf16_t* base = O;
        float sc = mul; if (split_cols) { const int t = colt / split_cols; base += (size_t)t * split_stride; colt -= t * split_cols; if (t == 0) sc = scale0 * mul; }
        const int col0 = colt + wc * 32 + 8 * fq, bcol0 = u.pn * col_per_pn + wc * 32 + 8 * fq;
        f32x4 bv[2][2], sv[2][2];
#pragma unroll
        for (int bj = 0; bj < 2; ++bj)
#pragma unroll
            for (int n = 0; n < 2; ++n) { bv[bj][n] = bias ? *(const f32x4*)(bias + bcol0 + bj * HALF + 4 * n) : (f32x4){0.f, 0.f, 0.f, 0.f};
                                          sv[bj][n] = cscale ? *(const f32x4*)(cscale + bcol0 + bj * HALF + 4 * n) : (f32x4){1.f, 1.f, 1.f, 1.f}; }
#pragma unroll
        for (int ai = 0; ai < 2; ++ai)
#pragma unroll
            for (int m = 0; m < 4; ++m) { bf16_t* rowp = base + (size_t)(row0 + ai * HALF + m * 16) * ldc + col0;
#pragma unroll
                for (int bj = 0; bj < 2; ++bj) { f32x4 v0 = (acc[ai][bj][m][0] + bv[bj][0]) * sv[bj][0] * sc, v1 = (acc[ai][bj][m][1] + bv[bj][1]) * sv[bj][1] * sc;
                    u32x4 w; w.x = cvt_pk_bf16(v0[0], v0[1]); w.y = cvt_pk_bf16(v0[2], v0[3]); w.z = cvt_pk_bf16(v1[0], v1[1]); w.w = cvt_pk_bf16(v1[2], v1[3]);
                    st16(rowp + bj * HALF, w); } }
    }
};
struct EpiSwiglu {
    struct Pre { f32x4 bgl[2], bln[2]; }; static constexpr bool HAS_PRE = true;
    unsigned char* act; const float* bup;
#if PROBE_NOEPI
    bool skip = false;
#endif
    __device__ __forceinline__ void pre_load(Pre& p, const Unit& u, int, int wc, int, int fq) const {
        const float* bg = bup + (size_t)u.e * 2048 + u.pn * HALF + wc * 32 + 8 * fq;
#pragma unroll
        for (int n = 0; n < 2; ++n) { p.bgl[n] = *(const f32x4*)(bg + 4 * n); p.bln[n] = *(const f32x4*)(bg + 1024 + 4 * n); }
    }
    __device__ __forceinline__ void operator()(const f32x4 (&acc)[2][2][4][2], const Unit& u, int wr, int wc, int fr, int fq, const Pre& pr) const {
#if PROBE_NOEPI == 1
        if (skip) return;
#endif
        const int row0 = u.pm * BM + wr * 64 + fr, col0 = u.pn * HALF + wc * 32 + 8 * fq;
        const f32x4 (&bgl)[2] = pr.bgl; const f32x4 (&bln)[2] = pr.bln;
#pragma unroll
        for (int ai = 0; ai < 2; ++ai)
#pragma unroll
            for (int m = 0; m < 4; ++m) {
                float o[8];
#pragma unroll
                for (int n = 0; n < 2; ++n)
#pragma unroll
                    for (int jp = 0; jp < 2; ++jp) {
                        const f32x2 a0 = {acc[ai][0][m][n][2 * jp], acc[ai][0][m][n][2 * jp + 1]}, a1 = {acc[ai][1][m][n][2 * jp], acc[ai][1][m][n][2 * jp + 1]};
                        const f32x2 bg2 = {bgl[n][2 * jp], bgl[n][2 * jp + 1]}, bl2 = {bln[n][2 * jp], bln[n][2 * jp + 1]};
                        f32x2 g = a0 * 0.015625f + bg2, l = a1 * 0.015625f + bl2;
                        g.x = fminf(g.x, 7.0f); g.y = fminf(g.y, 7.0f); l.x = __builtin_amdgcn_fmed3f(l.x, -7.0f, 7.0f); l.y = __builtin_amdgcn_fmed3f(l.y, -7.0f, 7.0f);
                        const f32x2 t = g * (-1.702f * LOG2E);
                        f32x2 e; e.x = __builtin_amdgcn_exp2f(t.x); e.y = __builtin_amdgcn_exp2f(t.y);
                        const f32x2 d = e + 1.0f;
                        f32x2 r; r.x = __builtin_amdgcn_rcpf(d.x); r.y = __builtin_amdgcn_rcpf(d.y);
                        const f32x2 gr = g * r, oo = gr * l + gr;
                        o[n * 4 + 2 * jp] = oo.x; o[n * 4 + 2 * jp + 1] = oo.y;
                    }
                u32x2 w; w.x = cvt_pk4_fp8(o[0], o[1], o[2], o[3]); w.y = cvt_pk4_fp8(o[4], o[5], o[6], o[7]);
#if PROBE_NOEPI == 3
                if (skip) asm volatile("" :: "v"(w.x), "v"(w.y)); else
#endif
                st8(act + (size_t)(row0 + ai * HALF + m * 16) * D + col0, w);
            }
    }
};
struct EpiDown {
    struct Pre {}; static constexpr bool HAS_PRE = true;
    unsigned char* Y; const float* bdn; const float* gate; const int* list; MoeTab tb; LAS unsigned char* lds;
#if PROBE_NOEPI
    bool skip = false;
#endif
    __device__ __forceinline__ void pre_load(Pre&, const Unit& u, int wr, int wc, int fr, int fq) const {
        const int w = wr * 4 + wc, lane = fq * 16 + fr;
        const unsigned* src = (w < 4 ? (const unsigned*)list : (const unsigned*)gate) + (u.e * LIST_CAP + u.aux + (w & 3) * 64 + lane);
        __builtin_amdgcn_global_load_lds(src, (LAS unsigned*)(lds + M_PRE + w * 256), 4, 0, 0);
        if (w < 4) __builtin_amdgcn_global_load_lds((const unsigned*)(bdn + (size_t)u.e * D + u.pn * BM + w * 64 + lane), (LAS unsigned*)(lds + M_PRE + 2048 + w * 256), 4, 0, 0);
    }
    __device__ __forceinline__ void operator()(const f32x4 (&acc)[2][2][4][2], const Unit& u, int wr, int wc, int fr, int fq, const Pre&) const {
#if PROBE_NOEPI == 1
        if (skip) return;
#endif
        const int n = __builtin_amdgcn_readfirstlane(tb.cnt[u.e]);
        const int col0 = u.pn * BM + wc * 32 + 8 * fq;
        const LAS int* ps = (const LAS int*)(lds + M_PRE); const LAS float* pg = (const LAS float*)(lds + M_PRE + 1024); const LAS float* pb = (const LAS float*)(lds + M_PRE + 2048) + wc * 32 + 8 * fq;
        f32x4 bv[2][2];
#pragma unroll
        for (int bj = 0; bj < 2; ++bj)
#pragma unroll
            for (int nn = 0; nn < 2; ++nn) bv[bj][nn] = *(const LAS f32x4*)(pb + bj * HALF + 4 * nn);
#if Y_FP8 && EPI_STAGE
        { const int lane = fq * 16 + fr, w = wr * 4 + wc;
        unsigned char* ybase = Y + u.pn * BM + (lane & 15) * 16;
#pragma unroll
        for (int p = 0; p < 4; ++p) {
            const int ai = p >> 1, mh = p & 1;
            LAS unsigned char* stg = lds + ((p & 1) ? STG1 : STG0);
#pragma unroll
            for (int mm = 0; mm < 2; ++mm) { const int m = 2 * mh + mm, lr = wr * 32 + mm * 16 + fr;
                const float g16 = pg[ai * HALF + wr * 64 + m * 16 + fr] * 4.0f;
#pragma unroll
                for (int bj = 0; bj < 2; ++bj) { const f32x4 v0 = (acc[ai][bj][m][0] * 0.015625f + bv[bj][0]) * g16, v1 = (acc[ai][bj][m][1] * 0.015625f + bv[bj][1]) * g16;
                    u32x2 wv; wv.x = cvt_pk4_fp8(v0[0], v0[1], v0[2], v0[3]); wv.y = cvt_pk4_fp8(v1[0], v1[1], v1[2], v1[3]);
                    const int chunk = bj * 8 + wc * 2 + (fq >> 1);
                    *(LAS u32x2*)(stg + lr * 256 + ((chunk ^ (lr & 15)) << 4) + (fq & 1) * 8) = wv; } }
            LDS_WAIT(); __builtin_amdgcn_s_barrier();
#pragma unroll
            for (int k = 0; k < 2; ++k) { const int lr = k * 32 + w * 4 + (lane >> 4), j = lane & 15;
                const u32x4 v = *(const LAS u32x4*)(stg + lr * 256 + ((j ^ (lr & 15)) << 4));
                const int q = ai * HALF + (lr >> 5) * 64 + (2 * mh + ((lr >> 4) & 1)) * 16 + (lr & 15);
#if Y_SORTED
#if PROBE_NOEPI == 3
                const int sl = (!skip && u.aux + q < n) ? u.pm * BM + q : -1;
                if (skip) asm volatile("" :: "v"(v.x), "v"(v.y), "v"(v.z), "v"(v.w));
#else
                const int sl = (u.aux + q < n) ? u.pm * BM + q : -1;
#endif
#else
                const int sl = (u.aux + q < n) ? ps[q] : -1;
#endif
#if Y_SORTED
                if (sl >= 0) { unsigned char* dst = Y + ((size_t)(u.pm * 4 + u.pn) << 16) + q * 256 + (lane & 15) * 16;
                    if (STAGE_NT) st16nt(dst, v); else st16(dst, v); } }
#else
                if (sl >= 0) { if (STAGE_NT) st16nt(ybase + (size_t)sl * D, v); else st16(ybase + (size_t)sl * D, v); } }
#endif
        } }
#elif Y_FP8
#pragma unroll
        for (int ai = 0; ai < 2; ++ai) {
            float g16[4];
#pragma unroll
            for (int m = 0; m < 4; ++m) g16[m] = pg[ai * HALF + wr * 64 + m * 16 + fr] * 4.0f;
            const int q = ai * HALF + wr * 64 + fq * 16 + fr;
#if PROBE_NOEPI == 2
            const int sl = skip ? u.pm * BM + q : ((u.aux + q < n) ? ps[q] : -1);
#elif PROBE_NOEPI == 3
            const int sl = skip ? -1 : ((u.aux + q < n) ? ps[q] : -1);
#elif PROBE_NOEPI == 4
            const int sl = skip ? 65536 + (blockIdx.x * 8 + (q & 7)) : ((u.aux + q < n) ? ps[q] : -1);
#else
            const int sl = (u.aux + q < n) ? ps[q] : -1;
#endif
            unsigned W[2][4][2];
#pragma unroll
            for (int bj = 0; bj < 2; ++bj)
#pragma unroll
                for (int m = 0; m < 4; ++m) { const f32x4 v0 = (acc[ai][bj][m][0] * 0.015625f + bv[bj][0]) * g16[m], v1 = (acc[ai][bj][m][1] * 0.015625f + bv[bj][1]) * g16[m];
                    W[bj][m][0] = cvt_pk4_fp8(v0[0], v0[1], v0[2], v0[3]); W[bj][m][1] = cvt_pk4_fp8(v1[0], v1[1], v1[2], v1[3]); }
#pragma unroll
            for (int bj = 0; bj < 2; ++bj)
#pragma unroll
                for (int d = 0; d < 2; ++d) {
                    u32x2 r;
                    r = __builtin_amdgcn_permlane32_swap(W[bj][0][d], W[bj][2][d], false, false); W[bj][0][d] = r[0]; W[bj][2][d] = r[1];
                    r = __builtin_amdgcn_permlane32_swap(W[bj][1][d], W[bj][3][d], false, false); W[bj][1][d] = r[0]; W[bj][3][d] = r[1];
                    r = __builtin_amdgcn_permlane16_swap(W[bj][0][d], W[bj][1][d], false, false); W[bj][0][d] = r[0]; W[bj][1][d] = r[1];
                    r = __builtin_amdgcn_permlane16_swap(W[bj][2][d], W[bj][3][d], false, false); W[bj][2][d] = r[0]; W[bj][3][d] = r[1];
                }
#if PROBE_NOEPI == 5
            if (skip) {
                unsigned char* rp = Y + (size_t)(u.pm * 4 + u.pn) * 65536 + (wr * 4 + wc) * 8192 + ai * 4096 + (fq * 16 + fr) * 16;
#pragma unroll
                for (int bj = 0; bj < 2; ++bj) {
#if PROBE_NT5
                    st16nt(rp + bj * 2048, (u32x4){W[bj][0][0], W[bj][0][1], W[bj][1][0], W[bj][1][1]}); st16nt(rp + bj * 2048 + 1024, (u32x4){W[bj][2][0], W[bj][2][1], W[bj][3][0], W[bj][3][1]});
#else
                    st16(rp + bj * 2048, (u32x4){W[bj][0][0], W[bj][0][1], W[bj][1][0], W[bj][1][1]}); st16(rp + bj * 2048 + 1024, (u32x4){W[bj][2][0], W[bj][2][1], W[bj][3][0], W[bj][3][1]});
#endif
                }
            } else
#endif
            if (sl >= 0) {
                unsigned char* rowp = Y + (size_t)sl * D + u.pn * BM + wc * 32;
#pragma unroll
                for (int bj = 0; bj < 2; ++bj) {
                    if (NT_DOWN) { st16nt(rowp + bj * HALF, (u32x4){W[bj][0][0], W[bj][0][1], W[bj][1][0], W[bj][1][1]}); st16nt(rowp + bj * HALF + 16, (u32x4){W[bj][2][0], W[bj][2][1], W[bj][3][0], W[bj][3][1]}); }
                    else { st16(rowp + bj * HALF, (u32x4){W[bj][0][0], W[bj][0][1], W[bj][1][0], W[bj][1][1]}); st16(rowp + bj * HALF + 16, (u32x4){W[bj][2][0], W[bj][2][1], W[bj][3][0], W[bj][3][1]}); } }
            }
            asm volatile("" ::: "memory");
        }
#else
#pragma unroll
        for (int ai = 0; ai < 2; ++ai) {
            int slot[4]; float gt[4];
#pragma unroll
            for (int i = 0; i < 4; ++i) { const int q = ai * HALF + wr * 64 + i * 16 + fr; slot[i] = (u.aux + q < n) ? ps[q] : -1; gt[i] = pg[q]; }
#pragma unroll
            for (int m = 0; m < 4; ++m) {
                const int sl = slot[m];
                if (sl >= 0) {
                    bf16_t* rowp = (bf16_t*)Y + (size_t)sl * D + col0; const float g1 = gt[m];
#pragma unroll
                    for (int bj = 0; bj < 2; ++bj) { const f32x4 v0 = (acc[ai][bj][m][0] * 0.015625f + bv[bj][0]) * g1, v1 = (acc[ai][bj][m][1] * 0.015625f + bv[bj][1]) * g1;
                        u32x4 w; w.x = cvt_pk_bf16(v0[0], v0[1]); w.y = cvt_pk_bf16(v0[2], v0[3]); w.z = cvt_pk_bf16(v1[0], v1[1]); w.w = cvt_pk_bf16(v1[2], v1[3]);
                        st16(rowp + bj * HALF, w); }
                }
            }
            asm volatile("" ::: "memory");
        }
#endif
    }
};
}

struct Args {
    const float* x; const float* c; const float* ctx; const float* c_ctx; const float* ada_w; const float* ada_b; const float* norm_g;
    const float* w_qkv; const float* w_o; const float* rpb; const float* pool_w; const float* pool_b; const float* pool_scale;
    const float* w_router; const float* b_router; const float* w_up; const float* b_up; const float* w_down; const float* b_down;
    float* out; unsigned char* ws; int ph_lo, ph_hi;
};

struct Frame {
    LAS unsigned char* lds; int tid, lane, wave, G, vcu;
};

struct Row { f32x4 v[4]; };
typedef __amdgpu_buffer_rsrc_t rsrc_t;
__device__ __forceinline__ rsrc_t mk_rsrc(const void* p, unsigned bytes) { return __builtin_amdgcn_make_buffer_rsrc((void*)p, (short)0, (int)bytes, 0x00020000); }
__device__ __forceinline__ Row row_load_f32(rsrc_t rs, unsigned soff, int lane) { Row r;
#pragma unroll
    for (int j = 0; j < 4; ++j) r.v[j] = __builtin_bit_cast(f32x4, __builtin_amdgcn_raw_buffer_load_b128(rs, 16 * lane, soff + 1024 * j, 0));
    return r; }
__device__ __forceinline__ void row_load_bf16_raw(rsrc_t rs, unsigned soff, int lane, u32x2 (&w)[4]) {
#pragma unroll
    for (int j = 0; j < 4; ++j) w[j] = __builtin_bit_cast(u32x2, __builtin_amdgcn_raw_buffer_load_b64(rs, 8 * lane, soff + 512 * j, 0)); }
__device__ __forceinline__ Row row_unpack_bf16(const u32x2 (&w)[4]) { Row r;
#pragma unroll
    for (int j = 0; j < 4; ++j) r.v[j] = (f32x4){bf_lo(w[j].x), bf_hi(w[j].x), bf_lo(w[j].y), bf_hi(w[j].y)};
    return r; }
__device__ __forceinline__ Row row_load_bf16(rsrc_t rs, unsigned soff, int lane) { u32x2 w[4]; row_load_bf16_raw(rs, soff, lane, w); return row_unpack_bf16(w); }
__device__ __forceinline__ void row_store_f32(rsrc_t rs, unsigned soff, int lane, const Row& r) {
#pragma unroll
    for (int j = 0; j < 4; ++j) __builtin_amdgcn_raw_buffer_store_b128(__builtin_bit_cast(u32x4, r.v[j]), rs, 16 * lane, soff + 1024 * j, 0); }
__device__ __forceinline__ void row_store_bf16(rsrc_t rs, unsigned soff, int lane, const Row& r) {
#pragma unroll
    for (int j = 0; j < 4; ++j) { u32x2 w; w.x = cvt_pk_bf16(r.v[j][0], r.v[j][1]); w.y = cvt_pk_bf16(r.v[j][2], r.v[j][3]); __builtin_amdgcn_raw_buffer_store_b64(w, rs, 8 * lane, soff + 512 * j, 0); } }
__device__ __forceinline__ void row_store_fp8(rsrc_t rs, unsigned soff, int lane, const Row& r) {
#pragma unroll
    for (int j = 0; j < 4; ++j) __builtin_amdgcn_raw_buffer_store_b32(cvt_pk4_fp8_sat(r.v[j][0], r.v[j][1], r.v[j][2], r.v[j][3]), rs, 4 * lane, soff + 256 * j, 0); }
__device__ __forceinline__ float row_sumsq(const Row& r) { float s = 0.f;
#pragma unroll
    for (int j = 0; j < 4; ++j) s += (r.v[j][0] * r.v[j][0] + r.v[j][1] * r.v[j][1]) + (r.v[j][2] * r.v[j][2] + r.v[j][3] * r.v[j][3]);
    return wave_sum(s); }
__device__ __forceinline__ float rstd_of(float ss) { return 1.0f / sqrtf(ss * (1.0f / D) + RMS_EPS); }

__device__ __forceinline__ float silu_f(float v) { return v / (1.0f + __expf(-v)); }
__device__ __forceinline__ void p0_adaln(const Frame& F, const Args& a) {
    LAS f32x4* red = (LAS f32x4*)F.lds;
    float* mod = (float*)(a.ws + WS_MOD);
    for (int it = blockIdx.x; it < 256; it += F.G) {
        const int layer = it >> 7, cb = it & 127, cl = F.tid & 15, ks = F.tid >> 4;
        f32x4 a0 = {0.f, 0.f, 0.f, 0.f}, a1 = {0.f, 0.f, 0.f, 0.f};
        if (cl < 12) {
            const float* wp = a.ada_w + ((size_t)layer * D + ks * 32) * 6144 + cb * 48 + cl * 4;
#pragma unroll 8
            for (int kk = 0; kk < 32; ++kk) { const f32x4 w = *(const f32x4*)(wp + (size_t)kk * 6144); const float s0 = silu_f(a.c[ks * 32 + kk]), s1 = silu_f(a.c_ctx[ks * 32 + kk]); a0 += w * s0; a1 += w * s1; }
        }
        red[ks * 16 + cl] = a0; red[512 + ks * 16 + cl] = a1;
        __syncthreads();
        if (F.tid < 32) { const int which = F.tid >> 4, c4 = F.tid & 15;
            if (c4 < 12) { f32x4 s = {0.f, 0.f, 0.f, 0.f};
                for (int k2 = 0; k2 < 32; ++k2) s += red[which * 512 + k2 * 16 + c4];
                const int col = cb * 48 + c4 * 4; s += *(const f32x4*)(a.ada_b + layer * 6144 + col);
                if (which == 0) *(f32x4*)(mod + (layer == 0 ? 0 : 2) * 6144 + col) = s;
                else if (layer == 0) *(f32x4*)(mod + 6144 + col) = s; } }
        __syncthreads();
    }
}
struct TItem { const float* src; bf16_t* dst; int N, ldwt; };
__device__ __forceinline__ void titem_load(const TItem& t, f32x4 (&v)[16], int lane) {
    const float* src = t.src + (size_t)(lane >> 4) * t.N + 4 * (lane & 15);
#pragma unroll
    for (int i = 0; i < 16; ++i) v[i] = __builtin_nontemporal_load((const f32x4*)(src + (size_t)(4 * i) * t.N));
}
__device__ __forceinline__ void titem_finish(const TItem& t, const f32x4 (&v)[16], LAS float* scr, int lane) {
    const int lk = lane >> 4, n4 = lane & 15;
#pragma unroll
    for (int i = 0; i < 16; ++i) { const int k = 4 * i + lk; *(LAS f32x4*)(scr + k * 64 + ((4 * n4) ^ (4 * (k >> 3)))) = v[i]; }
    LDS_WAIT(); asm volatile("" ::: "memory");
    const int c = lane & 7;
#pragma unroll
    for (int j = 0; j < 8; ++j) { const int n = (lane >> 3) + 8 * j; const LAS float* sp = scr + (8 * c) * 64 + (n ^ (4 * c));
        u32x4 o; o.x = cvt_pk_bf16(sp[0 * 64], sp[1 * 64]); o.y = cvt_pk_bf16(sp[2 * 64], sp[3 * 64]); o.z = cvt_pk_bf16(sp[4 * 64], sp[5 * 64]); o.w = cvt_pk_bf16(sp[6 * 64], sp[7 * 64]);
        *(u32x4*)(t.dst + (size_t)n * t.ldwt + 8 * c) = o; }
    LDS_WAIT(); asm volatile("" ::: "memory");
}
struct TItem8 { const float* src; unsigned char* dst; int N, ldwt; };
__device__ __forceinline__ void titem8_load(const TItem8& t, f32x4 (&v)[16], int lane) {
    const float* src = t.src + (size_t)(lane >> 3) * t.N + 4 * (lane & 7);
#pragma unroll
    for (int i = 0; i < 16; ++i) v[i] = __builtin_nontemporal_load((const f32x4*)(src + (size_t)(8 * i) * t.N));
}
__device__ __forceinline__ void titem8_finish(const TItem8& t, const f32x4 (&v)[16], LAS float* scr, int lane) {
    const int lk = lane >> 3, n4 = lane & 7;
#pragma unroll
    for (int i = 0; i < 16; ++i) { const int k = 8 * i + lk; *(LAS f32x4*)(scr + k * 32 + ((n4 ^ ((k >> 4) & 7)) << 2)) = v[i] * 64.0f; }
    LDS_WAIT(); asm volatile("" ::: "memory");
    const int c = lane & 7;
#pragma unroll
    for (int j = 0; j < 4; ++j) { const int n = (lane >> 3) + 8 * j; const LAS float* sp = scr + (16 * c) * 32 + ((((n >> 2) ^ c) << 2) | (n & 3));
        u32x4 o; o.x = cvt_pk4_fp8(sp[0 * 32], sp[1 * 32], sp[2 * 32], sp[3 * 32]); o.y = cvt_pk4_fp8(sp[4 * 32], sp[5 * 32], sp[6 * 32], sp[7 * 32]);
        o.z = cvt_pk4_fp8(sp[8 * 32], sp[9 * 32], sp[10 * 32], sp[11 * 32]); o.w = cvt_pk4_fp8(sp[12 * 32], sp[13 * 32], sp[14 * 32], sp[15 * 32]);
        __builtin_nontemporal_store(o, (u32x4*)(t.dst + (size_t)n * t.ldwt + 16 * c)); }
    LDS_WAIT(); asm volatile("" ::: "memory");
}
__device__ __forceinline__ void transpose_item(const float* W, int N, bf16_t* WT, int ldwt, int k0, int n0, int drow0, LAS float* scr, int lane) {
    const TItem t{W + (size_t)k0 * N + n0, WT + (size_t)drow0 * ldwt + k0, N, ldwt};
    f32x4 v[16]; titem_load(t, v, lane); titem_finish(t, v, scr, lane);
}
__device__ __forceinline__ void p0_router_weights(const Frame& F, const Args& a) {
    bf16_t* wrt = (bf16_t*)(a.ws + WS_WRT);
    for (int i = blockIdx.x * NT + F.tid; i < 2 * NE * D; i += F.G * NT) { const int l = i / (NE * D), r = i % (NE * D), e = r / D, k = r % D;
        const float w = a.w_router[((size_t)l * D + k) * NE + e]; const unsigned hb = cvt_pk_bf16(w, 0.f) & 0xffffu; const float lo = w - __uint_as_float(hb << 16);
        wrt[((size_t)(l * 2 + 0) * NE + e) * D + k] = (bf16_t)hb; wrt[((size_t)(l * 2 + 1) * NE + e) * D + k] = (bf16_t)(cvt_pk_bf16(lo, 0.f) & 0xffffu); }
}
__device__ __forceinline__ void p0_convert_small(const Frame& F, const Args& a) {
    LAS float* scr = (LAS float*)(F.lds + F.wave * 16384);
    const int gw = F.vcu * NWAVES + F.wave, NGW = F.G * NWAVES;
    constexpr int I_QKV = 16 * 48, I_O = 16 * 16, I_POOL = 4 * 4 * 4, NITEMS = I_QKV + I_O + I_POOL;
    bf16_t* wqkv = (bf16_t*)(a.ws + WS_WQKV); bf16_t* wo = (bf16_t*)(a.ws + WS_WO); bf16_t* wpool = (bf16_t*)(a.ws + WS_WPOOL);
    for (int it = gw; it < NITEMS; it += NGW) {
        int r = it;
#if QKV_FP8
        if (r < I_QKV) { const int kb = r / 96, nb = r % 96; const TItem8 t{a.w_qkv + (size_t)(kb * 128) * 3072 + nb * 32, (unsigned char*)wqkv + (size_t)(nb * 32) * 1024 + kb * 128, 3072, 1024};
            f32x4 v[16]; titem8_load(t, v, F.lane); titem8_finish(t, v, scr, F.lane); continue; } r -= I_QKV;
#else
        if (r < I_QKV) { const int kb = r / 48, nb = r % 48; transpose_item(a.w_qkv, 3072, wqkv, 1024, kb * 64, nb * 64, nb * 64, scr, F.lane); continue; } r -= I_QKV;
#endif
        if (r < I_O) { const int kb = r / 16, nb = r % 16; transpose_item(a.w_o, 1024, wo, 1024, kb * 64, nb * 64, nb * 64, scr, F.lane); continue; } r -= I_O;
        { const int g = r / 16, q = r % 16, kb = q / 4, nb = q % 4; transpose_item(a.pool_w + (size_t)g * 65536, 256, wpool + (size_t)g * 65536, 256, kb * 64, nb * 64, nb * 64, scr, F.lane); }
    }
}
constexpr int CV_UP1 = 16 * 32, CV_UP = 32 * CV_UP1, CV_DN1 = 16 * 16, CV_DN = 32 * CV_DN1, CV_ITEMS = CV_UP + CV_DN, CV_CHUNK = 8, CV_NCHUNK = CV_ITEMS / CV_CHUNK;
__device__ __forceinline__ TItem8 cv_item(const Args& a, int layer, int r) {
    unsigned char* wup = a.ws + WS_WUP + (size_t)layer * 32 * 2048 * 1024; unsigned char* wdn = a.ws + WS_WDN + (size_t)layer * 32 * 1024 * 1024;
    const float* sup = a.w_up + (size_t)layer * 32 * 1024 * 2048; const float* sdn = a.w_down + (size_t)layer * 32 * 1024 * 1024;
    if (r < CV_UP) { const int mat = r / CV_UP1, q = r % CV_UP1, kb = q / 64, nb = q % 64, n0 = nb * 32;
        const int drow = (n0 < 1024) ? ((n0 >> 7) * 256 + (n0 & 127)) : (((n0 - 1024) >> 7) * 256 + 128 + ((n0 - 1024) & 127));
        return TItem8{sup + (size_t)mat * 1024 * 2048 + (size_t)(kb * 128) * 2048 + n0, wup + (size_t)mat * 2048 * 1024 + (size_t)drow * 1024 + kb * 128, 2048, 1024}; }
    r -= CV_UP; const int mat = r / CV_DN1, q = r % CV_DN1, kb = q / 32, nb = q % 32;
    return TItem8{sdn + (size_t)mat * 1024 * 1024 + (size_t)(kb * 128) * 1024 + nb * 32, wdn + (size_t)mat * 1024 * 1024 + (size_t)(nb * 32) * 1024 + kb * 128, 1024, 1024};
}
__device__ __forceinline__ void bg_convert(const Frame& F, const Args& a, int layer, int phase, unsigned Gf, bool fg) {
    unsigned* ctl = (unsigned*)(a.ws + WS_CTL); unsigned* q = ctl + CW_Q + 64 * layer; unsigned* done = ctl + CW_DONE + 64 * phase;
    volatile LAS unsigned* sh = (volatile LAS unsigned*)(F.lds + MISC_OFF + 64);
    LAS float* scr = (LAS float*)(F.lds + F.wave * 16384);
    const unsigned NC = (unsigned)CV_NCHUNK;
    __syncthreads();
    if (fg && F.tid == 0) __hip_atomic_fetch_add(done, 1u, __ATOMIC_RELAXED, __HIP_MEMORY_SCOPE_AGENT);
    unsigned ia = NC, ib = NC, dn = 0u;
    if (F.tid == 0) { if (Gf != 0u) dn = __hip_atomic_load(done, __ATOMIC_RELAXED, __HIP_MEMORY_SCOPE_AGENT);
        if (Gf == 0u || dn < Gf) { ia = __hip_atomic_fetch_add(q, 1u, __ATOMIC_RELAXED, __HIP_MEMORY_SCOPE_AGENT); ib = __hip_atomic_fetch_add(q, 1u, __ATOMIC_RELAXED, __HIP_MEMORY_SCOPE_AGENT); }
        sh[0] = ia; sh[1] = ib; }
    __syncthreads();
    unsigned c0 = sh[0], c1 = sh[1];
    __syncthreads();
    if (c0 >= NC) return;
    f32x4 va[16], vb[16];
    TItem8 ta = cv_item(a, layer, (int)c0 * CV_CHUNK + F.wave), tb = ta;
    titem8_load(ta, va, F.lane);
    for (;;) {
        if (c1 < NC) { tb = cv_item(a, layer, (int)c1 * CV_CHUNK + F.wave); titem8_load(tb, vb, F.lane); }
        unsigned nx = NC;
        if (F.tid == 0) { const bool stop = (Gf != 0u) && (dn >= Gf); if (!stop) nx = __hip_atomic_fetch_add(q, 1u, __ATOMIC_RELAXED, __HIP_MEMORY_SCOPE_AGENT);
            if (Gf != 0u) dn = __hip_atomic_load(done, __ATOMIC_RELAXED, __HIP_MEMORY_SCOPE_AGENT); }
        titem8_finish(ta, va, scr, F.lane);
        if (c1 >= NC) break;
        if (F.tid == 0) sh[0] = nx;
        __syncthreads();
        c0 = sh[0];
        __syncthreads();
        if (c0 < NC) { ta = cv_item(a, layer, (int)c0 * CV_CHUNK + F.wave); titem8_load(ta, va, F.lane); }
        nx = NC;
        if (F.tid == 0) { const bool stop = (Gf != 0u) && (dn >= Gf); if (!stop) nx = __hip_atomic_fetch_add(q, 1u, __ATOMIC_RELAXED, __HIP_MEMORY_SCOPE_AGENT);
            if (Gf != 0u) dn = __hip_atomic_load(done, __ATOMIC_RELAXED, __HIP_MEMORY_SCOPE_AGENT); }
        titem8_finish(tb, vb, scr, F.lane);
        if (c0 >= NC) break;
        if (F.tid == 0) sh[0] = nx;
        __syncthreads();
        c1 = sh[0];
        __syncthreads();
    }
    __syncthreads();
}

template <bool OUT8 = false>
__device__ __forceinline__ void modulate_rows(const Frame& F, const float* x, int nrows, const float* g, const float* shift, const float* scale, void* out, int gw, int NGW) {
    const int lane = F.lane;
    const rsrc_t rx = mk_rsrc(x, (unsigned)nrows * D * 4), ro = mk_rsrc(out, (unsigned)nrows * D * (OUT8 ? 1 : 2));
    Row gs = row_load_f32(mk_rsrc(g, D * 4), 0, lane), sh = row_load_f32(mk_rsrc(shift, D * 4), 0, lane); { const Row sc = row_load_f32(mk_rsrc(scale, D * 4), 0, lane);
#pragma unroll
        for (int j = 0; j < 4; ++j) gs.v[j] = gs.v[j] * (sc.v[j] + 1.0f); }
    for (int m = gw; m < nrows; m += NGW) {
        Row r = row_load_f32(rx, (unsigned)m * D * 4, lane);
        const float rs = rstd_of(row_sumsq(r));
#pragma unroll
        for (int j = 0; j < 4; ++j) r.v[j] = r.v[j] * rs * gs.v[j] + sh.v[j];
        if (OUT8) row_store_fp8(ro, (unsigned)m * D, lane, r); else row_store_bf16(ro, (unsigned)m * D * 2, lane, r);
    }
}

namespace na {
constexpr int LDS_CK = 0, LDS_CV = 32768, LDS_RING = 65536, SLOT = 16384, LDS_BIAS = LDS_RING + 3 * SLOT;
__device__ __forceinline__ unsigned kaddr(int key, int c) { return (unsigned)(key * 128 + ((c ^ ((key >> 1) & 7)) << 4)); }
__device__ __forceinline__ s16x4 vtr(const LAS unsigned char* p) { typedef short v4i16_t __attribute__((ext_vector_type(4)));
    return __builtin_bit_cast(s16x4, __builtin_amdgcn_ds_read_tr16_b64_v4i16((LAS v4i16_t*)p)); }

template <bool LOCAL>
__device__ __forceinline__ void tile(const LAS unsigned char* kimg, int key0, const LAS unsigned char* vimg, int vstride, const bf16x8 (&qf)[2], float& m, float& l, f32x4 (&o)[4],
                                     const LAS float* brow, unsigned valid, int lane) {
    const int fr = lane & 15, fq = lane >> 4;
    f32x4 s[2];
#pragma unroll
    for (int kb = 0; kb < 2; ++kb) {
        const int key = key0 + kb * 16 + fr;
        const bf16x8 k0 = *(const LAS bf16x8*)(kimg + kaddr(key, fq)), k1 = *(const LAS bf16x8*)(kimg + kaddr(key, 4 + fq));
        s[kb] = __builtin_amdgcn_mfma_f32_16x16x32_bf16(k0, qf[0], (f32x4){0.f, 0.f, 0.f, 0.f}, 0, 0, 0);
        s[kb] = __builtin_amdgcn_mfma_f32_16x16x32_bf16(k1, qf[1], s[kb], 0, 0, 0);
    }
    if (LOCAL) {
#pragma unroll
        for (int kb = 0; kb < 2; ++kb)
#pragma unroll
            for (int r = 0; r < 4; ++r) { const float b = brow[kb * 16 + r]; s[kb][r] = ((valid >> (kb * 4 + r)) & 1u) ? s[kb][r] + b : -1e30f; }
    }
    float mt = fmaxf(fmaxf(fmaxf(s[0][0], s[0][1]), fmaxf(s[0][2], s[0][3])), fmaxf(fmaxf(s[1][0], s[1][1]), fmaxf(s[1][2], s[1][3])));
    mt = fmaxf(mt, __shfl_xor(mt, 16)); mt = fmaxf(mt, __shfl_xor(mt, 32));
    const float mn = fmaxf(m, mt), alpha = __builtin_amdgcn_exp2f(m - mn);
    m = mn;
    float p[8]; float ps = 0.f;
#pragma unroll
    for (int kb = 0; kb < 2; ++kb)
#pragma unroll
        for (int r = 0; r < 4; ++r) { p[kb * 4 + r] = __builtin_amdgcn_exp2f(s[kb][r] - mn); ps += p[kb * 4 + r]; }
    l = l * alpha + ps;
    u32x4 pw; pw.x = cvt_pk_bf16(p[0], p[1]); pw.y = cvt_pk_bf16(p[2], p[3]); pw.z = cvt_pk_bf16(p[4], p[5]); pw.w = cvt_pk_bf16(p[6], p[7]);
    const bf16x8 pb = __builtin_bit_cast(bf16x8, pw);
    const int q = fr >> 2, pp = fr & 3;
#pragma unroll
    for (int db = 0; db < 4; ++db) {
        const LAS unsigned char* vb = vimg + db * vstride + (key0 + 4 * fq + q) * 32 + pp * 8;
        const s16x4 lo = vtr(vb), hi = vtr(vb + 16 * 32);
        const bf16x8 vf = (bf16x8){lo[0], lo[1], lo[2], lo[3], hi[0], hi[1], hi[2], hi[3]};
        o[db] = o[db] * alpha;
        o[db] = __builtin_amdgcn_mfma_f32_16x16x32_bf16(vf, pb, o[db], 0, 0, 0);
    }
}

__device__ __forceinline__ void tile2(const LAS unsigned char* kloc, int key0, const LAS unsigned char* vloc, const LAS unsigned char* kctx, int ckey0, const LAS unsigned char* vctx,
                                      const bf16x8 (&qf)[2], float& m, f32x4& l, f32x4 (&o)[4], const LAS float* brow, unsigned valid, int lane) {
    const int fr = lane & 15, fq = lane >> 4;
    f32x4 s[4];
#pragma unroll
    for (int kb = 0; kb < 2; ++kb) {
        const int key = key0 + kb * 16 + fr, ck = ckey0 + kb * 16 + fr;
        const bf16x8 k0 = *(const LAS bf16x8*)(kloc + kaddr(key, fq)), k1 = *(const LAS bf16x8*)(kloc + kaddr(key, 4 + fq));
        const bf16x8 c0 = *(const LAS bf16x8*)(kctx + kaddr(ck, fq)), c1 = *(const LAS bf16x8*)(kctx + kaddr(ck, 4 + fq));
        s[kb] = __builtin_amdgcn_mfma_f32_16x16x32_bf16(k0, qf[0], (f32x4){0.f, 0.f, 0.f, 0.f}, 0, 0, 0);
        s[kb] = __builtin_amdgcn_mfma_f32_16x16x32_bf16(k1, qf[1], s[kb], 0, 0, 0);
        s[2 + kb] = __builtin_amdgcn_mfma_f32_16x16x32_bf16(c0, qf[0], (f32x4){0.f, 0.f, 0.f, 0.f}, 0, 0, 0);
        s[2 + kb] = __builtin_amdgcn_mfma_f32_16x16x32_bf16(c1, qf[1], s[2 + kb], 0, 0, 0);
    }
#pragma unroll
    for (int kb = 0; kb < 2; ++kb)
#pragma unroll
        for (int r = 0; r < 4; ++r) { const float b = brow[kb * 16 + r]; s[kb][r] = ((valid >> (kb * 4 + r)) & 1u) ? s[kb][r] + b : -1e30f; }
    float mt = fmaxf(fmaxf(fmaxf(s[0][0], s[0][1]), fmaxf(s[0][2], s[0][3])), fmaxf(fmaxf(s[1][0], s[1][1]), fmaxf(s[1][2], s[1][3])));
    mt = fmaxf(mt, fmaxf(fmaxf(fmaxf(s[2][0], s[2][1]), fmaxf(s[2][2], s[2][3])), fmaxf(fmaxf(s[3][0], s[3][1]), fmaxf(s[3][2], s[3][3]))));
    mt = fmaxf(mt, __shfl_xor(mt, 16)); mt = fmaxf(mt, __shfl_xor(mt, 32));
    if (__builtin_amdgcn_ballot_w64(mt > m + 8.0f) != 0ull) {
        const float mn = fmaxf(m, mt), alpha = __builtin_amdgcn_exp2f(m - mn);
        m = mn; l = l * alpha;
#pragma unroll
        for (int db = 0; db < 4; ++db) o[db] = o[db] * alpha;
    }
    float p[16];
#pragma unroll
    for (int t = 0; t < 4; ++t)
#pragma unroll
        for (int r = 0; r < 4; ++r) p[t * 4 + r] = __builtin_amdgcn_exp2f(s[t][r] - m);
    u32x4 pw; pw.x = cvt_pk_bf16(p[0], p[1]); pw.y = cvt_pk_bf16(p[2], p[3]); pw.z = cvt_pk_bf16(p[4], p[5]); pw.w = cvt_pk_bf16(p[6], p[7]);
    u32x4 pc; pc.x = cvt_pk_bf16(p[8], p[9]); pc.y = cvt_pk_bf16(p[10], p[11]); pc.z = cvt_pk_bf16(p[12], p[13]); pc.w = cvt_pk_bf16(p[14], p[15]);
    const bf16x8 pb = __builtin_bit_cast(bf16x8, pw), pcb = __builtin_bit_cast(bf16x8, pc);
    { const bf16x8 ones = (bf16x8){0x3F80, 0x3F80, 0x3F80, 0x3F80, 0x3F80, 0x3F80, 0x3F80, 0x3F80};
      l = __builtin_amdgcn_mfma_f32_16x16x32_bf16(ones, pb, l, 0, 0, 0); l = __builtin_amdgcn_mfma_f32_16x16x32_bf16(ones, pcb, l, 0, 0, 0); }
    const int q = fr >> 2, pp = fr & 3;
#pragma unroll
    for (int db = 0; db < 4; ++db) {
        const LAS unsigned char* vb = vloc + db * (64 * 32) + (key0 + 4 * fq + q) * 32 + pp * 8;
        const LAS unsigned char* vc = vctx + db * (256 * 32) + (ckey0 + 4 * fq + q) * 32 + pp * 8;
        const s16x4 lo = vtr(vb), hi = vtr(vb + 16 * 32), clo = vtr(vc), chi = vtr(vc + 16 * 32);
        const bf16x8 vf = (bf16x8){lo[0], lo[1], lo[2], lo[3], hi[0], hi[1], hi[2], hi[3]}, cf = (bf16x8){clo[0], clo[1], clo[2], clo[3], chi[0], chi[1], chi[2], chi[3]};
        o[db] = __builtin_amdgcn_mfma_f32_16x16x32_bf16(vf, pb, o[db], 0, 0, 0);
        o[db] = __builtin_amdgcn_mfma_f32_16x16x32_bf16(cf, pcb, o[db], 0, 0, 0);
    }
}

struct BandSel { unsigned fm[4]; int boff[4]; unsigned pm01, pm23; };
__device__ __forceinline__ void tile3(const LAS unsigned char* kloc, int key0, const LAS unsigned char* vloc, const LAS unsigned char* kctx, int ckey0, const LAS unsigned char* vctx,
                                      const bf16x8 (&qf)[2], float& m, f32x4& l, f32x4 (&o)[4], const LAS float* brow, const BandSel& bs, int lane, bool first) {
    const int fr = lane & 15, fq = lane >> 4;
    f32x4 s[4];
#pragma unroll
    for (int kb = 0; kb < 2; ++kb) {
        const int key = key0 + kb * 16 + fr, ck = ckey0 + kb * 16 + fr;
        const bf16x8 k0 = *(const LAS bf16x8*)(kloc + kaddr(key, fq)), k1 = *(const LAS bf16x8*)(kloc + kaddr(key, 4 + fq));
        const bf16x8 c0 = *(const LAS bf16x8*)(kctx + kaddr(ck, fq)), c1 = *(const LAS bf16x8*)(kctx + kaddr(ck, 4 + fq));
        s[kb] = __builtin_amdgcn_mfma_f32_16x16x32_bf16(k0, qf[0], (f32x4){0.f, 0.f, 0.f, 0.f}, 0, 0, 0);
        s[kb] = __builtin_amdgcn_mfma_f32_16x16x32_bf16(k1, qf[1], s[kb], 0, 0, 0);
        s[2 + kb] = __builtin_amdgcn_mfma_f32_16x16x32_bf16(c0, qf[0], (f32x4){0.f, 0.f, 0.f, 0.f}, 0, 0, 0);
        s[2 + kb] = __builtin_amdgcn_mfma_f32_16x16x32_bf16(c1, qf[1], s[2 + kb], 0, 0, 0);
    }
    float sl[4];
#pragma unroll
    for (int r = 0; r < 4; ++r) { const unsigned a_ = __float_as_uint(s[0][r]), b_ = __float_as_uint(s[1][r]); sl[r] = __uint_as_float((a_ & bs.fm[r]) | (b_ & ~bs.fm[r])) + brow[bs.boff[r]]; }
    if (first) {
        float mt = fmaxf(fmaxf(sl[0], sl[1]), fmaxf(sl[2], sl[3]));
        mt = fmaxf(mt, fmaxf(fmaxf(fmaxf(s[2][0], s[2][1]), fmaxf(s[2][2], s[2][3])), fmaxf(fmaxf(s[3][0], s[3][1]), fmaxf(s[3][2], s[3][3]))));
        mt = fmaxf(mt, __shfl_xor(mt, 16)); mt = fmaxf(mt, __shfl_xor(mt, 32));
        m = mt;
    }
    float pl[4], pcx[8];
#pragma unroll
    for (int r = 0; r < 4; ++r) pl[r] = __builtin_amdgcn_exp2f(sl[r] - m);
#pragma unroll
    for (int t = 0; t < 2; ++t)
#pragma unroll
        for (int r = 0; r < 4; ++r) pcx[t * 4 + r] = __builtin_amdgcn_exp2f(s[2 + t][r] - m);
    const unsigned pk01 = cvt_pk_bf16(pl[0], pl[1]), pk23 = cvt_pk_bf16(pl[2], pl[3]);
    u32x4 pw; pw.x = pk01 & bs.pm01; pw.y = pk23 & bs.pm23; pw.z = pk01 & ~bs.pm01; pw.w = pk23 & ~bs.pm23;
    u32x4 pc; pc.x = cvt_pk_bf16(pcx[0], pcx[1]); pc.y = cvt_pk_bf16(pcx[2], pcx[3]); pc.z = cvt_pk_bf16(pcx[4], pcx[5]); pc.w = cvt_pk_bf16(pcx[6], pcx[7]);
    const bf16x8 pb = __builtin_bit_cast(bf16x8, pw), pcb = __builtin_bit_cast(bf16x8, pc);
    { const bf16x8 ones = (bf16x8){0x3F80, 0x3F80, 0x3F80, 0x3F80, 0x3F80, 0x3F80, 0x3F80, 0x3F80};
      l = __builtin_amdgcn_mfma_f32_16x16x32_bf16(ones, pb, l, 0, 0, 0); l = __builtin_amdgcn_mfma_f32_16x16x32_bf16(ones, pcb, l, 0, 0, 0); }
    const int q = fr >> 2, pp = fr & 3;
#pragma unroll
    for (int db = 0; db < 4; ++db) {
        const LAS unsigned char* vb = vloc + db * (64 * 32) + (key0 + 4 * fq + q) * 32 + pp * 8;
        const LAS unsigned char* vc = vctx + db * (256 * 32) + (ckey0 + 4 * fq + q) * 32 + pp * 8;
        const s16x4 lo = vtr(vb), hi = vtr(vb + 16 * 32), clo = vtr(vc), chi = vtr(vc + 16 * 32);
        const bf16x8 vf = (bf16x8){lo[0], lo[1], lo[2], lo[3], hi[0], hi[1], hi[2], hi[3]}, cf = (bf16x8){clo[0], clo[1], clo[2], clo[3], chi[0], chi[1], chi[2], chi[3]};
        o[db] = __builtin_amdgcn_mfma_f32_16x16x32_bf16(vf, pb, o[db], 0, 0, 0);
        o[db] = __builtin_amdgcn_mfma_f32_16x16x32_bf16(cf, pcb, o[db], 0, 0, 0);
    }
}

__device__ __forceinline__ void attn_unit(const Frame& F, const Args& a, int h, int rlo, int rhi, bool border) {
    const bf16_t* Q = (const bf16_t*)(a.ws + WS_Q); const bf16_t* Kg = (const bf16_t*)(a.ws + WS_K); const bf16_t* Vg = (const bf16_t*)(a.ws + WS_V); bf16_t* O = (bf16_t*)(a.ws + WS_O);
    const int tid = F.tid, lane = F.lane, wid = F.wave, fr = lane & 15, fq = lane >> 4, g = wid & 3;
    LAS unsigned char* lds = F.lds;
    LAS float* bias = (LAS float*)(lds + LDS_BIAS) + 32;
    const int kb = border ? (rlo < 128 ? 0 : 248) : rlo - 4, ke = border ? kb + 7 : rhi + 3;
    int row0[4], ws0[4], nj[4];
#pragma unroll
    for (int j = 0; j < 4; ++j) { const int s = (wid >> 2) + 2 * j;
        if (border) { row0[j] = rlo + s; ws0[j] = kb; nj[j] = (s < 4) ? 1 : 0; }
        else { const int rA = rlo + ((s - rlo) & 7); row0[j] = rA; ws0[j] = rA - 4; nj[j] = (rA > rhi) ? 0 : ((rhi - rA) >> 3) + 1; } }
    const int sg = (g == 0) ? 0 : (g == 1) ? 8 : (g == 2) ? 24 : 32;
    const int cq = 16 * g + fr, c0 = min(max(cq - 8, 0), 48);
    const int dc0 = sg + 4 * fq - cq + 15;
    BandSel bs;
    { const int lo = c0 - sg; bool v0[4];
#pragma unroll
      for (int r = 0; r < 4; ++r) { v0[r] = (4 * fq + r) >= lo; bs.fm[r] = v0[r] ? 0xFFFFFFFFu : 0u; bs.boff[r] = r + (v0[r] ? 0 : 16); }
      bs.pm01 = (v0[0] ? 0xFFFFu : 0u) | (v0[1] ? 0xFFFF0000u : 0u); bs.pm23 = (v0[2] ? 0xFFFFu : 0u) | (v0[3] ? 0xFFFF0000u : 0u); }
    const unsigned qoff = (unsigned)cq * D + h * HD + 8 * fq, ooff = (unsigned)cq * D + h * HD + 4 * fq;
    float m[4]; f32x4 l[4]; f32x4 o[4][4]; bf16x8 qf[4][2], qn[2];
    __syncthreads();
#pragma unroll
    for (int n = 0; n < 4; ++n) { const int ch = tid + NT * n, key = ch >> 3, c = ch & 7;
        const u32x4 kv = *(const u32x4*)(Kg + (size_t)(L + key) * D + h * HD + c * 8), vv = *(const u32x4*)(Vg + (size_t)(L + key) * D + h * HD + c * 8);
        *(LAS u32x4*)(lds + LDS_CK + kaddr(key, c)) = kv;
        *(LAS u32x4*)(lds + LDS_CV + (c >> 1) * (256 * 32) + key * 32 + (c & 1) * 16) = vv; }
    if (tid < 465) bias[tid] = a.rpb[h * 465 + tid] * LOG2E;
    const int key = tid >> 3, c = tid & 7;
    const unsigned kvoff = (unsigned)key * D + h * HD + c * 8;
    const unsigned ksl = kaddr(key, c), vsl = 8192 + (c >> 1) * (64 * 32) + key * 32 + (c & 1) * 16;
#pragma unroll
    for (int n = 0; n < 2; ++n) { const size_t go = (size_t)(kb + n) * GW * D + kvoff; const u32x4 kv = *(const u32x4*)(Kg + go), vv = *(const u32x4*)(Vg + go);
        *(LAS u32x4*)(lds + LDS_RING + n * SLOT + ksl) = kv; *(LAS u32x4*)(lds + LDS_RING + n * SLOT + vsl) = vv; }
#pragma unroll
    for (int j = 0; j < 4; ++j) if (nj[j] > 0 && ws0[j] == kb) { const bf16_t* qp = Q + (size_t)row0[j] * GW * D + qoff; qf[j][0] = *(const bf16x8*)qp; qf[j][1] = *(const bf16x8*)(qp + 32); }
    __syncthreads();
    int rs = 0;
    for (int kr = kb; kr <= ke; ++kr) {
        u32x4 kreg, vreg; const bool pf = kr + 2 <= ke;
        if (pf) { const size_t go = (size_t)(kr + 2) * GW * D + kvoff; kreg = *(const u32x4*)(Kg + go); vreg = *(const u32x4*)(Vg + go); }
#pragma unroll
        for (int j = 0; j < 4; ++j) { const int d = kr + 1 - ws0[j]; if (d >= 0 && d < 8 * nj[j] && (d & 7) == 0) { const bf16_t* qp = Q + (size_t)(row0[j] + d) * GW * D + qoff; qn[0] = *(const bf16x8*)qp; qn[1] = *(const bf16x8*)(qp + 32); } }
        const LAS unsigned char* slot = lds + LDS_RING + rs * SLOT;
#pragma unroll
        for (int j = 0; j < 4; ++j) { const int d = kr - ws0[j];
            if (d >= 0 && d < 8 * nj[j]) { const int i = d & 7, row = row0[j] + (d & ~7);
                if (i == 0) { m[j] = -1e30f; l[j] = (f32x4){0.f, 0.f, 0.f, 0.f};
#pragma unroll
                    for (int db = 0; db < 4; ++db) o[j][db] = (f32x4){0.f, 0.f, 0.f, 0.f};
                    if (kr != kb) { qf[j][0] = qn[0]; qf[j][1] = qn[1]; } }
                tile3(slot, sg, slot + 8192, lds + LDS_CK, i * 32, lds + LDS_CV, qf[j], m[j], l[j], o[j], bias + (kr - row + 7) * 31 + dc0, bs, lane, i == 0);
                if (i == 7) { const float inv = 1.0f / l[j][0];
                    bf16_t* orow = O + (size_t)row * GW * D;
#pragma unroll
                    for (int db = 0; db < 4; ++db) { u32x2 w; w.x = cvt_pk_bf16(o[j][db][0] * inv, o[j][db][1] * inv); w.y = cvt_pk_bf16(o[j][db][2] * inv, o[j][db][3] * inv); st8(orow + (ooff + db * 16), w); } }
            } }
        if (pf) { const int ws_ = (rs + 2 >= 3) ? rs - 1 : rs + 2; *(LAS u32x4*)(lds + LDS_RING + ws_ * SLOT + ksl) = kreg; *(LAS u32x4*)(lds + LDS_RING + ws_ * SLOT + vsl) = vreg; }
        rs = (rs == 2) ? 0 : rs + 1;
        __syncthreads();
    }
}
#ifndef ATT_STRIPS
#define ATT_STRIPS 14
#endif
__device__ __forceinline__ void attn_phase(const Frame& F, const Args& a) {
    constexpr int NS = ATT_STRIPS, NFG = 16 * NS, BASE = 248 / NS, REM = 248 % NS;
    const int u = blockIdx.x;
    if (F.G == 256 && u >= NFG) {
        const int b = u - NFG;
        if (b < 32) attn_unit(F, a, b & 15, b < 16 ? 0 : 252, b < 16 ? 3 : 255, true);
        return;
    }
    for (int unit = u; unit < NFG; unit += (F.G == 256 ? 256 : F.G)) {
        const int h = unit & 15, strip = unit >> 4;
        const int rlo = 4 + strip * BASE + (strip < REM ? strip : REM), rhi = rlo + BASE + (strip < REM ? 1 : 0) - 1;
        attn_unit(F, a, h, rlo, rhi, false);
    }
    if (F.G != 256) for (int b = u; b < 32; b += F.G) attn_unit(F, a, b & 15, b < 16 ? 0 : 252, b < 16 ? 3 : 255, true);
}
}

__device__ __forceinline__ void vec_phase(const Frame& F, const Args& a) {
    float* V = (float*)(a.ws + WS_VEC); const float* modb = (const float*)(a.ws + WS_MOD);
    for (int c = F.tid; c < D; c += NT) {
#pragma unroll
        for (int l = 0; l < 2; ++l) { const float* mod = modb + (l == 0 ? 0 : 2) * 6144; const float* ng = a.norm_g + l * 4 * D;
            V[(4 + 4 * l) * D + c] = mod[2 * D + c] * ng[D + c]; V[(5 + 4 * l) * D + c] = ng[2 * D + c] * (1.0f + mod[4 * D + c]);
            V[(6 + 4 * l) * D + c] = mod[3 * D + c]; V[(7 + 4 * l) * D + c] = mod[5 * D + c] * ng[3 * D + c]; }
        const float* mod1 = modb + 2 * 6144;
        V[12 * D + c] = a.norm_g[4 * D + c] * (1.0f + mod1[D + c]); V[13 * D + c] = mod1[c];
    }
}

namespace post {
constexpr int LDS_WR = 0;
constexpr int M_TKE = MISC_OFF + 2048;
constexpr int M_TKW = MISC_OFF + 3072;
constexpr int M_RANK = MISC_OFF + 4096;
constexpr int M_LCNT = MISC_OFF + 5120;
constexpr int M_BASE = MISC_OFF + 5248;
__device__ __forceinline__ float reduce32(float (&acc)[32], int lane) {
    float a16[16], a8[8], a4[4], a2[2];
    { const bool hi = lane & 32;
#pragma unroll
      for (int i = 0; i < 16; ++i) { const float send = hi ? acc[i] : acc[i + 16], keep = hi ? acc[i + 16] : acc[i]; a16[i] = keep + __shfl_xor(send, 32); } }
    { const bool hi = lane & 16;
#pragma unroll
      for (int i = 0; i < 8; ++i) { const float send = hi ? a16[i] : a16[i + 8], keep = hi ? a16[i + 8] : a16[i]; a8[i] = keep + __shfl_xor(send, 16); } }
    { const bool hi = lane & 8;
#pragma unroll
      for (int i = 0; i < 4; ++i) { const float send = hi ? a8[i] : a8[i + 4], keep = hi ? a8[i + 4] : a8[i]; a4[i] = keep + __shfl_xor(send, 8); } }
    { const bool hi = lane & 4;
#pragma unroll
      for (int i = 0; i < 2; ++i) { const float send = hi ? a4[i] : a4[i + 2], keep = hi ? a4[i + 2] : a4[i]; a2[i] = keep + __shfl_xor(send, 4); } }
    float v; { const bool hi = lane & 2; const float send = hi ? a2[0] : a2[1], keep = hi ? a2[1] : a2[0]; v = keep + __shfl_xor(send, 2); }
    v += __shfl_xor(v, 1);
    return v;
}
__device__ __forceinline__ float reduce16(float (&acc)[16], int lane) {
    float a8[8], a4[4], a2[2];
    { const bool hi = lane & 16;
#pragma unroll
      for (int i = 0; i < 8; ++i) { const float send = hi ? acc[i] : acc[i + 8], keep = hi ? acc[i + 8] : acc[i]; a8[i] = keep + __shfl_xor(send, 16); } }
    { const bool hi = lane & 8;
#pragma unroll
      for (int i = 0; i < 4; ++i) { const float send = hi ? a8[i] : a8[i + 4], keep = hi ? a8[i + 4] : a8[i]; a4[i] = keep + __shfl_xor(send, 8); } }
    { const bool hi = lane & 4;
#pragma unroll
      for (int i = 0; i < 2; ++i) { const float send = hi ? a4[i] : a4[i + 2], keep = hi ? a4[i + 2] : a4[i]; a2[i] = keep + __shfl_xor(send, 4); } }
    float v; { const bool hi = lane & 2; const float send = hi ? a2[0] : a2[1], keep = hi ? a2[1] : a2[0]; v = keep + __shfl_xor(send, 2); }
    v += __shfl_xor(v, 1); v += __shfl_xor(v, 32);
    return v;
}
__device__ __forceinline__ unsigned wave_max_u32(unsigned v) {
    v = max(v, (unsigned)__builtin_amdgcn_update_dpp(0, (int)v, 0xB1, 0xf, 0xf, true));
    v = max(v, (unsigned)__builtin_amdgcn_update_dpp(0, (int)v, 0x4E, 0xf, 0xf, true));
    v = max(v, (unsigned)__builtin_amdgcn_update_dpp(0, (int)v, 0x124, 0xf, 0xf, true));
    v = max(v, (unsigned)__builtin_amdgcn_update_dpp(0, (int)v, 0x128, 0xf, 0xf, true));
    v = max(v, (unsigned)__builtin_amdgcn_ds_swizzle((int)v, 0x401F));
    return max((unsigned)__builtin_amdgcn_readlane((int)v, 0), (unsigned)__builtin_amdgcn_readlane((int)v, 32));
}
__device__ __forceinline__ void top4(float v, int lane, int (&ei)[4], float (&wv)[4]) {
    const int e = ((lane >> 5) << 4) | ((lane >> 1) & 15); float val[4];
    const unsigned u = __float_as_uint(v);
    unsigned key = ((u ^ ((u >> 31) ? 0xFFFFFFFFu : 0x80000000u)) & ~31u) | (unsigned)(31 - e);
#pragma unroll
    for (int k = 0; k < 4; ++k) {
        const unsigned best = wave_max_u32(key);
        ei[k] = 31 - (int)(best & 31u);
        const unsigned kb = best & ~31u; val[k] = __uint_as_float((kb & 0x80000000u) ? (kb ^ 0x80000000u) : ~kb);
        if (key == best) key = 0u;
    }
    float s = 0.f;
#pragma unroll
    for (int k = 0; k < 4; ++k) { wv[k] = __expf(val[k] - val[0]); s += wv[k]; }
    const float inv = 1.0f / s;
#pragma unroll
    for (int k = 0; k < 4; ++k) wv[k] *= inv;
}
__device__ __forceinline__ void post_phase(const Frame& F, const Args& a, int layer, const float* xin, int nfg, bool do_lists = true) {
    const float* V = (const float*)(a.ws + WS_VEC) + (size_t)(4 + 4 * layer) * D;
    const float* wrt = a.w_router + (size_t)layer * D * NE; const float* brt = a.b_router + layer * NE;
    const rsrc_t rMX = mk_rsrc(a.ws + WS_MX, L * D * 2), rX = mk_rsrc(xin, L * D * 4), rXR = mk_rsrc(a.ws + WS_XR, L * D * 2), rH = mk_rsrc(a.ws + WS_HX2, L * D), rV = mk_rsrc(V, 3 * D * 4);
    int* list = (int*)(a.ws + WS_LIST); float* gate = (float*)(a.ws + WS_GATE); unsigned* gcnt = (unsigned*)(a.ws + WS_CTL) + CW_CNT + 64 * layer;
    LAS unsigned char* lds = F.lds; const int tid = F.tid, lane = F.lane;
    LAS int* tke = (LAS int*)(lds + M_TKE); LAS float* tkw = (LAS float*)(lds + M_TKW); LAS int* rank = (LAS int*)(lds + M_RANK); LAS int* lcnt = (LAS int*)(lds + M_LCNT); LAS int* lbase = (LAS int*)(lds + M_BASE);
    __syncthreads();
    constexpr int XT_HI = 0, XT_LO = 32768, PART = 65536;
    const int wid = F.wave, fr = lane & 15, fq = lane >> 4, et = wid & 1, kq = wid >> 1;
    bf16x8 wh[8], wl[8];
    { const bf16_t* wrt = (const bf16_t*)(a.ws + WS_WRT) + (size_t)(layer * 2) * NE * D + (size_t)(16 * et + fr) * D + kq * 256 + 8 * fq;
#pragma unroll
      for (int s_ = 0; s_ < 8; ++s_) { wh[s_] = *(const bf16x8*)(wrt + 32 * s_); wl[s_] = *(const bf16x8*)(wrt + (size_t)NE * D + 32 * s_); } }
    const int el = ((lane >> 5) << 4) | ((lane >> 1) & 15);
    const float bre = brt[el];
    constexpr int CST = 73728;
    for (int i = tid; i < 3 * D / 4; i += NT) *(LAS f32x4*)(lds + CST + i * 16) = *(const f32x4*)(V + 4 * i);
    __syncthreads();
    auto cst_row = [&](int v) { Row r;
#pragma unroll
        for (int j = 0; j < 4; ++j) r.v[j] = *(const LAS f32x4*)(lds + CST + v * 4096 + j * 1024 + lane * 16);
        return r; };
    for (int tile = blockIdx.x; tile < L / 64; tile += nfg) {
        { unsigned l_; asm volatile("v_mbcnt_lo_u32_b32 %0, -1, 0\n\tv_mbcnt_hi_u32_b32 %0, -1, %0" : "=v"(l_)); if (F.wave == 0 && l_ < 32u) lcnt[l_] = 0; }
        __syncthreads();
        u32x2 mra[4], mrb[4]; Row xna, xnb; u32x2 xra[4], xrb[4];
        { const unsigned t0 = (unsigned)(tile * 64 + 2 * wid);
          row_load_bf16_raw(rMX, t0 * D * 2, lane, mra); row_load_bf16_raw(rMX, (t0 + 1) * D * 2, lane, mrb);
          if (layer == 0) { xna = row_load_f32(rX, t0 * D * 4, lane); xnb = row_load_f32(rX, (t0 + 1) * D * 4, lane); }
          else { row_load_bf16_raw(rXR, t0 * D * 2, lane, xra); row_load_bf16_raw(rXR, (t0 + 1) * D * 2, lane, xrb); } }
        for (int b = 0; b < 4; ++b) {
            const int lr = 16 * b + 2 * wid; const unsigned t0 = (unsigned)(tile * 64 + lr);
            Row xa, xb;
            {   const Row ma = row_unpack_bf16(mra), mb = row_unpack_bf16(mrb);
                if (layer == 0) { xa = xna; xb = xnb; } else { xa = row_unpack_bf16(xra); xb = row_unpack_bf16(xrb); }
                if (b < 3) { const unsigned t1 = t0 + 16;
                    row_load_bf16_raw(rMX, t1 * D * 2, lane, mra); row_load_bf16_raw(rMX, (t1 + 1) * D * 2, lane, mrb);
                    if (layer == 0) { xna = row_load_f32(rX, t1 * D * 4, lane); xnb = row_load_f32(rX, (t1 + 1) * D * 4, lane); }
                    else { row_load_bf16_raw(rXR, t1 * D * 2, lane, xra); row_load_bf16_raw(rXR, (t1 + 1) * D * 2, lane, xrb); } }
                const float ra = rstd_of(row_sumsq(ma)), rb = rstd_of(row_sumsq(mb));
                const Row cA = cst_row(0);
#pragma unroll
                for (int j = 0; j < 4; ++j) { xa.v[j] += cA.v[j] * (ma.v[j] * ra); xb.v[j] += cA.v[j] * (mb.v[j] * rb); } }
            row_store_bf16(rXR, t0 * D * 2, lane, xa); row_store_bf16(rXR, (t0 + 1) * D * 2, lane, xb);
            { const float ra = rstd_of(row_sumsq(xa)), rb = rstd_of(row_sumsq(xb));
              const Row cB = cst_row(1), cC = cst_row(2);
#pragma unroll
              for (int j = 0; j < 4; ++j) { xa.v[j] = xa.v[j] * ra * cB.v[j] + cC.v[j]; xb.v[j] = xb.v[j] * rb * cB.v[j] + cC.v[j]; } }
            row_store_fp8(rH, t0 * D, lane, xa); row_store_fp8(rH, (t0 + 1) * D, lane, xb);
#pragma unroll
            for (int rr = 0; rr < 2; ++rr) { const Row& xr = rr ? xb : xa; const int row = 2 * wid + rr;
#pragma unroll
                for (int j = 0; j < 4; ++j) { const f32x4 v = xr.v[j];
                    u32x2 h; h.x = cvt_pk_bf16(v[0], v[1]); h.y = cvt_pk_bf16(v[2], v[3]);
                    u32x2 lo; lo.x = cvt_pk_bf16(v[0] - bf_lo(h.x), v[1] - bf_hi(h.x)); lo.y = cvt_pk_bf16(v[2] - bf_lo(h.y), v[3] - bf_hi(h.y));
                    const unsigned ad = (unsigned)row * 2048u + ((((unsigned)(lane >> 1) + 32u * j) ^ (unsigned)row) << 4) + ((unsigned)(lane & 1) << 3);
                    *(LAS u32x2*)(lds + XT_HI + ad) = h; *(LAS u32x2*)(lds + XT_LO + ad) = lo; } }
            __syncthreads();
            {   f32x4 acc = {0.f, 0.f, 0.f, 0.f};
#pragma unroll
                for (int s_ = 0; s_ < 8; ++s_) { const unsigned ad = (unsigned)fr * 2048u + ((((unsigned)(4 * (kq * 8 + s_) + fq)) ^ (unsigned)fr) << 4);
                    const bf16x8 xh = *(const LAS bf16x8*)(lds + XT_HI + ad), xl = *(const LAS bf16x8*)(lds + XT_LO + ad);
                    acc = __builtin_amdgcn_mfma_f32_16x16x32_bf16(wh[s_], xh, acc, 0, 0, 0);
                    acc = __builtin_amdgcn_mfma_f32_16x16x32_bf16(wh[s_], xl, acc, 0, 0, 0);
                    acc = __builtin_amdgcn_mfma_f32_16x16x32_bf16(wl[s_], xh, acc, 0, 0, 0); }
                LAS float* pp = (LAS float*)(lds + PART) + (kq * 2 + et) * 256 + (4 * fq) * 16 + fr;
#pragma unroll
                for (int r_ = 0; r_ < 4; ++r_) pp[r_ * 16] = acc[r_]; }
            __syncthreads();
            {   const LAS float* pp = (const LAS float*)(lds + PART) + (lane >> 5) * 256 + ((lane >> 1) & 15) * 16 + 2 * wid;
                float la = bre, lb = bre;
#pragma unroll
                for (int q_ = 0; q_ < 4; ++q_) { la += pp[q_ * 512]; lb += pp[q_ * 512 + 1]; }
                int ea[4], eb[4]; float wa[4], wb[4];
                top4(la, lane, ea, wa); top4(lb, lane, eb, wb);
                if (lane == 0) {
#pragma unroll
                    for (int k = 0; k < 4; ++k) { tke[lr * 4 + k] = ea[k]; tkw[lr * 4 + k] = wa[k]; tke[(lr + 1) * 4 + k] = eb[k]; tkw[(lr + 1) * 4 + k] = wb[k]; } } }
        }
        __syncthreads();
        if (do_lists) {
            unsigned l_; asm volatile("v_mbcnt_lo_u32_b32 %0, -1, 0\n\tv_mbcnt_hi_u32_b32 %0, -1, %0" : "=v"(l_)); const int t2 = F.wave * 64 + (int)l_;
            int e = 0;
            if (t2 < 256) { e = tke[t2]; rank[t2] = atomicAdd((int*)&lcnt[e], 1); }
            __syncthreads();
            if (t2 < 32) { const int n = lcnt[t2]; lbase[t2] = n ? (int)atomicAdd(gcnt + t2, (unsigned)n) : 0; }
            __syncthreads();
            if (t2 < 256) { const int pos = lbase[e] + rank[t2], slot = tile * 256 + t2; list[e * LIST_CAP + pos] = slot; gate[e * LIST_CAP + pos] = tkw[t2];
                if (Y_SORTED) ((int*)(a.ws + WS_POS))[slot] = (e << 16) | pos; }
            __syncthreads();
        }
    }
}
}

constexpr int M_TSTART = MISC_OFF + 256, M_CNT = MISC_OFF + 512, M_TILEE = MISC_OFF + 768;
__device__ __forceinline__ gm::MoeTab moe_tables(const Frame& F, const Args& a, int layer) {
    LAS int* tstart = (LAS int*)(F.lds + M_TSTART); LAS int* cnt = (LAS int*)(F.lds + M_CNT); LAS unsigned char* tile_e = F.lds + M_TILEE;
    const unsigned* gcnt = (const unsigned*)(a.ws + WS_CTL) + CW_CNT + 64 * layer;
    __syncthreads();
    if (F.wave == 0) {
        const int e = F.lane & 31;
        const int n = (int)__hip_atomic_load(gcnt + e, __ATOMIC_RELAXED, __HIP_MEMORY_SCOPE_AGENT), nt = (n + 255) >> 8;
        int ts = 0, tot = 0;
#pragma unroll
        for (int j = 0; j < 32; ++j) { const int v = __builtin_amdgcn_readlane(nt, j); if (j < e) ts += v; tot += v; }
        if (F.lane < 32) { cnt[e] = n; tstart[e] = ts; if (e == 31) tstart[32] = tot;
            for (int t = 0; t < nt; ++t) tile_e[ts + t] = (unsigned char)e; }
    }
    __syncthreads();
    const int T = __builtin_amdgcn_readfirstlane(tstart[32]);
    gm::MoeTab tb; tb.tstart = tstart; tb.cnt = cnt; tb.tile_e = tile_e; tb.T = T; return tb;
}

template <int layer> __device__ __forceinline__ void combine_phase(const Frame& F, const Args& a) {
    const float* V = (const float*)(a.ws + WS_VEC);
    const rsrc_t rY = mk_rsrc(a.ws + WS_Y, Y_SORTED ? (unsigned)ACT_ROWS * D : (unsigned)L * 4 * D * (Y_FP8 ? 1 : 2)), rO = mk_rsrc(a.out, L * D * 4), rXR = mk_rsrc(a.ws + WS_XR, L * D * 2), rHX = mk_rsrc(a.ws + WS_HX, L * D * 2), rV = mk_rsrc(V, 16 * D * 4);
    const int lane = F.lane, gw = F.vcu * NWAVES + F.wave, NGW = F.G * NWAVES;
    const Row cD = row_load_f32(rV, (7 + 4 * layer) * D * 4, lane);
    Row cE, cF;
    if (layer == 0) { cE = row_load_f32(rV, 12 * D * 4, lane); cF = row_load_f32(rV, 13 * D * 4, lane); }
#if Y_FP8 && Y_SORTED
    struct Raw { unsigned y[4][4]; u32x2 x[4]; };
    auto load_raw = [&](int rowv, int ii, int t, Raw& r) {
#pragma unroll
        for (int k = 0; k < 4; ++k) { const unsigned row = (unsigned)__builtin_amdgcn_readlane(rowv, 4 * ii + k);
#pragma unroll
            for (int j = 0; j < 4; ++j) r.y[k][j] = (unsigned)__builtin_amdgcn_raw_buffer_load_b32(rY, 4 * lane, ((((row >> 8) << 2) + j) << 16) + ((row & 255u) << 8), 0); }
#elif Y_FP8
    struct Raw { unsigned y[4][4]; u32x2 x[4]; };
    auto load_raw = [&](int t, Raw& r) {
#pragma unroll
        for (int k = 0; k < 4; ++k)
#pragma unroll
            for (int j = 0; j < 4; ++j) r.y[k][j] = (unsigned)__builtin_amdgcn_raw_buffer_load_b32(rY, 4 * lane, ((unsigned)t * 4 + k) * D + 256 * j, 0);
#else
    struct Raw { u32x2 y[4][4]; u32x2 x[4]; };
    auto load_raw = [&](int t, Raw& r) {
#pragma unroll
        for (int k = 0; k < 4; ++k) row_load_bf16_raw(rY, ((unsigned)t * 4 + k) * D * 2, lane, r.y[k]);
#endif
        row_load_bf16_raw(rXR, (unsigned)t * D * 2, lane, r.x);
    };
    auto finish = [&](int t, const Raw& r) {
        Row f, x = row_unpack_bf16(r.x);
#pragma unroll
        for (int j = 0; j < 4; ++j) { f.v[j] = (f32x4){0.f, 0.f, 0.f, 0.f};
#pragma unroll
            for (int k = 0; k < 4; ++k) {
#if Y_FP8
                const f32x2 a_ = __builtin_amdgcn_cvt_pk_f32_fp8((int)r.y[k][j], false), b_ = __builtin_amdgcn_cvt_pk_f32_fp8((int)r.y[k][j], true); f.v[j] += (f32x4){a_[0], a_[1], b_[0], b_[1]};
#else
                const u32x2 w = r.y[k][j]; f.v[j] += (f32x4){bf_lo(w.x), bf_hi(w.x), bf_lo(w.y), bf_hi(w.y)};
#endif
            } }
#if Y_FP8
#pragma unroll
        for (int j = 0; j < 4; ++j) f.v[j] = f.v[j] * 0.25f;
#endif
        const float rs = rstd_of(row_sumsq(f));
#pragma unroll
        for (int j = 0; j < 4; ++j) x.v[j] += cD.v[j] * (f.v[j] * rs);
        if (layer == 0) row_store_bf16(rXR, (unsigned)t * D * 2, lane, x); else row_store_f32(rO, (unsigned)t * D * 4, lane, x);
        if (layer == 0) { const float r2 = rstd_of(row_sumsq(x));
#pragma unroll
            for (int j = 0; j < 4; ++j) x.v[j] = x.v[j] * r2 * cE.v[j] + cF.v[j];
            row_store_bf16(rHX, (unsigned)t * D * 2, lane, x); }
    };
#if Y_FP8 && Y_SORTED
    const int* posp = (const int*)(a.ws + WS_POS); const LAS int* tstart = (const LAS int*)(F.lds + M_TSTART);
#pragma unroll 1
    for (int i0 = 0; gw + i0 * NGW < L; i0 += 16) {
        int rowv = 0; { const int t_ = gw + (i0 + (lane >> 2)) * NGW; if (t_ < L) { const int pv = posp[4 * t_ + (lane & 3)]; rowv = (tstart[pv >> 16] << 8) + (pv & 0xffff); } }
#pragma unroll 1
        for (int ii = 0; ii < 16; ii += 2) { const int t0 = gw + (i0 + ii) * NGW, t1 = t0 + NGW; if (t0 >= L) break;
            Raw ra, rb; load_raw(rowv, ii, t0, ra); if (t1 < L) load_raw(rowv, ii + 1, t1, rb); finish(t0, ra); if (t1 < L) finish(t1, rb); }
    }
#else
    int t = gw;
    for (; t + NGW < L; t += 2 * NGW) { Raw ra, rb; load_raw(t, ra); load_raw(t + NGW, rb); finish(t, ra); finish(t + NGW, rb); }
    for (; t < L; t += NGW) { Raw ra; load_raw(t, ra); finish(t, ra); }
#endif
}

__device__ __forceinline__ void diff_phase(const Frame& F, const Args& a) {
    const bf16_t* HX = (const bf16_t*)(a.ws + WS_HX); bf16_t* DF = (bf16_t*)(a.ws + WS_O);
    const int cg = F.tid & 127, rg = F.tid >> 7, g = cg >> 5, hs = 1 << g;
    for (int tile = blockIdx.x; tile < L / 64; tile += F.G) {
        const int t0 = tile * 64 + rg * 16;
        float sum[8];
#pragma unroll
        for (int i = 0; i < 8; ++i) sum[i] = 0.f;
        const int lo0 = max(t0 - hs, 0), hi0 = min(t0 + hs, L);
        for (int u = lo0; u < hi0; ++u) { const u32x4 w = *(const u32x4*)(HX + (size_t)u * D + cg * 8);
            sum[0] += bf_lo(w.x); sum[1] += bf_hi(w.x); sum[2] += bf_lo(w.y); sum[3] += bf_hi(w.y); sum[4] += bf_lo(w.z); sum[5] += bf_hi(w.z); sum[6] += bf_lo(w.w); sum[7] += bf_hi(w.w); }
        for (int t = t0; t < t0 + 16; ++t) {
            const int lo = max(t - hs, 0), hi = min(t + hs, L); const float ic = 1.0f / (float)(hi - lo);
            const u32x4 w = *(const u32x4*)(HX + (size_t)t * D + cg * 8);
            const float cv[8] = {bf_lo(w.x), bf_hi(w.x), bf_lo(w.y), bf_hi(w.y), bf_lo(w.z), bf_hi(w.z), bf_lo(w.w), bf_hi(w.w)};
            u32x4 o; o.x = cvt_pk_bf16(sum[0] * ic - cv[0], sum[1] * ic - cv[1]); o.y = cvt_pk_bf16(sum[2] * ic - cv[2], sum[3] * ic - cv[3]);
            o.z = cvt_pk_bf16(sum[4] * ic - cv[4], sum[5] * ic - cv[5]); o.w = cvt_pk_bf16(sum[6] * ic - cv[6], sum[7] * ic - cv[7]);
            st16(DF + (size_t)t * D + cg * 8, o);
            if (t + hs < L) { const u32x4 e = *(const u32x4*)(HX + (size_t)(t + hs) * D + cg * 8);
                sum[0] += bf_lo(e.x); sum[1] += bf_hi(e.x); sum[2] += bf_lo(e.y); sum[3] += bf_hi(e.y); sum[4] += bf_lo(e.z); sum[5] += bf_hi(e.z); sum[6] += bf_lo(e.w); sum[7] += bf_hi(e.w); }
            if (t - hs >= 0) { const u32x4 e = *(const u32x4*)(HX + (size_t)(t - hs) * D + cg * 8);
                sum[0] -= bf_lo(e.x); sum[1] -= bf_hi(e.x); sum[2] -= bf_lo(e.y); sum[3] -= bf_hi(e.y); sum[4] -= bf_lo(e.z); sum[5] -= bf_hi(e.z); sum[6] -= bf_lo(e.w); sum[7] -= bf_hi(e.w); }
        }
    }
}

__device__ __forceinline__ void diff_tile(const Frame& F, const Args& a, int pm, int g) {
    const bf16_t* HX = (const bf16_t*)(a.ws + WS_HX); bf16_t* DF = (bf16_t*)(a.ws + WS_O);
    const int col = g * 256 + (F.tid & 31) * 8, hs = 1 << g, t0 = pm * 256 + (F.tid >> 5) * 16;
    float sum[8];
#pragma unroll
    for (int i = 0; i < 8; ++i) sum[i] = 0.f;
    const int lo0 = max(t0 - hs, 0), hi0 = min(t0 + hs, L);
    for (int u = lo0; u < hi0; ++u) { const u32x4 w = *(const u32x4*)(HX + (size_t)u * D + col);
        sum[0] += bf_lo(w.x); sum[1] += bf_hi(w.x); sum[2] += bf_lo(w.y); sum[3] += bf_hi(w.y); sum[4] += bf_lo(w.z); sum[5] += bf_hi(w.z); sum[6] += bf_lo(w.w); sum[7] += bf_hi(w.w); }
    for (int t = t0; t < t0 + 16; ++t) {
        const int lo = max(t - hs, 0), hi = min(t + hs, L); const float ic = 1.0f / (float)(hi - lo);
        const u32x4 w = *(const u32x4*)(HX + (size_t)t * D + col);
        const float cv[8] = {bf_lo(w.x), bf_hi(w.x), bf_lo(w.y), bf_hi(w.y), bf_lo(w.z), bf_hi(w.z), bf_lo(w.w), bf_hi(w.w)};
        u32x4 o; o.x = cvt_pk_bf16(sum[0] * ic - cv[0], sum[1] * ic - cv[1]); o.y = cvt_pk_bf16(sum[2] * ic - cv[2], sum[3] * ic - cv[3]);
        o.z = cvt_pk_bf16(sum[4] * ic - cv[4], sum[5] * ic - cv[5]); o.w = cvt_pk_bf16(sum[6] * ic - cv[6], sum[7] * ic - cv[7]);
        st16(DF + (size_t)t * D + col, o);
        if (t + hs < L) { const u32x4 e = *(const u32x4*)(HX + (size_t)(t + hs) * D + col);
            sum[0] += bf_lo(e.x); sum[1] += bf_hi(e.x); sum[2] += bf_lo(e.y); sum[3] += bf_hi(e.y); sum[4] += bf_lo(e.z); sum[5] += bf_hi(e.z); sum[6] += bf_lo(e.w); sum[7] += bf_hi(e.w); }
        if (t - hs >= 0) { const u32x4 e = *(const u32x4*)(HX + (size_t)(t - hs) * D + col);
            sum[0] -= bf_lo(e.x); sum[1] -= bf_hi(e.x); sum[2] -= bf_lo(e.y); sum[3] -= bf_hi(e.y); sum[4] -= bf_lo(e.z); sum[5] -= bf_hi(e.z); sum[6] -= bf_lo(e.w); sum[7] -= bf_hi(e.w); }
    }
}

constexpr int N_PHASES = 15;
__global__ void __launch_bounds__(NT, 2) mk_fwd(Args args) {
    extern __shared__ __attribute__((aligned(16))) unsigned char lds_raw[];
    Frame F; F.lds = (LAS unsigned char*)lds_raw; F.tid = 0; F.lane = 0; F.wave = __builtin_amdgcn_readfirstlane(threadIdx.x >> 6);
    F.G = gridDim.x; { const int bx = blockIdx.x; F.vcu = (F.G % 8 == 0) ? (bx % 8) * (F.G / 8) + bx / 8 : bx; }
    volatile LAS unsigned* MISC = (volatile LAS unsigned*)(F.lds + MISC_OFF);
    if (threadIdx.x < 16) MISC[threadIdx.x] = 0u;
    __syncthreads();
    const int lo = args.ph_lo, hi = args.ph_hi;
    unsigned* ctl = (unsigned*)(args.ws + WS_CTL);
    XcdBarrier bar; bar.bar = ctl + CW_BAR; bar.x = 0; bar.st = nullptr;
    if (hi - lo > 1) bar = xcd_barrier_post(ctl + CW_BAR, MISC + 8, threadIdx.x == 0);
#ifndef P0_CONV_WGS
#define P0_CONV_WGS 0
#endif
#ifndef PROBE_BAR2
#define PROBE_BAR2 0
#endif
#ifndef POST_FG
#define POST_FG 256
#endif
#ifndef CTX_IN_P1
#define CTX_IN_P1 0
#endif
#ifndef MOE_EXTRA_ROUNDS
#define MOE_EXTRA_ROUNDS 0
#endif
#ifndef FUSE_DIFF
#define FUSE_DIFF 1
#endif
#ifndef BG_STOP_NUM
#define BG_STOP_NUM 1
#define BG_STOP_DEN 1
#endif
#ifndef BG_MASK
#define BG_MASK 0xffff
#endif
#ifndef PROBE_DUP
#define PROBE_DUP 0
#endif
#ifndef STAGGER
#define STAGGER 0
#endif

#define REPS(k) (((PROBE_DUP >> (k)) & 1) ? 2 : 1)
#ifndef PH_MASK
#define PH_MASK 0x7fff
#endif
#define IN(k) (((PH_MASK >> (k)) & 1) && lo <= (k) && (k) < hi)
#define PHASE_FRAME() Frame Fp = F; { unsigned l_; asm volatile("v_mbcnt_lo_u32_b32 %0, -1, 0\n\tv_mbcnt_hi_u32_b32 %0, -1, %0" : "=v"(l_)); Fp.lane = (int)l_; Fp.tid = F.wave * 64 + (int)l_; }
#define SEAM(k) do { if (IN(k) && IN((k) + 1)) { unsigned l_; asm volatile("v_mbcnt_lo_u32_b32 %0, -1, 0\n\tv_mbcnt_hi_u32_b32 %0, -1, %0" : "=v"(l_)); xcd_barrier(bar, F.wave == 0 && l_ == 0u); if (PROBE_BAR2) xcd_barrier(bar, F.wave == 0 && l_ == 0u); } } while (0)
    unsigned char* ws = args.ws;
    bf16_t* HX = (bf16_t*)(ws + WS_HX);
    const float* mod0 = (const float*)(ws + WS_MOD);

    if (IN(0)) for (int rep_ = 0; rep_ < REPS(0); ++rep_) { PHASE_FRAME(); p0_adaln(Fp, args); p0_router_weights(Fp, args); p0_convert_small(Fp, args); if ((int)blockIdx.x < P0_CONV_WGS) { bg_convert(Fp, args, 0, 0, 0u, false); bg_convert(Fp, args, 1, 0, 0u, false); } }
    SEAM(0);
    const bool ctx_p1 = CTX_IN_P1 && !QKV_FP8 && F.G == 256;
    if (IN(1)) for (int rep_ = 0; rep_ < REPS(1); ++rep_) { PHASE_FRAME();
        if (ctx_p1) {
            if (blockIdx.x >= 248) {
                modulate_rows(Fp, args.ctx, CTX, args.norm_g, mod0 + 6144, mod0 + 6144 + D, HX + (size_t)L * D, Fp.wave, NWAVES);
                asm volatile("s_waitcnt vmcnt(0)" ::: "memory"); __syncthreads();
                gm::OneProb P{(const char*)HX, (const char*)(ws + WS_WQKV), 2048u, 2048u, 1024, L / 256, 4 + ((int)blockIdx.x - 248), (size_t)256 * 2048};
                gm::EpiBf16 E{(bf16_t*)(ws + WS_Q), D, nullptr, nullptr, D, (size_t)(WS_K - WS_Q) / 2, QSCALE, 256, 1.f};
                gm::gemm_phase(Fp.lds, Fp.tid, P, E);
            } else {
                modulate_rows(Fp, args.x, L, args.norm_g, mod0, mod0 + D, HX, (int)blockIdx.x * NWAVES + Fp.wave, 248 * NWAVES);
                if (blockIdx.x == 247) vec_phase(Fp, args);
            }
        } else {
            modulate_rows<QKV_FP8 != 0>(Fp, args.x, L, args.norm_g, mod0, mod0 + D, HX, Fp.vcu * NWAVES + Fp.wave, (int)F.G * NWAVES);
            modulate_rows<QKV_FP8 != 0>(Fp, args.ctx, CTX, args.norm_g, mod0 + 6144, mod0 + 6144 + D, QKV_FP8 ? (void*)((unsigned char*)HX + (size_t)L * D) : (void*)(HX + (size_t)L * D), Fp.vcu * NWAVES + Fp.wave, (int)F.G * NWAVES);
            if (blockIdx.x == gridDim.x - 1) vec_phase(Fp, args);
        }
    }
    SEAM(1);
    if (IN(2)) for (int rep_ = 0; rep_ < REPS(2); ++rep_) { PHASE_FRAME();
        const int nMq = ctx_p1 ? L / 256 : MQ / 256, NU = nMq * 12; const int Gf = min((int)F.G, (NU + ((NU + F.G - 1) / F.G) - 1) / ((NU + F.G - 1) / F.G));
        if ((int)blockIdx.x < Gf) {
#if QKV_FP8
            gm::DenseProbT<true> P{(const char*)HX, (const char*)(ws + WS_WQKV), 1024u, 1024u, 1024, nMq, 12, Gf, (int)blockIdx.x, 0, (size_t)256 * 1024};
            gm::EpiBf16 E{(bf16_t*)(ws + WS_Q), D, nullptr, nullptr, D, (size_t)(WS_K - WS_Q) / 2, QSCALE, 256, 0.015625f};
#else
            gm::DenseProb P{(const char*)HX, (const char*)(ws + WS_WQKV), 2048u, 2048u, 1024, nMq, 12, Gf, (int)blockIdx.x, 0, (size_t)256 * 2048};
            gm::EpiBf16 E{(bf16_t*)(ws + WS_Q), D, nullptr, nullptr, D, (size_t)(WS_K - WS_Q) / 2, QSCALE, 256, 1.f};
#endif
            gm::gemm_phase(Fp.lds, Fp.tid, P, E);
        }
        if ((BG_MASK >> 2) & 1) { PHASE_FRAME(); bg_convert(Fp, args, 0, 2, (unsigned)max(1, Gf * BG_STOP_NUM / BG_STOP_DEN), (int)blockIdx.x < Gf); }
    }
    SEAM(2);
    if (IN(3)) for (int rep_ = 0; rep_ < REPS(3); ++rep_) { PHASE_FRAME(); na::attn_phase(Fp, args);
        if (F.G == 256 && ((BG_MASK >> 3) & 1)) { PHASE_FRAME(); bg_convert(Fp, args, 0, 3, (unsigned)max(1, 16 * ATT_STRIPS * BG_STOP_NUM / BG_STOP_DEN), (int)blockIdx.x < 16 * ATT_STRIPS); } }
    SEAM(3);
    if (IN(4)) for (int rep_ = 0; rep_ < REPS(4); ++rep_) { PHASE_FRAME();
        gm::DenseProb P{(const char*)(ws + WS_O), (const char*)(ws + WS_WO), 2048u, 2048u, 1024, L / 256, 4, F.G, (int)blockIdx.x, 0, (size_t)256 * 2048};
        gm::EpiBf16 E{(bf16_t*)(ws + WS_MX), D, nullptr, nullptr, 0, 0, 1.f, 256, 1.f};
        gm::gemm_phase(Fp.lds, Fp.tid, P, E);
    }
    SEAM(4);
    if (IN(5)) for (int rep_ = 0; rep_ < REPS(5); ++rep_) { const int nfg = (F.G == 256) ? POST_FG : (int)F.G;
        if ((int)blockIdx.x < nfg) { PHASE_FRAME(); post::post_phase(Fp, args, 0, args.x, nfg, rep_ == REPS(5) - 1); }
        { PHASE_FRAME(); bg_convert(Fp, args, 0, 5, 0u, false); } }
    SEAM(5);
    if (IN(6)) for (int rep_ = 0; rep_ < REPS(6); ++rep_) { PHASE_FRAME();
        const gm::MoeTab tb = moe_tables(Fp, args, 0);
        const int NU = tb.T * 8, rounds = (NU + F.G - 1) / F.G + MOE_EXTRA_ROUNDS, Gf = min((int)F.G, (NU + rounds - 1) / rounds);
        if ((int)blockIdx.x < Gf) {
            const bool hot_ = PROBE_HOT == 1 && REPS(6) == 2 && rep_ == 0; const unsigned ld_ = hot_ ? 0u : 1024u;
            gm::MoeProb<true> P{(const char*)(ws + WS_HX2), (const char*)(ws + WS_WUP), ld_, ld_, 1024, 8, Gf, (int)blockIdx.x, tb, (const int*)(ws + WS_LIST), hot_ ? (size_t)0 : (size_t)2048 * 1024, hot_ ? (size_t)0 : (size_t)256 * 1024};
            gm::EpiSwiglu E{ws + WS_ACT, args.b_up};
#if PROBE_NOEPI
            E.skip = REPS(6) == 2 && rep_ == 0;
#endif
            gm::gemm_phase(Fp.lds, Fp.tid, P, E);
        }
        if ((BG_MASK >> 6) & 1) { PHASE_FRAME(); bg_convert(Fp, args, 1, 6, (unsigned)max(1, Gf * BG_STOP_NUM / BG_STOP_DEN), (int)blockIdx.x < Gf); }
    }
    SEAM(6);
    if (IN(7)) for (int rep_ = 0; rep_ < REPS(7); ++rep_) { PHASE_FRAME();
        const gm::MoeTab tb = moe_tables(Fp, args, 0);
        const int NU = tb.T * 4, rounds = (NU + F.G - 1) / F.G + MOE_EXTRA_ROUNDS, Gf = min((int)F.G, (NU + rounds - 1) / rounds);
        if (STAGGER && (blockIdx.x & 1)) for (int i_ = 0; i_ < STAGGER; ++i_) __builtin_amdgcn_s_sleep(64);
        if ((int)blockIdx.x < Gf) {
            const bool hot_ = PROBE_HOT == 1 && REPS(7) == 2 && rep_ == 0; const unsigned ld_ = hot_ ? 0u : 1024u;
            gm::MoeProb<false> P{(const char*)(ws + WS_ACT), (const char*)(ws + WS_WDN), ld_, ld_, 1024, 4, Gf, (int)blockIdx.x, tb, (const int*)(ws + WS_LIST), hot_ ? (size_t)0 : (size_t)1024 * 1024, hot_ ? (size_t)0 : (size_t)256 * 1024};
#if PROBE_HOT == 2
            P.same = REPS(7) == 2 && rep_ == 0;
#endif
            gm::EpiDown E{ws + WS_Y, args.b_down, (const float*)(ws + WS_GATE), (const int*)(ws + WS_LIST), tb, Fp.lds};
#if PROBE_NOEPI
            E.skip = REPS(7) == 2 && rep_ == 0;
#endif
            gm::gemm_phase(Fp.lds, Fp.tid, P, E);
        }
        if ((BG_MASK >> 7) & 1) { PHASE_FRAME(); bg_convert(Fp, args, 1, 7, (unsigned)max(1, Gf * BG_STOP_NUM / BG_STOP_DEN), (int)blockIdx.x < Gf); }
    }
    SEAM(7);
    if (IN(8)) for (int rep_ = 0; rep_ < REPS(8); ++rep_) { PHASE_FRAME(); if (Y_SORTED) (void)moe_tables(Fp, args, 0); combine_phase<0>(Fp, args); }
    SEAM(8);
    if (!FUSE_DIFF) { if (IN(9)) for (int rep_ = 0; rep_ < REPS(9); ++rep_) { PHASE_FRAME(); diff_phase(Fp, args); }
        SEAM(9); }
    if (IN(10)) for (int rep_ = 0; rep_ < REPS(10); ++rep_) { PHASE_FRAME();
        gm::DenseProb P{(const char*)(ws + WS_O), (const char*)(ws + WS_WPOOL), 2048u, 512u, 256, L / 256, 4, F.G, (int)blockIdx.x, 512, (size_t)256 * 512};
        if (FUSE_DIFF) {
            gm::Unit u_; for (int i_ = 0; P.next(i_, u_); ++i_) diff_tile(Fp, args, u_.pm, u_.pn);
            asm volatile("s_waitcnt vmcnt(0)" ::: "memory"); __syncthreads();
        }
        gm::EpiBf16 E{(bf16_t*)(ws + WS_MX), D, args.pool_b, args.pool_scale, 0, 0, 1.f, 256, 1.f};
        gm::gemm_phase(Fp.lds, Fp.tid, P, E);
    }
    SEAM(10);
    if (IN(11)) for (int rep_ = 0; rep_ < REPS(11); ++rep_) { const int nfg = (F.G == 256) ? POST_FG : (int)F.G;
        if ((int)blockIdx.x < nfg) { PHASE_FRAME(); post::post_phase(Fp, args, 1, args.x, nfg); }
        { PHASE_FRAME(); bg_convert(Fp, args, 1, 11, 0u, false); } }
    SEAM(11);
    if (IN(12)) for (int rep_ = 0; rep_ < REPS(12); ++rep_) { PHASE_FRAME();
        const gm::MoeTab tb = moe_tables(Fp, args, 1);
        gm::MoeProb<true> P{(const char*)(ws + WS_HX2), (const char*)(ws + WS_WUP) + (size_t)32 * 2048 * 1024, 1024u, 1024u, 1024, 8, F.G, (int)blockIdx.x, tb, (const int*)(ws + WS_LIST), (size_t)2048 * 1024, (size_t)256 * 1024};
        gm::EpiSwiglu E{ws + WS_ACT, args.b_up + 32 * 2048};
        gm::gemm_phase(Fp.lds, Fp.tid, P, E);
    }
    SEAM(12);
    if (IN(13)) for (int rep_ = 0; rep_ < REPS(13); ++rep_) { PHASE_FRAME();
        const gm::MoeTab tb = moe_tables(Fp, args, 1);
        if (STAGGER && (blockIdx.x & 1)) for (int i_ = 0; i_ < STAGGER; ++i_) __builtin_amdgcn_s_sleep(64);
        gm::MoeProb<false> P{(const char*)(ws + WS_ACT), (const char*)(ws + WS_WDN) + (size_t)32 * 1024 * 1024, 1024u, 1024u, 1024, 4, F.G, (int)blockIdx.x, tb, (const int*)(ws + WS_LIST), (size_t)1024 * 1024, (size_t)256 * 1024};
        gm::EpiDown E{ws + WS_Y, args.b_down + 32 * D, (const float*)(ws + WS_GATE), (const int*)(ws + WS_LIST), tb, Fp.lds};
        gm::gemm_phase(Fp.lds, Fp.tid, P, E);
    }
    SEAM(13);
    if (IN(14)) for (int rep_ = 0; rep_ < REPS(14); ++rep_) { PHASE_FRAME(); if (Y_SORTED) (void)moe_tables(Fp, args, 1); combine_phase<1>(Fp, args); }
#undef IN
#undef SEAM
#undef PHASE_FRAME
}

extern "C" void kernel_launch(void* const* d_in, const int* in_sizes, int n_in, void* d_out, int out_size, void* d_ws, size_t ws_size, hipStream_t stream) {
    static int grid = 0;
    if (grid == 0) {
        if (n_in != 19 || in_sizes[0] != L * D || out_size != L * D || ws_size < WS_END) { fprintf(stderr, "kernel_launch: unexpected problem (n_in %d, in0 %d, out %d, ws %zu); nothing launched\n", n_in, n_in > 0 ? in_sizes[0] : -1, out_size, ws_size); grid = -1; return; }
        int dev = 0, cus = 0, per_cu = 0;
        if (hipGetDevice(&dev) != hipSuccess || hipDeviceGetAttribute(&cus, hipDeviceAttributeMultiprocessorCount, dev) != hipSuccess) { grid = -1; return; }
        if (hipFuncSetAttribute((const void*)mk_fwd, hipFuncAttributeMaxDynamicSharedMemorySize, LDS_BYTES) != hipSuccess) { fprintf(stderr, "kernel_launch: hipFuncSetAttribute failed\n"); grid = -1; return; }
        if (hipOccupancyMaxActiveBlocksPerMultiprocessor(&per_cu, (const void*)mk_fwd, NT, LDS_BYTES) != hipSuccess || per_cu < 1) fprintf(stderr, "kernel_launch: occupancy query reports %d workgroups per CU\n", per_cu);
        (void)hipGetLastError();
        grid = cus;
    }
    if (grid < 0) return;
    (void)hipMemsetAsync((char*)d_ws + WS_CTL, 0, CTL_ZERO_BYTES, stream);
    Args a{};
    a.x = (const float*)d_in[0]; a.c = (const float*)d_in[1]; a.ctx = (const float*)d_in[2]; a.c_ctx = (const float*)d_in[3]; a.ada_w = (const float*)d_in[4]; a.ada_b = (const float*)d_in[5];
    a.norm_g = (const float*)d_in[6]; a.w_qkv = (const float*)d_in[7]; a.w_o = (const float*)d_in[8]; a.rpb = (const float*)d_in[9]; a.pool_w = (const float*)d_in[10]; a.pool_b = (const float*)d_in[11];
    a.pool_scale = (const float*)d_in[12]; a.w_router = (const float*)d_in[13]; a.b_router = (const float*)d_in[14]; a.w_up = (const float*)d_in[15]; a.b_up = (const float*)d_in[16];
    a.w_down = (const float*)d_in[17]; a.b_down = (const float*)d_in[18];
    a.out = (float*)d_out; a.ws = (unsigned char*)d_ws;
#if MK_ONE_LAUNCH
    a.ph_lo = 0; a.ph_hi = N_PHASES;
    hipLaunchKernelGGL(mk_fwd, dim3(grid), dim3(NT), LDS_BYTES, stream, a);
#else
    for (int p = 0; p < N_PHASES; ++p) { a.ph_lo = p; a.ph_hi = p + 1; hipLaunchKernelGGL(mk_fwd, dim3(grid), dim3(NT), LDS_BYTES, stream, a); }
#endif
}
```

```cpp
#include <hip/hip_runtime.h>
#include <cstdio>
#include <cstdint>

#ifndef Y_FP8
#define Y_FP8 1
#endif
#ifndef MK_ONE_LAUNCH
#define MK_ONE_LAUNCH 1
#ifndef PROBE_HOT
#define PROBE_HOT 0
#endif
#ifndef PROBE_NT5
#define PROBE_NT5 0
#endif
#ifndef PROBE_NOEPI
#define PROBE_NOEPI 0
#endif
#ifndef QKV_FP8
#define QKV_FP8 1
#endif
#endif

#define GAS __attribute__((address_space(1)))
#define LAS __attribute__((address_space(3)))
typedef unsigned short bf16_t;
typedef short bf16x8 __attribute__((ext_vector_type(8)));
typedef short s16x4 __attribute__((ext_vector_type(4)));
typedef float f32x4 __attribute__((ext_vector_type(4)));
typedef float f32x2 __attribute__((ext_vector_type(2)));
typedef unsigned u32x4 __attribute__((ext_vector_type(4)));
typedef unsigned u32x2 __attribute__((ext_vector_type(2)));
typedef int v8i __attribute__((ext_vector_type(8)));
typedef int v4i __attribute__((ext_vector_type(4)));

constexpr int L = 16384, D = 1024, CTX = 256, NH = 16, HD = 64, NE = 32, GW = 64;
constexpr int MQ = L + CTX;
constexpr float RMS_EPS = 1e-6f;
constexpr float LOG2E = 1.4426950408889634f;
constexpr float QSCALE = 0.125f * LOG2E;
constexpr int NWAVES = 8, NT = 512;

constexpr size_t MiB = 1u << 20;
constexpr size_t WS_CTL = 0, CTL_ZERO_BYTES = 128 * 1024;
constexpr size_t WS_MOD = 1 * MiB;
constexpr size_t WS_POS = 1 * MiB + 256 * 1024;
constexpr size_t WS_VEC = 1 * MiB + 512 * 1024;
constexpr size_t WS_WRT = 1 * MiB + 768 * 1024;
constexpr size_t WS_WQKV = 2 * MiB;
constexpr size_t WS_WO = 8 * MiB;
constexpr size_t WS_WPOOL = 10 * MiB;
constexpr size_t WS_LIST = 12 * MiB;
constexpr size_t WS_GATE = 14 * MiB;
constexpr size_t WS_HX = 16 * MiB;
constexpr size_t WS_Q = 50 * MiB, WS_K = 83 * MiB, WS_V = 116 * MiB;
constexpr size_t WS_O = 150 * MiB;
constexpr size_t WS_MX = 182 * MiB;
constexpr size_t WS_HX2 = 214 * MiB;
constexpr size_t WS_ACT = 256 * MiB;
constexpr size_t WS_Y = 408 * MiB;
constexpr size_t WS_WUP = 544 * MiB;
constexpr size_t WS_WDN = 816 * MiB;
constexpr size_t WS_XR = 952 * MiB;
constexpr size_t WS_END = 984 * MiB;
constexpr int CW_BAR = 4096;
constexpr int CW_CNT = 16384;
constexpr int CW_Q = 20480;
constexpr int CW_DONE = 24576;
constexpr int ACT_ROWS = 73728, LIST_CAP = 16384;

constexpr int RING_BYTES = 131072;
constexpr int MISC_OFF = RING_BYTES;
constexpr int M_PRE = MISC_OFF + 8192;
#ifndef Y_SORTED
#define Y_SORTED 1
#endif
#ifndef EPI_STAGE
#define EPI_STAGE 1
#endif
constexpr int STG0 = 3 * 16384;
constexpr int STG1 = 147456;
constexpr int LDS_BYTES = EPI_STAGE ? 163840 : 147456;

#define LDS_WAIT() asm volatile("s_waitcnt lgkmcnt(0)" ::: "memory")
#define VM_WAIT() asm volatile("s_waitcnt vmcnt(0)" ::: "memory")

typedef __bf16 bf16x2_t __attribute__((ext_vector_type(2)));
__device__ __forceinline__ unsigned cvt_pk_bf16(float lo, float hi) { const f32x2 v = {lo, hi}; return __builtin_bit_cast(unsigned, __builtin_convertvector(v, bf16x2_t)); }
__device__ __forceinline__ float clamp448(float v) { return __builtin_amdgcn_fmed3f(v, -448.0f, 448.0f); }
__device__ __forceinline__ unsigned cvt_pk4_fp8(float a, float b, float c, float d) { int w = __builtin_amdgcn_cvt_pk_fp8_f32(a, b, 0, false); w = __builtin_amdgcn_cvt_pk_fp8_f32(c, d, w, true); return (unsigned)w; }
__device__ __forceinline__ unsigned cvt_pk4_fp8_sat(float a, float b, float c, float d) { return cvt_pk4_fp8(clamp448(a), clamp448(b), clamp448(c), clamp448(d)); }
__device__ __forceinline__ float bf_lo(unsigned u) { return __uint_as_float(u << 16); }
__device__ __forceinline__ float bf_hi(unsigned u) { return __uint_as_float(u & 0xffff0000u); }
#ifndef WT_STORES
#define WT_STORES 0
#endif
__device__ __forceinline__ void st16(void* p, u32x4 v) {
#if WT_STORES
    asm volatile("global_store_dwordx4 %0, %1, off sc1\n\ts_nop 1" :: "v"(p), "v"(v) : "memory");
#else
    *(u32x4*)p = v;
#endif
}
#ifndef ROW_NT
#define ROW_NT 2
#endif
#ifndef ROW_LD_NT
#define ROW_LD_NT 0
#endif
#ifndef CONV_NT
#define CONV_NT 1
#endif
#ifndef STAGE_NT
#define STAGE_NT 1
#endif
#ifndef NT_DOWN
#define NT_DOWN 0
#endif
__device__ __forceinline__ void st16nt(void* p, u32x4 v) { __builtin_nontemporal_store(v, (u32x4*)p); }
__device__ __forceinline__ void st8(void* p, u32x2 v) {
#if 0
    asm volatile("global_store_dwordx2 %0, %1, off sc1\n\ts_nop 1" :: "v"(p), "v"(v) : "memory");
#else
    *(u32x2*)p = v;
#endif
}
__device__ __forceinline__ void st4(void* p, unsigned v) {
#if 0
    asm volatile("global_store_dword %0, %1, off sc1\n\ts_nop 1" :: "v"(p), "v"(v) : "memory");
#else
    *(unsigned*)p = v;
#endif
}
__device__ __forceinline__ float wave_sum(float v) {
    v += __builtin_bit_cast(float, __builtin_amdgcn_update_dpp(0, __builtin_bit_cast(int, v), 0xB1, 0xf, 0xf, true));
    v += __builtin_bit_cast(float, __builtin_amdgcn_update_dpp(0, __builtin_bit_cast(int, v), 0x4E, 0xf, 0xf, true));
    v += __builtin_bit_cast(float, __builtin_amdgcn_update_dpp(0, __builtin_bit_cast(int, v), 0x124, 0xf, 0xf, true));
    v += __builtin_bit_cast(float, __builtin_amdgcn_update_dpp(0, __builtin_bit_cast(int, v), 0x128, 0xf, 0xf, true));
    v += __builtin_bit_cast(float, __builtin_amdgcn_ds_swizzle(__builtin_bit_cast(int, v), 0x401F));
    return __builtin_bit_cast(float, __builtin_amdgcn_readlane(__builtin_bit_cast(int, v), 0)) + __builtin_bit_cast(float, __builtin_amdgcn_readlane(__builtin_bit_cast(int, v), 32));
}

#define XB_TMO      128
#define XB_XCNT(j)  (256  + 64 * (j))
#define XB_XSUB(j)  (1280 + 64 * (j))
#define XB_XGEN(j)  (2304 + 64 * (j))
#define XB_TOP      3328
#define XB_TOPGEN   3392
#define XCD_BAR_WORDS 3456
#define XB_SPIN_CAP (1u << 18)
__device__ __forceinline__ unsigned xb_ld(unsigned* p)              { return __hip_atomic_load(p, __ATOMIC_RELAXED, __HIP_MEMORY_SCOPE_AGENT); }
__device__ __forceinline__ unsigned xb_add(unsigned* p, unsigned v) { return __hip_atomic_fetch_add(p, v, __ATOMIC_RELAXED, __HIP_MEMORY_SCOPE_AGENT); }
__device__ __forceinline__ unsigned xb_xcc_id() { return (unsigned)__builtin_amdgcn_s_getreg((3 << 11) | 20) & 0xFu; }
#define XB_SPIN(cond, bar) do { unsigned _sp = 0; while (cond) { __builtin_amdgcn_s_sleep(1); \
    if ((++_sp & 255u) == 0u) { if (xb_ld(&(bar)[XB_TMO])) break; if (_sp > XB_SPIN_CAP) { atomicAdd(&(bar)[XB_TMO], 1u); break; } } } } while (0)
struct XcdBarrier { unsigned* bar; unsigned x; volatile LAS unsigned* st; };
__device__ __forceinline__ XcdBarrier xcd_barrier_post(unsigned* bar, volatile LAS unsigned* st, bool leader) {
    XcdBarrier b; b.bar = bar; b.x = xb_xcc_id(); b.st = st;
    if (leader) (void)xb_add(&bar[XB_XCNT(b.x)], 1u);
    return b;
}
__device__ __forceinline__ void xcd_barrier_complete(unsigned* bar, unsigned x, unsigned& nloc, unsigned& nx) {
    const unsigned G = gridDim.x * gridDim.y * gridDim.z;
    unsigned sum, cnt, mine, sp = 0u;
    for (;;) {
        sum = 0u; cnt = 0u; mine = 0u;
#pragma unroll
        for (unsigned j = 0; j < 16; ++j) { const unsigned c = xb_ld(&bar[XB_XCNT(j)]); sum += c; cnt += (c > 0u) ? 1u : 0u; mine = (j == x) ? c : mine; }
        if (sum == G) break;
        __builtin_amdgcn_s_sleep(1);
        if ((++sp & 255u) == 0u) { if (xb_ld(&bar[XB_TMO])) break; if (sp > XB_SPIN_CAP) { atomicAdd(&bar[XB_TMO], 1u); break; } }
    }
    nloc = mine > 0u ? mine : 1u; nx = cnt > 0u ? cnt : 1u;
}
__device__ __forceinline__ void xcd_barrier(const XcdBarrier& b, bool leader) {
    asm volatile("s_waitcnt vmcnt(0)" ::: "memory");
    __syncthreads();
    if (leader) {
        unsigned* bar = b.bar;
        __builtin_amdgcn_s_waitcnt(0);
        unsigned nloc = b.st[0], nx = b.st[1];
        if (nloc == 0u) { xcd_barrier_complete(bar, b.x, nloc, nx); b.st[0] = nloc; b.st[1] = nx; }
        const unsigned old = xb_add(&bar[XB_XSUB(b.x)], 1u);
        const unsigned gen = old / nloc;
        if (old + 1u == (gen + 1u) * nloc) {
            __builtin_amdgcn_fence(__ATOMIC_RELEASE, "agent");
            asm volatile("s_waitcnt vmcnt(0)" ::: "memory");
            const unsigned og = xb_add(&bar[XB_TOP], 1u);
            const unsigned tg = og / nx;
            if (og + 1u == (tg + 1u) * nx) xb_add(&bar[XB_TOPGEN], 1u);
            else XB_SPIN(xb_ld(&bar[XB_TOPGEN]) == tg, bar);
            __builtin_amdgcn_fence(__ATOMIC_ACQUIRE, "agent");
            xb_add(&bar[XB_XGEN(b.x)], 1u);
            asm volatile("s_waitcnt vmcnt(0)" ::: "memory");
        } else {
            XB_SPIN(xb_ld(&bar[XB_XGEN(b.x)]) == gen, bar);
            __builtin_amdgcn_fence(__ATOMIC_ACQUIRE, "agent");
            asm volatile("s_waitcnt vmcnt(0)" ::: "memory");
        }
    }
    __syncthreads();
}

#ifndef K_ROT
#define K_ROT 0
#endif
namespace gm {
constexpr int BM = 256, BK = 64, HALF = 128, HTB = HALF * BK * 2, STAGE_BYTES = 8 * HTB, NXCD = 8, WGM = 8;
__device__ __forceinline__ int lds_byte(int r, int c) { const int st = (r >> 4) * 2 + (c >> 5), rr = r & 15, cc = c & 31, ob = rr * 64 + cc * 2; return st * 1024 + (ob ^ (((ob >> 9) & 1) << 5)); }
__device__ __forceinline__ void stage_rc(int b, int& R, int& C) { const int st = b / 1024, sb = b % 1024, swz = sb ^ (((sb >> 9) & 1) << 5); R = (st >> 1) * 16 + swz / 64; C = (st & 1) * 32 + (swz % 64) / 2; }
__device__ __forceinline__ int perm32(int rho) { const int n = rho >> 4, i = rho & 15; return 8 * (i >> 2) + 4 * n + (i & 3); }

struct Unit { int pm, pn, e, aux, rot; const char* Ab; const char* Bb; };

__device__ __forceinline__ bool static_order(int i, int G, int c, int nM, int nN, int& pm, int& pn) {
    const int nwg = nM * nN; const int Lx = i * G + c; if (Lx >= nwg) return false;
    int wgid = Lx; { const int q = nwg / NXCD, r = nwg % NXCD, xcd = wgid % NXCD, off = wgid / NXCD; wgid = (xcd < r ? xcd * (q + 1) : r * (q + 1) + (xcd - r) * q) + off; }
    const int nig = WGM * nN, gid = wgid / nig, fm = gid * WGM, gsz = (nM - fm) < WGM ? (nM - fm) : WGM;
    pm = fm + ((wgid % nig) % gsz); pn = (wgid % nig) / gsz; return true;
}

template <class Prob, class Epi>
__device__ __forceinline__ void gemm_phase(LAS unsigned char* lds, const int tid, const Prob& P, const Epi& E) {
    const int wid = __builtin_amdgcn_readfirstlane(tid >> 6), lane = tid & 63, wr = wid >> 2, wc = wid & 3, fr = lane & 15, fq = lane >> 4;
    const int nt = Prob::FP8 ? P.K / 128 : P.K / BK;
    int Rl[2], Cl[2]; unsigned offB[2];
#pragma unroll
    for (int i = 0; i < 2; ++i) { int R, C; stage_rc(tid * 16 + i * 8192, R, C); const int Rb = (R & ~31) + perm32(R & 31); Rl[i] = R; Cl[i] = C; offB[i] = (unsigned)Rb * P.ldb + (unsigned)C * 2u; }
    const size_t hB = (size_t)HALF * P.ldb;
    const unsigned ldsw = (unsigned)wid * 1024u;
    const int aoff = lds_byte(wr * 64 + fr, fq * 8), boff = lds_byte(wc * 32 + fr, fq * 8);
#define GM_SA(b, h) (((b) * 2 + (h)) * HTB)
#define GM_SB(b, h) ((4 + (b) * 2 + (h)) * HTB)
#define GM_STAGE(bufoff, gbase, voff, kb) do { _Pragma("unroll") for (int _i = 0; _i < 2; ++_i)   \
        __builtin_amdgcn_global_load_lds((const unsigned*)((const char*)(gbase) + ((voff)[_i] + (unsigned)(kb))), (LAS unsigned*)(lds + (bufoff) + ldsw + _i * 8192), 16, 0, 0); } while (0)
#define GM_LD8(addr) __builtin_shufflevector(*(const LAS v4i*)(addr), *(const LAS v4i*)((addr) + 1024), 0, 1, 2, 3, 4, 5, 6, 7)
#define GM_LDA(dst, b, h) do { _Pragma("unroll") for (int m = 0; m < 4; ++m) dst[m] = GM_LD8(lds + GM_SA(b, h) + aoff + m * 2048); } while (0)
#define GM_LDB(dst, b, h) do { _Pragma("unroll") for (int n = 0; n < 2; ++n) dst[n] = GM_LD8(lds + GM_SB(b, h) + boff + n * 2048); } while (0)
#define GM_LO(x) __builtin_bit_cast(bf16x8, __builtin_shufflevector(x, x, 0, 1, 2, 3))
#define GM_HI(x) __builtin_bit_cast(bf16x8, __builtin_shufflevector(x, x, 4, 5, 6, 7))
#define GM_MMA(ai, bj, At, Bt) do { __builtin_amdgcn_s_setprio(1); _Pragma("unroll") for (int m = 0; m < 4; ++m) _Pragma("unroll") for (int n = 0; n < 2; ++n) { \
        if (Prob::FP8)   \
            acc[ai][bj][m][n] = __builtin_amdgcn_mfma_scale_f32_16x16x128_f8f6f4(Bt[n], At[m], acc[ai][bj][m][n], 0, 0, 0, 0, 0, 0); \
        else { acc[ai][bj][m][n] = __builtin_amdgcn_mfma_f32_16x16x32_bf16(GM_LO(Bt[n]), GM_LO(At[m]), acc[ai][bj][m][n], 0, 0, 0); \
               acc[ai][bj][m][n] = __builtin_amdgcn_mfma_f32_16x16x32_bf16(GM_HI(Bt[n]), GM_HI(At[m]), acc[ai][bj][m][n], 0, 0, 0); } } \
        __builtin_amdgcn_s_setprio(0); } while (0)
#define GM_WAIT_V(n) asm volatile("s_waitcnt vmcnt(" #n ")" ::: "memory")
#define GM_WAIT_L(n) asm volatile("s_waitcnt lgkmcnt(" #n ")" ::: "memory")
#define GM_BAR __builtin_amdgcn_s_barrier()
#define GM_SCHED __builtin_amdgcn_sched_barrier(0)
    Unit cur, nxt; int ui = 0;
    if (!P.next(0, cur)) return;
    unsigned offC[2][2];
    P.a_off(cur, Rl, Cl, offC);
    f32x4 acc[2][2][4][2];
#pragma unroll
    for (int a = 0; a < 2; ++a)
#pragma unroll
        for (int b = 0; b < 2; ++b)
#pragma unroll
            for (int m = 0; m < 4; ++m)
#pragma unroll
                for (int n = 0; n < 2; ++n) acc[a][b][m][n] = (f32x4){0.f, 0.f, 0.f, 0.f};
    v8i At[4], B0[2], B1[2];
    typename Epi::Pre pre;
    const char* cA = cur.Ab; const char* cB = cur.Bb;
    const int ntm = nt - 1;
#define GM_KB(t_, r_) ((((t_) + (r_)) & ntm) << 7)
    { const int p0 = GM_KB(0, cur.rot), p1 = GM_KB(1, cur.rot);
    GM_STAGE(GM_SB(0, 0), cB, offB, p0); GM_STAGE(GM_SB(0, 1), cB + hB, offB, p0); GM_STAGE(GM_SA(0, 0), cA, offC[0], p0); GM_STAGE(GM_SA(0, 1), cA, offC[1], p0);
    if (wr == 1) GM_BAR;
    GM_WAIT_V(2); GM_BAR;
    GM_STAGE(GM_SB(1, 0), cB, offB, p1); GM_STAGE(GM_SA(1, 0), cA, offC[0], p1); GM_STAGE(GM_SB(1, 1), cB + hB, offB, p1); }
    GM_WAIT_V(6); GM_BAR;
    for (;;) {
        const bool has_next = P.next(ui + 1, nxt);
        unsigned offN[2][2] = {{0u, 0u}, {0u, 0u}};
        if (Prob::GATHER) { if (has_next) P.a_raw(nxt, Rl, offN); }
        const char* nA = has_next ? nxt.Ab : cA; const char* nB = has_next ? nxt.Bb : cB; const int rc = cur.rot, rn = has_next ? nxt.rot : rc;
        for (int t = 0; t < nt; t += 2) {
            const bool last = (t == nt - 2);
            if (Epi::HAS_PRE) { if (last) { unsigned l_; asm volatile("v_mbcnt_lo_u32_b32 %0, -1, 0\n\tv_mbcnt_hi_u32_b32 %0, -1, %0" : "=v"(l_)); E.pre_load(pre, cur, wr, wc, (int)(l_ & 15u), (int)(l_ >> 4)); } }
            const char* ab = last ? nA : cA; const char* bb = last ? nB : cB;
            const int k1 = GM_KB(t + 1, rc), k2 = last ? GM_KB(0, rn) : GM_KB(t + 2, rc), k3 = last ? GM_KB(1, rn) : GM_KB(t + 3, rc);
            GM_LDB(B0, 0, 0); GM_LDB(B1, 0, 1); GM_SCHED; GM_LDA(At, 0, 0); GM_STAGE(GM_SA(1, 1), cA, offC[1], k1);
            if (Prob::GATHER) { if (last && has_next) {
#pragma unroll
                for (int h = 0; h < 2; ++h)
#pragma unroll
                    for (int i = 0; i < 2; ++i) offC[h][i] = (offN[h][i] >> 2) * P.lda + (unsigned)Cl[i] * 2u; } }
            GM_WAIT_V(8); GM_WAIT_L(0); GM_BAR; GM_MMA(0, 0, At, B0); GM_MMA(0, 1, At, B1); GM_BAR; GM_SCHED;
            GM_LDA(At, 0, 1); GM_STAGE(GM_SB(0, 0), bb, offB, k2); GM_STAGE(GM_SB(0, 1), bb + hB, offB, k2); GM_STAGE(GM_SA(0, 0), ab, offC[0], k2);
            GM_WAIT_V(8); GM_WAIT_L(0); GM_BAR; GM_MMA(1, 0, At, B0); GM_MMA(1, 1, At, B1); GM_BAR; GM_SCHED;
            GM_LDB(B0, 1, 0); GM_LDB(B1, 1, 1); GM_SCHED; GM_LDA(At, 1, 0); GM_STAGE(GM_SA(0, 1), ab, offC[1], k2);
            GM_WAIT_V(8); GM_WAIT_L(0); GM_BAR; GM_MMA(0, 0, At, B0); GM_MMA(0, 1, At, B1); GM_BAR; GM_SCHED;
            GM_LDA(At, 1, 1); GM_STAGE(GM_SB(1, 0), bb, offB, k3); GM_STAGE(GM_SB(1, 1), bb + hB, offB, k3); GM_STAGE(GM_SA(1, 0), ab, offC[0], k3);
            GM_WAIT_V(8); GM_WAIT_L(0); GM_BAR; GM_MMA(1, 0, At, B0); GM_MMA(1, 1, At, B1); GM_BAR; GM_SCHED;
        }
        if (wr == 0) GM_BAR;
        { unsigned l_; asm volatile("v_mbcnt_lo_u32_b32 %0, -1, 0\n\tv_mbcnt_hi_u32_b32 %0, -1, %0" : "=v"(l_));
          E(acc, cur, wr, wc, (int)(l_ & 15u), (int)(l_ >> 4), pre); }
        if (!has_next) break;
#pragma unroll
        for (int a = 0; a < 2; ++a)
#pragma unroll
            for (int b = 0; b < 2; ++b)
#pragma unroll
                for (int m = 0; m < 4; ++m)
#pragma unroll
                    for (int n = 0; n < 2; ++n) acc[a][b][m][n] = (f32x4){0.f, 0.f, 0.f, 0.f};
        cur = nxt; cA = nA; cB = nB; ++ui;
        if (wr == 1) GM_BAR;
    }
    GM_WAIT_V(0);
    GM_BAR;
#undef GM_SA
#undef GM_KB
#undef GM_SB
#undef GM_STAGE
#undef GM_LDA
#undef GM_LDB
#undef GM_LD8
#undef GM_LO
#undef GM_HI
#undef GM_MMA
#undef GM_WAIT_V
#undef GM_WAIT_L
#undef GM_BAR
#undef GM_SCHED
}

template <bool FP8_> struct DenseProbT {
    static constexpr bool GATHER = false, FP8 = FP8_;
    __device__ __forceinline__ void a_raw(const Unit&, const int (&)[2], unsigned (&)[2][2]) const {}
    const char* A; const char* B; unsigned lda, ldb; int K, nM, nN, G, c;
    int a_col_per_pn;
    size_t b_per_pn;
    __device__ __forceinline__ bool next(int i, Unit& u) const {
        int pm, pn; if (!static_order(i, G, c, nM, nN, pm, pn)) return false;
        u.pm = pm; u.pn = pn; u.e = 0; u.aux = 0; u.rot = K_ROT ? pm + 2 * pn : 0; u.Ab = A + (size_t)pm * BM * lda + (size_t)pn * a_col_per_pn; u.Bb = B + (size_t)pn * b_per_pn; return true;
    }
    __device__ __forceinline__ void a_off(const Unit&, const int (&Rl)[2], const int (&Cl)[2], unsigned (&off)[2][2]) const {
#pragma unroll
        for (int h = 0; h < 2; ++h)
#pragma unroll
            for (int i = 0; i < 2; ++i) off[h][i] = (unsigned)(h * HALF + Rl[i]) * lda + (unsigned)Cl[i] * 2u;
    }
};
using DenseProb = DenseProbT<false>;
struct OneProb {
    static constexpr bool GATHER = false, FP8 = false;
    __device__ __forceinline__ void a_raw(const Unit&, const int (&)[2], unsigned (&)[2][2]) const {}
    const char* A; const char* B; unsigned lda, ldb; int K, pm, pn; size_t b_per_pn;
    __device__ __forceinline__ bool next(int i, Unit& u) const { if (i != 0) return false; u.pm = pm; u.pn = pn; u.e = 0; u.aux = 0; u.rot = 0; u.Ab = A + (size_t)pm * BM * lda; u.Bb = B + (size_t)pn * b_per_pn; return true; }
    __device__ __forceinline__ void a_off(const Unit&, const int (&Rl)[2], const int (&Cl)[2], unsigned (&off)[2][2]) const {
#pragma unroll
        for (int h = 0; h < 2; ++h)
#pragma unroll
            for (int i = 0; i < 2; ++i) off[h][i] = (unsigned)(h * HALF + Rl[i]) * lda + (unsigned)Cl[i] * 2u;
    }
};
struct MoeTab { LAS int* tstart; LAS int* cnt; LAS unsigned char* tile_e; int T; };
template <bool GATHER_> struct MoeProb {
    static constexpr bool GATHER = GATHER_, gather = GATHER_, FP8 = true;
    const char* A; const char* B; unsigned lda, ldb; int K, nN, G, c; MoeTab tb; const int* list; size_t b_per_e, b_per_pn;
#if PROBE_HOT == 2
    bool same = false;
#endif
    __device__ __forceinline__ bool next(int i, Unit& u) const {
        int pm, pn; if (!static_order(i, G, c, tb.T, nN, pm, pn)) return false;
        const int e = __builtin_amdgcn_readfirstlane((int)tb.tile_e[pm]);
        u.pm = pm; u.pn = pn; u.e = e; u.rot = K_ROT ? pm + 2 * pn : 0; u.aux = (pm - __builtin_amdgcn_readfirstlane(tb.tstart[e])) * BM;
        u.Ab = gather ? A : A + (size_t)pm * BM * lda; u.Bb = B + (size_t)e * b_per_e + (size_t)pn * b_per_pn;
#if PROBE_HOT == 2
        if (same) { u.Ab = A; u.Bb = B; }
#endif
        return true;
    }
    __device__ __forceinline__ void a_raw(const Unit& u, const int (&Rl)[2], unsigned (&raw)[2][2]) const {
        const int n = __builtin_amdgcn_readfirstlane(tb.cnt[u.e]);
#pragma unroll
        for (int h = 0; h < 2; ++h)
#pragma unroll
            for (int i = 0; i < 2; ++i) { const int p = u.aux + h * HALF + Rl[i]; raw[h][i] = (p < n) ? (unsigned)list[u.e * LIST_CAP + p] : 0u; }
    }
    __device__ __forceinline__ void a_off(const Unit& u, const int (&Rl)[2], const int (&Cl)[2], unsigned (&off)[2][2]) const {
        if (gather) {
            const int n = __builtin_amdgcn_readfirstlane(tb.cnt[u.e]);
#pragma unroll
            for (int h = 0; h < 2; ++h)
#pragma unroll
                for (int i = 0; i < 2; ++i) { const int p = u.aux + h * HALF + Rl[i]; int tok = 0; if (p < n) tok = list[u.e * LIST_CAP + p] >> 2; off[h][i] = (unsigned)tok * lda + (unsigned)Cl[i] * 2u; }
        } else {
#pragma unroll
            for (int h = 0; h < 2; ++h)
#pragma unroll
                for (int i = 0; i < 2; ++i) off[h][i] = (unsigned)(h * HALF + Rl[i]) * lda + (unsigned)Cl[i] * 2u;
        }
    }
};

struct EpiBf16 {
    struct Pre {}; static constexpr bool HAS_PRE = false; __device__ __forceinline__ void pre_load(Pre&, const Unit&, int, int, int, int) const {}
    bf16_t* O; int ldc; const float* bias; const float* cscale; int split_cols; size_t split_stride; float scale0; int col_per_pn; float mul;
    __device__ __forceinline__ void operator()(const f32x4 (&acc)[2][2][4][2], const Unit& u, int wr, int wc, int fr, int fq, const Pre&) const {
        const int row0 = u.pm * BM + wr * 64 + fr; int colt = u.pn * col_per_pn; bf16_t* base = O;
        float sc = mul; if (split_cols) { const int t = colt / split_cols; base += (size_t)t * split_stride; colt -= t * split_cols; if (t == 0) sc = scale0 * mul; }
        const int col0 = colt + wc * 32 + 8 * fq, bcol0 = u.pn * col_per_pn + wc * 32 + 8 * fq;
        f32x4 bv[2][2], sv[2][2];
#pragma unroll
        for (int bj = 0; bj < 2; ++bj)
#pragma unroll
            for (int n = 0; n < 2; ++n) { bv[bj][n] = bias ? *(const f32x4*)(bias + bcol0 + bj * HALF + 4 * n) : (f32x4){0.f, 0.f, 0.f, 0.f};
                                          sv[bj][n] = cscale ? *(const f32x4*)(cscale + bcol0 + bj * HALF + 4 * n) : (f32x4){1.f, 1.f, 1.f, 1.f}; }
#pragma unroll
        for (int ai = 0; ai < 2; ++ai)
#pragma unroll
            for (int m = 0; m < 4; ++m) { bf16_t* rowp = base + (size_t)(row0 + ai * HALF + m * 16) * ldc + col0;
#pragma unroll
                for (int bj = 0; bj < 2; ++bj) { f32x4 v0 = (acc[ai][bj][m][0] + bv[bj][0]) * sv[bj][0] * sc, v1 = (acc[ai][bj][m][1] + bv[bj][1]) * sv[bj][1] * sc;
                    u32x4 w; w.x = cvt_pk_bf16(v0[0], v0[1]); w.y = cvt_pk_bf16(v0[2], v0[3]); w.z = cvt_pk_bf16(v1[0], v1[1]); w.w = cvt_pk_bf16(v1[2], v1[3]);
                    st16(rowp + bj * HALF, w); } }
    }
};
struct EpiSwiglu {
    struct Pre { f32x4 bgl[2], bln[2]; }; static constexpr bool HAS_PRE = true;
    unsigned char* act; const float* bup;
#if PROBE_NOEPI
    bool skip = false;
#endif
    __device__ __forceinline__ void pre_load(Pre& p, const Unit& u, int, int wc, int, int fq) const {
        const float* bg = bup + (size_t)u.e * 2048 + u.pn * HALF + wc * 32 + 8 * fq;
#pragma unroll
        for (int n = 0; n < 2; ++n) { p.bgl[n] = *(const f32x4*)(bg + 4 * n); p.bln[n] = *(const f32x4*)(bg + 1024 + 4 * n); }
    }
    __device__ __forceinline__ void operator()(const f32x4 (&acc)[2][2][4][2], const Unit& u, int wr, int wc, int fr, int fq, const Pre& pr) const {
#if PROBE_NOEPI == 1
        if (skip) return;
#endif
        const int row0 = u.pm * BM + wr * 64 + fr, col0 = u.pn * HALF + wc * 32 + 8 * fq;
        const f32x4 (&bgl)[2] = pr.bgl; const f32x4 (&bln)[2] = pr.bln;
#pragma unroll
        for (int ai = 0; ai < 2; ++ai)
#pragma unroll
            for (int m = 0; m < 4; ++m) {
                float o[8];
#pragma unroll
                for (int n = 0; n < 2; ++n)
#pragma unroll
                    for (int jp = 0; jp < 2; ++jp) {
                        const f32x2 a0 = {acc[ai][0][m][n][2 * jp], acc[ai][0][m][n][2 * jp + 1]}, a1 = {acc[ai][1][m][n][2 * jp], acc[ai][1][m][n][2 * jp + 1]};
                        const f32x2 bg2 = {bgl[n][2 * jp], bgl[n][2 * jp + 1]}, bl2 = {bln[n][2 * jp], bln[n][2 * jp + 1]};
                        f32x2 g = a0 * 0.015625f + bg2, l = a1 * 0.015625f + bl2;
                        g.x = fminf(g.x, 7.0f); g.y = fminf(g.y, 7.0f); l.x = __builtin_amdgcn_fmed3f(l.x, -7.0f, 7.0f); l.y = __builtin_amdgcn_fmed3f(l.y, -7.0f, 7.0f);
                        const f32x2 t = g * (-1.702f * LOG2E);
                        f32x2 e; e.x = __builtin_amdgcn_exp2f(t.x); e.y = __builtin_amdgcn_exp2f(t.y);
                        const f32x2 d = e + 1.0f;
                        f32x2 r; r.x = __builtin_amdgcn_rcpf(d.x); r.y = __builtin_amdgcn_rcpf(d.y);
                        const f32x2 gr = g * r, oo = gr * l + gr;
                        o[n * 4 + 2 * jp] = oo.x; o[n * 4 + 2 * jp + 1] = oo.y;
                    }
                u32x2 w; w.x = cvt_pk4_fp8(o[0], o[1], o[2], o[3]); w.y = cvt_pk4_fp8(o[4], o[5], o[6], o[7]);
#if PROBE_NOEPI == 3
                if (skip) asm volatile("" :: "v"(w.x), "v"(w.y)); else
#endif
                st8(act + (size_t)(row0 + ai * HALF + m * 16) * D + col0, w);
            }
    }
};
struct EpiDown {
    struct Pre {}; static constexpr bool HAS_PRE = true;
    unsigned char* Y; const float* bdn; const float* gate; const int* list; MoeTab tb; LAS unsigned char* lds;
#if PROBE_NOEPI
    bool skip = false;
#endif
    __device__ __forceinline__ void pre_load(Pre&, const Unit& u, int wr, int wc, int fr, int fq) const {
        const int w = wr * 4 + wc, lane = fq * 16 + fr;
        const unsigned* src = (w < 4 ? (const unsigned*)list : (const unsigned*)gate) + (u.e * LIST_CAP + u.aux + (w & 3) * 64 + lane);
        __builtin_amdgcn_global_load_lds(src, (LAS unsigned*)(lds + M_PRE + w * 256), 4, 0, 0);
        if (w < 4) __builtin_amdgcn_global_load_lds((const unsigned*)(bdn + (size_t)u.e * D + u.pn * BM + w * 64 + lane), (LAS unsigned*)(lds + M_PRE + 2048 + w * 256), 4, 0, 0);
    }
    __device__ __forceinline__ void operator()(const f32x4 (&acc)[2][2][4][2], const Unit& u, int wr, int wc, int fr, int fq, const Pre&) const {
#if PROBE_NOEPI == 1
        if (skip) return;
#endif
        const int n = __builtin_amdgcn_readfirstlane(tb.cnt[u.e]);
        const int col0 = u.pn * BM + wc * 32 + 8 * fq;
        const LAS int* ps = (const LAS int*)(lds + M_PRE); const LAS float* pg = (const LAS float*)(lds + M_PRE + 1024); const LAS float* pb = (const LAS float*)(lds + M_PRE + 2048) + wc * 32 + 8 * fq;
        f32x4 bv[2][2];
#pragma unroll
        for (int bj = 0; bj < 2; ++bj)
#pragma unroll
            for (int nn = 0; nn < 2; ++nn) bv[bj][nn] = *(const LAS f32x4*)(pb + bj * HALF + 4 * nn);
#if Y_FP8 && EPI_STAGE
        { const int lane = fq * 16 + fr, w = wr * 4 + wc;
        unsigned char* ybase = Y + u.pn * BM + (lane & 15) * 16;
#pragma unroll
        for (int p = 0; p < 4; ++p) {
            const int ai = p >> 1, mh = p & 1;
            LAS unsigned char* stg = lds + ((p & 1) ? STG1 : STG0);
#pragma unroll
            for (int mm = 0; mm < 2; ++mm) { const int m = 2 * mh + mm, lr = wr * 32 + mm * 16 + fr;
                const float g16 = pg[ai * HALF + wr * 64 + m * 16 + fr] * 4.0f;
#pragma unroll
                for (int bj = 0; bj < 2; ++bj) { const f32x4 v0 = (acc[ai][bj][m][0] * 0.015625f + bv[bj][0]) * g16, v1 = (acc[ai][bj][m][1] * 0.015625f + bv[bj][1]) * g16;
                    u32x2 wv; wv.x = cvt_pk4_fp8(v0[0], v0[1], v0[2], v0[3]); wv.y = cvt_pk4_fp8(v1[0], v1[1], v1[2], v1[3]);
                    const int chunk = bj * 8 + wc * 2 + (fq >> 1);
                    *(LAS u32x2*)(stg + lr * 256 + ((chunk ^ (lr & 15)) << 4) + (fq & 1) * 8) = wv; } }
            LDS_WAIT(); __builtin_amdgcn_s_barrier();
#pragma unroll
            for (int k = 0; k < 2; ++k) { const int lr = k * 32 + w * 4 + (lane >> 4), j = lane & 15;
                const u32x4 v = *(const LAS u32x4*)(stg + lr * 256 + ((j ^ (lr & 15)) << 4));
                const int q = ai * HALF + (lr >> 5) * 64 + (2 * mh + ((lr >> 4) & 1)) * 16 + (lr & 15);
#if Y_SORTED
#if PROBE_NOEPI == 3
                const int sl = (!skip && u.aux + q < n) ? u.pm * BM + q : -1;
                if (skip) asm volatile("" :: "v"(v.x), "v"(v.y), "v"(v.z), "v"(v.w));
#else
                const int sl = (u.aux + q < n) ? u.pm * BM + q : -1;
#endif
#else
                const int sl = (u.aux + q < n) ? ps[q] : -1;
#endif
#if Y_SORTED
                if (sl >= 0) { unsigned char* dst = Y + ((size_t)(u.pm * 4 + u.pn) << 16) + q * 256 + (lane & 15) * 16;
                    if (STAGE_NT) st16nt(dst, v); else st16(dst, v); } }
#else
                if (sl >= 0) { if (STAGE_NT) st16nt(ybase + (size_t)sl * D, v); else st16(ybase + (size_t)sl * D, v); } }
#endif
        } }
#elif Y_FP8
#pragma unroll
        for (int ai = 0; ai < 2; ++ai) {
            float g16[4];
#pragma unroll
            for (int m = 0; m < 4; ++m) g16[m] = pg[ai * HALF + wr * 64 + m * 16 + fr] * 4.0f;
            const int q = ai * HALF + wr * 64 + fq * 16 + fr;
#if PROBE_NOEPI == 2
            const int sl = skip ? u.pm * BM + q : ((u.aux + q < n) ? ps[q] : -1);
#elif PROBE_NOEPI == 3
            const int sl = skip ? -1 : ((u.aux + q < n) ? ps[q] : -1);
#elif PROBE_NOEPI == 4
            const int sl = skip ? 65536 + (blockIdx.x * 8 + (q & 7)) : ((u.aux + q < n) ? ps[q] : -1);
#else
            const int sl = (u.aux + q < n) ? ps[q] : -1;
#endif
            unsigned W[2][4][2];
#pragma unroll
            for (int bj = 0; bj < 2; ++bj)
#pragma unroll
                for (int m = 0; m < 4; ++m) { const f32x4 v0 = (acc[ai][bj][m][0] * 0.015625f + bv[bj][0]) * g16[m], v1 = (acc[ai][bj][m][1] * 0.015625f + bv[bj][1]) * g16[m];
                    W[bj][m][0] = cvt_pk4_fp8(v0[0], v0[1], v0[2], v0[3]); W[bj][m][1] = cvt_pk4_fp8(v1[0], v1[1], v1[2], v1[3]); }
#pragma unroll
            for (int bj = 0; bj < 2; ++bj)
#pragma unroll
                for (int d = 0; d < 2; ++d) {
                    u32x2 r;
                    r = __builtin_amdgcn_permlane32_swap(W[bj][0][d], W[bj][2][d], false, false); W[bj][0][d] = r[0]; W[bj][2][d] = r[1];
                    r = __builtin_amdgcn_permlane32_swap(W[bj][1][d], W[bj][3][d], false, false); W[bj][1][d] = r[0]; W[bj][3][d] = r[1];
                    r = __builtin_amdgcn_permlane16_swap(W[bj][0][d], W[bj][1][d], false, false); W[bj][0][d] = r[0]; W[bj][1][d] = r[1];
                    r = __builtin_amdgcn_permlane16_swap(W[bj][2][d], W[bj][3][d], false, false); W[bj][2][d] = r[0]; W[bj][3][d] = r[1];
                }
#if PROBE_NOEPI == 5
            if (skip) {
                unsigned char* rp = Y + (size_t)(u.pm * 4 + u.pn) * 65536 + (wr * 4 + wc) * 8192 + ai * 4096 + (fq * 16 + fr) * 16;
#pragma unroll
                for (int bj = 0; bj < 2; ++bj) {
#if PROBE_NT5
                    st16nt(rp + bj * 2048, (u32x4){W[bj][0][0], W[bj][0][1], W[bj][1][0], W[bj][1][1]}); st16nt(rp + bj * 2048 + 1024, (u32x4){W[bj][2][0], W[bj][2][1], W[bj][3][0], W[bj][3][1]});
#else
                    st16(rp + bj * 2048, (u32x4){W[bj][0][0], W[bj][0][1], W[bj][1][0], W[bj][1][1]}); st16(rp + bj * 2048 + 1024, (u32x4){W[bj][2][0], W[bj][2][1], W[bj][3][0], W[bj][3][1]});
#endif
                }
            } else
#endif
            if (sl >= 0) {
                unsigned char* rowp = Y + (size_t)sl * D + u.pn * BM + wc * 32;
#pragma unroll
                for (int bj = 0; bj < 2; ++bj) {
                    if (NT_DOWN) { st16nt(rowp + bj * HALF, (u32x4){W[bj][0][0], W[bj][0][1], W[bj][1][0], W[bj][1][1]}); st16nt(rowp + bj * HALF + 16, (u32x4){W[bj][2][0], W[bj][2][1], W[bj][3][0], W[bj][3][1]}); }
                    else { st16(rowp + bj * HALF, (u32x4){W[bj][0][0], W[bj][0][1], W[bj][1][0], W[bj][1][1]}); st16(rowp + bj * HALF + 16, (u32x4){W[bj][2][0], W[bj][2][1], W[bj][3][0], W[bj][3][1]}); } }
            }
            asm volatile("" ::: "memory");
        }
#else
#pragma unroll
        for (int ai = 0; ai < 2; ++ai) {
            int slot[4]; float gt[4];
#pragma unroll
            for (int i = 0; i < 4; ++i) { const int q = ai * HALF + wr * 64 + i * 16 + fr; slot[i] = (u.aux + q < n) ? ps[q] : -1; gt[i] = pg[q]; }
#pragma unroll
            for (int m = 0; m < 4; ++m) {
                const int sl = slot[m];
                if (sl >= 0) {
                    bf16_t* rowp = (bf16_t*)Y + (size_t)sl * D + col0; const float g1 = gt[m];
#pragma unroll
                    for (int bj = 0; bj < 2; ++bj) { const f32x4 v0 = (acc[ai][bj][m][0] * 0.015625f + bv[bj][0]) * g1, v1 = (acc[ai][bj][m][1] * 0.015625f + bv[bj][1]) * g1;
                        u32x4 w; w.x = cvt_pk_bf16(v0[0], v0[1]); w.y = cvt_pk_bf16(v0[2], v0[3]); w.z = cvt_pk_bf16(v1[0], v1[1]); w.w = cvt_pk_bf16(v1[2], v1[3]);
                        st16(rowp + bj * HALF, w); }
                }
            }
            asm volatile("" ::: "memory");
        }
#endif
    }
};
}

struct Args {
    const float* x; const float* c; const float* ctx; const float* c_ctx; const float* ada_w; const float* ada_b; const float* norm_g;
    const float* w_qkv; const float* w_o; const float* rpb; const float* pool_w; const float* pool_b; const float* pool_scale;
    const float* w_router; const float* b_router; const float* w_up; const float* b_up; const float* w_down; const float* b_down;
    float* out; unsigned char* ws; int ph_lo, ph_hi;
};

struct Frame {
    LAS unsigned char* lds; int tid, lane, wave, G, vcu;
};

struct Row { f32x4 v[4]; };
typedef __amdgpu_buffer_rsrc_t rsrc_t;
__device__ __forceinline__ rsrc_t mk_rsrc(const void* p, unsigned bytes) { return __builtin_amdgcn_make_buffer_rsrc((void*)p, (short)0, (int)bytes, 0x00020000); }
__device__ __forceinline__ Row row_load_f32(rsrc_t rs, unsigned soff, int lane) { Row r;
#pragma unroll
    for (int j = 0; j < 4; ++j) r.v[j] = __builtin_bit_cast(f32x4, __builtin_amdgcn_raw_buffer_load_b128(rs, 16 * lane, soff + 1024 * j, ROW_LD_NT));
    return r; }
__device__ __forceinline__ void row_load_bf16_raw(rsrc_t rs, unsigned soff, int lane, u32x2 (&w)[4]) {
#pragma unroll
    for (int j = 0; j < 4; ++j) w[j] = __builtin_bit_cast(u32x2, __builtin_amdgcn_raw_buffer_load_b64(rs, 8 * lane, soff + 512 * j, ROW_LD_NT)); }
__device__ __forceinline__ Row row_unpack_bf16(const u32x2 (&w)[4]) { Row r;
#pragma unroll
    for (int j = 0; j < 4; ++j) r.v[j] = (f32x4){bf_lo(w[j].x), bf_hi(w[j].x), bf_lo(w[j].y), bf_hi(w[j].y)};
    return r; }
__device__ __forceinline__ Row row_load_bf16(rsrc_t rs, unsigned soff, int lane) { u32x2 w[4]; row_load_bf16_raw(rs, soff, lane, w); return row_unpack_bf16(w); }
__device__ __forceinline__ void row_store_f32(rsrc_t rs, unsigned soff, int lane, const Row& r) {
#pragma unroll
    for (int j = 0; j < 4; ++j) __builtin_amdgcn_raw_buffer_store_b128(__builtin_bit_cast(u32x4, r.v[j]), rs, 16 * lane, soff + 1024 * j, ROW_NT); }
__device__ __forceinline__ void row_store_bf16(rsrc_t rs, unsigned soff, int lane, const Row& r) {
#pragma unroll
    for (int j = 0; j < 4; ++j) { u32x2 w; w.x = cvt_pk_bf16(r.v[j][0], r.v[j][1]); w.y = cvt_pk_bf16(r.v[j][2], r.v[j][3]); __builtin_amdgcn_raw_buffer_store_b64(w, rs, 8 * lane, soff + 512 * j, ROW_NT); } }
__device__ __forceinline__ void row_store_fp8(rsrc_t rs, unsigned soff, int lane, const Row& r) {
#pragma unroll
    for (int j = 0; j < 4; ++j) __builtin_amdgcn_raw_buffer_store_b32(cvt_pk4_fp8_sat(r.v[j][0], r.v[j][1], r.v[j][2], r.v[j][3]), rs, 4 * lane, soff + 256 * j, ROW_NT); }
__device__ __forceinline__ float row_sumsq(const Row& r) { float s = 0.f;
#pragma unroll
    for (int j = 0; j < 4; ++j) s += (r.v[j][0] * r.v[j][0] + r.v[j][1] * r.v[j][1]) + (r.v[j][2] * r.v[j][2] + r.v[j][3] * r.v[j][3]);
    return wave_sum(s); }
__device__ __forceinline__ float rstd_of(float ss) { return 1.0f / sqrtf(ss * (1.0f / D) + RMS_EPS); }

__device__ __forceinline__ float silu_f(float v) { return v / (1.0f + __expf(-v)); }
__device__ __forceinline__ void p0_adaln(const Frame& F, const Args& a) {
    LAS f32x4* red = (LAS f32x4*)F.lds;
    float* mod = (float*)(a.ws + WS_MOD);
    for (int it = blockIdx.x; it < 256; it += F.G) {
        const int layer = it >> 7, cb = it & 127, cl = F.tid & 15, ks = F.tid >> 4;
        f32x4 a0 = {0.f, 0.f, 0.f, 0.f}, a1 = {0.f, 0.f, 0.f, 0.f};
        if (cl < 12) {
            const float* wp = a.ada_w + ((size_t)layer * D + ks * 32) * 6144 + cb * 48 + cl * 4;
#pragma unroll 8
            for (int kk = 0; kk < 32; ++kk) { const f32x4 w = *(const f32x4*)(wp + (size_t)kk * 6144); const float s0 = silu_f(a.c[ks * 32 + kk]), s1 = silu_f(a.c_ctx[ks * 32 + kk]); a0 += w * s0; a1 += w * s1; }
        }
        red[ks * 16 + cl] = a0; red[512 + ks * 16 + cl] = a1;
        __syncthreads();
        if (F.tid < 32) { const int which = F.tid >> 4, c4 = F.tid & 15;
            if (c4 < 12) { f32x4 s = {0.f, 0.f, 0.f, 0.f};
                for (int k2 = 0; k2 < 32; ++k2) s += red[which * 512 + k2 * 16 + c4];
                const int col = cb * 48 + c4 * 4; s += *(const f32x4*)(a.ada_b + layer * 6144 + col);
                if (which == 0) *(f32x4*)(mod + (layer == 0 ? 0 : 2) * 6144 + col) = s;
                else if (layer == 0) *(f32x4*)(mod + 6144 + col) = s; } }
        __syncthreads();
    }
}
struct TItem { const float* src; bf16_t* dst; int N, ldwt; };
__device__ __forceinline__ void titem_load(const TItem& t, f32x4 (&v)[16], int lane) {
    const float* src = t.src + (size_t)(lane >> 4) * t.N + 4 * (lane & 15);
#pragma unroll
    for (int i = 0; i < 16; ++i) v[i] = __builtin_nontemporal_load((const f32x4*)(src + (size_t)(4 * i) * t.N));
}
__device__ __forceinline__ void titem_finish(const TItem& t, const f32x4 (&v)[16], LAS float* scr, int lane) {
    const int lk = lane >> 4, n4 = lane & 15;
#pragma unroll
    for (int i = 0; i < 16; ++i) { const int k = 4 * i + lk; *(LAS f32x4*)(scr + k * 64 + ((4 * n4) ^ (4 * (k >> 3)))) = v[i]; }
    LDS_WAIT(); asm volatile("" ::: "memory");
    const int c = lane & 7;
#pragma unroll
    for (int j = 0; j < 8; ++j) { const int n = (lane >> 3) + 8 * j; const LAS float* sp = scr + (8 * c) * 64 + (n ^ (4 * c));
        u32x4 o; o.x = cvt_pk_bf16(sp[0 * 64], sp[1 * 64]); o.y = cvt_pk_bf16(sp[2 * 64], sp[3 * 64]); o.z = cvt_pk_bf16(sp[4 * 64], sp[5 * 64]); o.w = cvt_pk_bf16(sp[6 * 64], sp[7 * 64]);
        *(u32x4*)(t.dst + (size_t)n * t.ldwt + 8 * c) = o; }
    LDS_WAIT(); asm volatile("" ::: "memory");
}
struct TItem8 { const float* src; unsigned char* dst; int N, ldwt; };
__device__ __forceinline__ void titem8_load(const TItem8& t, f32x4 (&v)[16], int lane) {
    const float* src = t.src + (size_t)(lane >> 3) * t.N + 4 * (lane & 7);
#pragma unroll
    for (int i = 0; i < 16; ++i) v[i] = __builtin_nontemporal_load((const f32x4*)(src + (size_t)(8 * i) * t.N));
}
__device__ __forceinline__ void titem8_finish(const TItem8& t, const f32x4 (&v)[16], LAS float* scr, int lane) {
    const int lk = lane >> 3, n4 = lane & 7;
#pragma unroll
    for (int i = 0; i < 16; ++i) { const int k = 8 * i + lk; *(LAS f32x4*)(scr + k * 32 + ((n4 ^ ((k >> 4) & 7)) << 2)) = v[i] * 64.0f; }
    LDS_WAIT(); asm volatile("" ::: "memory");
    const int c = lane & 7;
#pragma unroll
    for (int j = 0; j < 4; ++j) { const int n = (lane >> 3) + 8 * j; const LAS float* sp = scr + (16 * c) * 32 + ((((n >> 2) ^ c) << 2) | (n & 3));
        u32x4 o; o.x = cvt_pk4_fp8(sp[0 * 32], sp[1 * 32], sp[2 * 32], sp[3 * 32]); o.y = cvt_pk4_fp8(sp[4 * 32], sp[5 * 32], sp[6 * 32], sp[7 * 32]);
        o.z = cvt_pk4_fp8(sp[8 * 32], sp[9 * 32], sp[10 * 32], sp[11 * 32]); o.w = cvt_pk4_fp8(sp[12 * 32], sp[13 * 32], sp[14 * 32], sp[15 * 32]);
        if (CONV_NT) __builtin_nontemporal_store(o, (u32x4*)(t.dst + (size_t)n * t.ldwt + 16 * c)); else *(u32x4*)(t.dst + (size_t)n * t.ldwt + 16 * c) = o; }
    LDS_WAIT(); asm volatile("" ::: "memory");
}
__device__ __forceinline__ void transpose_item(const float* W, int N, bf16_t* WT, int ldwt, int k0, int n0, int drow0, LAS float* scr, int lane) {
    const TItem t{W + (size_t)k0 * N + n0, WT + (size_t)drow0 * ldwt + k0, N, ldwt};
    f32x4 v[16]; titem_load(t, v, lane); titem_finish(t, v, scr, lane);
}
__device__ __forceinline__ void p0_router_weights(const Frame& F, const Args& a) {
    bf16_t* wrt = (bf16_t*)(a.ws + WS_WRT);
    for (int i = blockIdx.x * NT + F.tid; i < 2 * NE * D; i += F.G * NT) { const int l = i / (NE * D), r = i % (NE * D), e = r / D, k = r % D;
        const float w = a.w_router[((size_t)l * D + k) * NE + e]; const unsigned hb = cvt_pk_bf16(w, 0.f) & 0xffffu; const float lo = w - __uint_as_float(hb << 16);
        wrt[((size_t)(l * 2 + 0) * NE + e) * D + k] = (bf16_t)hb; wrt[((size_t)(l * 2 + 1) * NE + e) * D + k] = (bf16_t)(cvt_pk_bf16(lo, 0.f) & 0xffffu); }
}
__device__ __forceinline__ void p0_convert_small(const Frame& F, const Args& a) {
    LAS float* scr = (LAS float*)(F.lds + F.wave * 16384);
    const int gw = F.vcu * NWAVES + F.wave, NGW = F.G * NWAVES;
    constexpr int I_QKV = 16 * 48, I_O = 16 * 16, I_POOL = 4 * 4 * 4, NITEMS = I_QKV + I_O + I_POOL;
    bf16_t* wqkv = (bf16_t*)(a.ws + WS_WQKV); bf16_t* wo = (bf16_t*)(a.ws + WS_WO); bf16_t* wpool = (bf16_t*)(a.ws + WS_WPOOL);
    for (int it = gw; it < NITEMS; it += NGW) {
        int r = it;
#if QKV_FP8
        if (r < I_QKV) { const int kb = r / 96, nb = r % 96; const TItem8 t{a.w_qkv + (size_t)(kb * 128) * 3072 + nb * 32, (unsigned char*)wqkv + (size_t)(nb * 32) * 1024 + kb * 128, 3072, 1024};
            f32x4 v[16]; titem8_load(t, v, F.lane); titem8_finish(t, v, scr, F.lane); continue; } r -= I_QKV;
#else
        if (r < I_QKV) { const int kb = r / 48, nb = r % 48; transpose_item(a.w_qkv, 3072, wqkv, 1024, kb * 64, nb * 64, nb * 64, scr, F.lane); continue; } r -= I_QKV;
#endif
        if (r < I_O) { const int kb = r / 16, nb = r % 16; transpose_item(a.w_o, 1024, wo, 1024, kb * 64, nb * 64, nb * 64, scr, F.lane); continue; } r -= I_O;
        { const int g = r / 16, q = r % 16, kb = q / 4, nb = q % 4; transpose_item(a.pool_w + (size_t)g * 65536, 256, wpool + (size_t)g * 65536, 256, kb * 64, nb * 64, nb * 64, scr, F.lane); }
    }
}
constexpr int CV_UP1 = 16 * 32, CV_UP = 32 * CV_UP1, CV_DN1 = 16 * 16, CV_DN = 32 * CV_DN1, CV_ITEMS = CV_UP + CV_DN, CV_CHUNK = 8, CV_NCHUNK = CV_ITEMS / CV_CHUNK;
__device__ __forceinline__ TItem8 cv_item(const Args& a, int layer, int r) {
    unsigned char* wup = a.ws + WS_WUP + (size_t)layer * 32 * 2048 * 1024; unsigned char* wdn = a.ws + WS_WDN + (size_t)layer * 32 * 1024 * 1024;
    const float* sup = a.w_up + (size_t)layer * 32 * 1024 * 2048; const float* sdn = a.w_down + (size_t)layer * 32 * 1024 * 1024;
    if (r < CV_UP) { const int mat = r / CV_UP1, q = r % CV_UP1, kb = q / 64, nb = q % 64, n0 = nb * 32;
        const int drow = (n0 < 1024) ? ((n0 >> 7) * 256 + (n0 & 127)) : (((n0 - 1024) >> 7) * 256 + 128 + ((n0 - 1024) & 127));
        return TItem8{sup + (size_t)mat * 1024 * 2048 + (size_t)(kb * 128) * 2048 + n0, wup + (size_t)mat * 2048 * 1024 + (size_t)drow * 1024 + kb * 128, 2048, 1024}; }
    r -= CV_UP; const int mat = r / CV_DN1, q = r % CV_DN1, kb = q / 32, nb = q % 32;
    return TItem8{sdn + (size_t)mat * 1024 * 1024 + (size_t)(kb * 128) * 1024 + nb * 32, wdn + (size_t)mat * 1024 * 1024 + (size_t)(nb * 32) * 1024 + kb * 128, 1024, 1024};
}
__device__ __forceinline__ void bg_convert(const Frame& F, const Args& a, int layer, int phase, unsigned Gf, bool fg) {
    unsigned* ctl = (unsigned*)(a.ws + WS_CTL); unsigned* q = ctl + CW_Q + 64 * layer; unsigned* done = ctl + CW_DONE + 64 * phase;
    volatile LAS unsigned* sh = (volatile LAS unsigned*)(F.lds + MISC_OFF + 64);
    LAS float* scr = (LAS float*)(F.lds + F.wave * 16384);
    const unsigned NC = (unsigned)CV_NCHUNK;
    __syncthreads();
    if (fg && F.tid == 0) __hip_atomic_fetch_add(done, 1u, __ATOMIC_RELAXED, __HIP_MEMORY_SCOPE_AGENT);
    unsigned ia = NC, ib = NC, dn = 0u;
    if (F.tid == 0) { if (Gf != 0u) dn = __hip_atomic_load(done, __ATOMIC_RELAXED, __HIP_MEMORY_SCOPE_AGENT);
        if (Gf == 0u || dn < Gf) { ia = __hip_atomic_fetch_add(q, 1u, __ATOMIC_RELAXED, __HIP_MEMORY_SCOPE_AGENT); ib = __hip_atomic_fetch_add(q, 1u, __ATOMIC_RELAXED, __HIP_MEMORY_SCOPE_AGENT); }
        sh[0] = ia; sh[1] = ib; }
    __syncthreads();
    unsigned c0 = sh[0], c1 = sh[1];
    __syncthreads();
    if (c0 >= NC) return;
    f32x4 va[16], vb[16];
    TItem8 ta = cv_item(a, layer, (int)c0 * CV_CHUNK + F.wave), tb = ta;
    titem8_load(ta, va, F.lane);
    for (;;) {
        if (c1 < NC) { tb = cv_item(a, layer, (int)c1 * CV_CHUNK + F.wave); titem8_load(tb, vb, F.lane); }
        unsigned nx = NC;
        if (F.tid == 0) { const bool stop = (Gf != 0u) && (dn >= Gf); if (!stop) nx = __hip_atomic_fetch_add(q, 1u, __ATOMIC_RELAXED, __HIP_MEMORY_SCOPE_AGENT);
            if (Gf != 0u) dn = __hip_atomic_load(done, __ATOMIC_RELAXED, __HIP_MEMORY_SCOPE_AGENT); }
        titem8_finish(ta, va, scr, F.lane);
        if (c1 >= NC) break;
        if (F.tid == 0) sh[0] = nx;
        __syncthreads();
        c0 = sh[0];
        __syncthreads();
        if (c0 < NC) { ta = cv_item(a, layer, (int)c0 * CV_CHUNK + F.wave); titem8_load(ta, va, F.lane); }
        nx = NC;
        if (F.tid == 0) { const bool stop = (Gf != 0u) && (dn >= Gf); if (!stop) nx = __hip_atomic_fetch_add(q, 1u, __ATOMIC_RELAXED, __HIP_MEMORY_SCOPE_AGENT);
            if (Gf != 0u) dn = __hip_atomic_load(done, __ATOMIC_RELAXED, __HIP_MEMORY_SCOPE_AGENT); }
        titem8_finish(tb, vb, scr, F.lane);
        if (c0 >= NC) break;
        if (F.tid == 0) sh[0] = nx;
        __syncthreads();
        c1 = sh[0];
        __syncthreads();
    }
    __syncthreads();
}

template <bool OUT8 = false>
__device__ __forceinline__ void modulate_rows(const Frame& F, const float* x, int nrows, const float* g, const float* shift, const float* scale, void* out, int gw, int NGW) {
    const int lane = F.lane;
    const rsrc_t rx = mk_rsrc(x, (unsigned)nrows * D * 4), ro = mk_rsrc(out, (unsigned)nrows * D * (OUT8 ? 1 : 2));
    Row gs = row_load_f32(mk_rsrc(g, D * 4), 0, lane), sh = row_load_f32(mk_rsrc(shift, D * 4), 0, lane); { const Row sc = row_load_f32(mk_rsrc(scale, D * 4), 0, lane);
#pragma unroll
        for (int j = 0; j < 4; ++j) gs.v[j] = gs.v[j] * (sc.v[j] + 1.0f); }
    for (int m = gw; m < nrows; m += NGW) {
        Row r = row_load_f32(rx, (unsigned)m * D * 4, lane);
        const float rs = rstd_of(row_sumsq(r));
#pragma unroll
        for (int j = 0; j < 4; ++j) r.v[j] = r.v[j] * rs * gs.v[j] + sh.v[j];
        if (OUT8) row_store_fp8(ro, (unsigned)m * D, lane, r); else row_store_bf16(ro, (unsigned)m * D * 2, lane, r);
    }
}

namespace na {
constexpr int LDS_CK = 0, LDS_CV = 32768, LDS_RING = 65536, SLOT = 16384, LDS_BIAS = LDS_RING + 3 * SLOT;
__device__ __forceinline__ unsigned kaddr(int key, int c) { return (unsigned)(key * 128 + ((c ^ ((key >> 1) & 7)) << 4)); }
__device__ __forceinline__ s16x4 vtr(const LAS unsigned char* p) { typedef short v4i16_t __attribute__((ext_vector_type(4)));
    return __builtin_bit_cast(s16x4, __builtin_amdgcn_ds_read_tr16_b64_v4i16((LAS v4i16_t*)p)); }

template <bool LOCAL>
__device__ __forceinline__ void tile(const LAS unsigned char* kimg, int key0, const LAS unsigned char* vimg, int vstride, const bf16x8 (&qf)[2], float& m, float& l, f32x4 (&o)[4],
                                     const LAS float* brow, unsigned valid, int lane) {
    const int fr = lane & 15, fq = lane >> 4;
    f32x4 s[2];
#pragma unroll
    for (int kb = 0; kb < 2; ++kb) {
        const int key = key0 + kb * 16 + fr;
        const bf16x8 k0 = *(const LAS bf16x8*)(kimg + kaddr(key, fq)), k1 = *(const LAS bf16x8*)(kimg + kaddr(key, 4 + fq));
        s[kb] = __builtin_amdgcn_mfma_f32_16x16x32_bf16(k0, qf[0], (f32x4){0.f, 0.f, 0.f, 0.f}, 0, 0, 0);
        s[kb] = __builtin_amdgcn_mfma_f32_16x16x32_bf16(k1, qf[1], s[kb], 0, 0, 0);
    }
    if (LOCAL) {
#pragma unroll
        for (int kb = 0; kb < 2; ++kb)
#pragma unroll
            for (int r = 0; r < 4; ++r) { const float b = brow[kb * 16 + r]; s[kb][r] = ((valid >> (kb * 4 + r)) & 1u) ? s[kb][r] + b : -1e30f; }
    }
    float mt = fmaxf(fmaxf(fmaxf(s[0][0], s[0][1]), fmaxf(s[0][2], s[0][3])), fmaxf(fmaxf(s[1][0], s[1][1]), fmaxf(s[1][2], s[1][3])));
    mt = fmaxf(mt, __shfl_xor(mt, 16)); mt = fmaxf(mt, __shfl_xor(mt, 32));
    const float mn = fmaxf(m, mt), alpha = __builtin_amdgcn_exp2f(m - mn);
    m = mn;
    float p[8]; float ps = 0.f;
#pragma unroll
    for (int kb = 0; kb < 2; ++kb)
#pragma unroll
        for (int r = 0; r < 4; ++r) { p[kb * 4 + r] = __builtin_amdgcn_exp2f(s[kb][r] - mn); ps += p[kb * 4 + r]; }
    l = l * alpha + ps;
    u32x4 pw; pw.x = cvt_pk_bf16(p[0], p[1]); pw.y = cvt_pk_bf16(p[2], p[3]); pw.z = cvt_pk_bf16(p[4], p[5]); pw.w = cvt_pk_bf16(p[6], p[7]);
    const bf16x8 pb = __builtin_bit_cast(bf16x8, pw);
    const int q = fr >> 2, pp = fr & 3;
#pragma unroll
    for (int db = 0; db < 4; ++db) {
        const LAS unsigned char* vb = vimg + db * vstride + (key0 + 4 * fq + q) * 32 + pp * 8;
        const s16x4 lo = vtr(vb), hi = vtr(vb + 16 * 32);
        const bf16x8 vf = (bf16x8){lo[0], lo[1], lo[2], lo[3], hi[0], hi[1], hi[2], hi[3]};
        o[db] = o[db] * alpha;
        o[db] = __builtin_amdgcn_mfma_f32_16x16x32_bf16(vf, pb, o[db], 0, 0, 0);
    }
}

__device__ __forceinline__ void tile2(const LAS unsigned char* kloc, int key0, const LAS unsigned char* vloc, const LAS unsigned char* kctx, int ckey0, const LAS unsigned char* vctx,
                                      const bf16x8 (&qf)[2], float& m, f32x4& l, f32x4 (&o)[4], const LAS float* brow, unsigned valid, int lane) {
    const int fr = lane & 15, fq = lane >> 4;
    f32x4 s[4];
#pragma unroll
    for (int kb = 0; kb < 2; ++kb) {
        const int key = key0 + kb * 16 + fr, ck = ckey0 + kb * 16 + fr;
        const bf16x8 k0 = *(const LAS bf16x8*)(kloc + kaddr(key, fq)), k1 = *(const LAS bf16x8*)(kloc + kaddr(key, 4 + fq));
        const bf16x8 c0 = *(const LAS bf16x8*)(kctx + kaddr(ck, fq)), c1 = *(const LAS bf16x8*)(kctx + kaddr(ck, 4 + fq));
        s[kb] = __builtin_amdgcn_mfma_f32_16x16x32_bf16(k0, qf[0], (f32x4){0.f, 0.f, 0.f, 0.f}, 0, 0, 0);
        s[kb] = __builtin_amdgcn_mfma_f32_16x16x32_bf16(k1, qf[1], s[kb], 0, 0, 0);
        s[2 + kb] = __builtin_amdgcn_mfma_f32_16x16x32_bf16(c0, qf[0], (f32x4){0.f, 0.f, 0.f, 0.f}, 0, 0, 0);
        s[2 + kb] = __builtin_amdgcn_mfma_f32_16x16x32_bf16(c1, qf[1], s[2 + kb], 0, 0, 0);
    }
#pragma unroll
    for (int kb = 0; kb < 2; ++kb)
#pragma unroll
        for (int r = 0; r < 4; ++r) { const float b = brow[kb * 16 + r]; s[kb][r] = ((valid >> (kb * 4 + r)) & 1u) ? s[kb][r] + b : -1e30f; }
    float mt = fmaxf(fmaxf(fmaxf(s[0][0], s[0][1]), fmaxf(s[0][2], s[0][3])), fmaxf(fmaxf(s[1][0], s[1][1]), fmaxf(s[1][2], s[1][3])));
    mt = fmaxf(mt, fmaxf(fmaxf(fmaxf(s[2][0], s[2][1]), fmaxf(s[2][2], s[2][3])), fmaxf(fmaxf(s[3][0], s[3][1]), fmaxf(s[3][2], s[3][3]))));
    mt = fmaxf(mt, __shfl_xor(mt, 16)); mt = fmaxf(mt, __shfl_xor(mt, 32));
    if (__builtin_amdgcn_ballot_w64(mt > m + 8.0f) != 0ull) {
        const float mn = fmaxf(m, mt), alpha = __builtin_amdgcn_exp2f(m - mn);
        m = mn; l = l * alpha;
#pragma unroll
        for (int db = 0; db < 4; ++db) o[db] = o[db] * alpha;
    }
    float p[16];
#pragma unroll
    for (int t = 0; t < 4; ++t)
#pragma unroll
        for (int r = 0; r < 4; ++r) p[t * 4 + r] = __builtin_amdgcn_exp2f(s[t][r] - m);
    u32x4 pw; pw.x = cvt_pk_bf16(p[0], p[1]); pw.y = cvt_pk_bf16(p[2], p[3]); pw.z = cvt_pk_bf16(p[4], p[5]); pw.w = cvt_pk_bf16(p[6], p[7]);
    u32x4 pc; pc.x = cvt_pk_bf16(p[8], p[9]); pc.y = cvt_pk_bf16(p[10], p[11]); pc.z = cvt_pk_bf16(p[12], p[13]); pc.w = cvt_pk_bf16(p[14], p[15]);
    const bf16x8 pb = __builtin_bit_cast(bf16x8, pw), pcb = __builtin_bit_cast(bf16x8, pc);
    { const bf16x8 ones = (bf16x8){0x3F80, 0x3F80, 0x3F80, 0x3F80, 0x3F80, 0x3F80, 0x3F80, 0x3F80};
      l = __builtin_amdgcn_mfma_f32_16x16x32_bf16(ones, pb, l, 0, 0, 0); l = __builtin_amdgcn_mfma_f32_16x16x32_bf16(ones, pcb, l, 0, 0, 0); }
    const int q = fr >> 2, pp = fr & 3;
#pragma unroll
    for (int db = 0; db < 4; ++db) {
        const LAS unsigned char* vb = vloc + db * (64 * 32) + (key0 + 4 * fq + q) * 32 + pp * 8;
        const LAS unsigned char* vc = vctx + db * (256 * 32) + (ckey0 + 4 * fq + q) * 32 + pp * 8;
        const s16x4 lo = vtr(vb), hi = vtr(vb + 16 * 32), clo = vtr(vc), chi = vtr(vc + 16 * 32);
        const bf16x8 vf = (bf16x8){lo[0], lo[1], lo[2], lo[3], hi[0], hi[1], hi[2], hi[3]}, cf = (bf16x8){clo[0], clo[1], clo[2], clo[3], chi[0], chi[1], chi[2], chi[3]};
        o[db] = __builtin_amdgcn_mfma_f32_16x16x32_bf16(vf, pb, o[db], 0, 0, 0);
        o[db] = __builtin_amdgcn_mfma_f32_16x16x32_bf16(cf, pcb, o[db], 0, 0, 0);
    }
}

struct BandSel { unsigned fm[4]; int boff[4]; unsigned pm01, pm23; };
__device__ __forceinline__ void tile3(const LAS unsigned char* kloc, int key0, const LAS unsigned char* vloc, const LAS unsigned char* kctx, int ckey0, const LAS unsigned char* vctx,
                                      const bf16x8 (&qf)[2], float& m, f32x4& l, f32x4 (&o)[4], const LAS float* brow, const BandSel& bs, int lane, bool first) {
    const int fr = lane & 15, fq = lane >> 4;
    f32x4 s[4];
#pragma unroll
    for (int kb = 0; kb < 2; ++kb) {
        const int key = key0 + kb * 16 + fr, ck = ckey0 + kb * 16 + fr;
        const bf16x8 k0 = *(const LAS bf16x8*)(kloc + kaddr(key, fq)), k1 = *(const LAS bf16x8*)(kloc + kaddr(key, 4 + fq));
        const bf16x8 c0 = *(const LAS bf16x8*)(kctx + kaddr(ck, fq)), c1 = *(const LAS bf16x8*)(kctx + kaddr(ck, 4 + fq));
        s[kb] = __builtin_amdgcn_mfma_f32_16x16x32_bf16(k0, qf[0], (f32x4){0.f, 0.f, 0.f, 0.f}, 0, 0, 0);
        s[kb] = __builtin_amdgcn_mfma_f32_16x16x32_bf16(k1, qf[1], s[kb], 0, 0, 0);
        s[2 + kb] = __builtin_amdgcn_mfma_f32_16x16x32_bf16(c0, qf[0], (f32x4){0.f, 0.f, 0.f, 0.f}, 0, 0, 0);
        s[2 + kb] = __builtin_amdgcn_mfma_f32_16x16x32_bf16(c1, qf[1], s[2 + kb], 0, 0, 0);
    }
    float sl[4];
#pragma unroll
    for (int r = 0; r < 4; ++r) { const unsigned a_ = __float_as_uint(s[0][r]), b_ = __float_as_uint(s[1][r]); sl[r] = __uint_as_float((a_ & bs.fm[r]) | (b_ & ~bs.fm[r])) + brow[bs.boff[r]]; }
    if (first) {
        float mt = fmaxf(fmaxf(sl[0], sl[1]), fmaxf(sl[2], sl[3]));
        mt = fmaxf(mt, fmaxf(fmaxf(fmaxf(s[2][0], s[2][1]), fmaxf(s[2][2], s[2][3])), fmaxf(fmaxf(s[3][0], s[3][1]), fmaxf(s[3][2], s[3][3]))));
        mt = fmaxf(mt, __shfl_xor(mt, 16)); mt = fmaxf(mt, __shfl_xor(mt, 32));
        m = mt;
    }
    float pl[4], pcx[8];
#pragma unroll
    for (int r = 0; r < 4; ++r) pl[r] = __builtin_amdgcn_exp2f(sl[r] - m);
#pragma unroll
    for (int t = 0; t < 2; ++t)
#pragma unroll
        for (int r = 0; r < 4; ++r) pcx[t * 4 + r] = __builtin_amdgcn_exp2f(s[2 + t][r] - m);
    const unsigned pk01 = cvt_pk_bf16(pl[0], pl[1]), pk23 = cvt_pk_bf16(pl[2], pl[3]);
    u32x4 pw; pw.x = pk01 & bs.pm01; pw.y = pk23 & bs.pm23; pw.z = pk01 & ~bs.pm01; pw.w = pk23 & ~bs.pm23;
    u32x4 pc; pc.x = cvt_pk_bf16(pcx[0], pcx[1]); pc.y = cvt_pk_bf16(pcx[2], pcx[3]); pc.z = cvt_pk_bf16(pcx[4], pcx[5]); pc.w = cvt_pk_bf16(pcx[6], pcx[7]);
    const bf16x8 pb = __builtin_bit_cast(bf16x8, pw), pcb = __builtin_bit_cast(bf16x8, pc);
    { const bf16x8 ones = (bf16x8){0x3F80, 0x3F80, 0x3F80, 0x3F80, 0x3F80, 0x3F80, 0x3F80, 0x3F80};
      l = __builtin_amdgcn_mfma_f32_16x16x32_bf16(ones, pb, l, 0, 0, 0); l = __builtin_amdgcn_mfma_f32_16x16x32_bf16(ones, pcb, l, 0, 0, 0); }
    const int q = fr >> 2, pp = fr & 3;
#pragma unroll
    for (int db = 0; db < 4; ++db) {
        const LAS unsigned char* vb = vloc + db * (64 * 32) + (key0 + 4 * fq + q) * 32 + pp * 8;
        const LAS unsigned char* vc = vctx + db * (256 * 32) + (ckey0 + 4 * fq + q) * 32 + pp * 8;
        const s16x4 lo = vtr(vb), hi = vtr(vb + 16 * 32), clo = vtr(vc), chi = vtr(vc + 16 * 32);
        const bf16x8 vf = (bf16x8){lo[0], lo[1], lo[2], lo[3], hi[0], hi[1], hi[2], hi[3]}, cf = (bf16x8){clo[0], clo[1], clo[2], clo[3], chi[0], chi[1], chi[2], chi[3]};
        o[db] = __builtin_amdgcn_mfma_f32_16x16x32_bf16(vf, pb, o[db], 0, 0, 0);
        o[db] = __builtin_amdgcn_mfma_f32_16x16x32_bf16(cf, pcb, o[db], 0, 0, 0);
    }
}

__device__ __forceinline__ void attn_unit(const Frame& F, const Args& a, int h, int rlo, int rhi, bool border) {
    const bf16_t* Q = (const bf16_t*)(a.ws + WS_Q); const bf16_t* Kg = (const bf16_t*)(a.ws + WS_K); const bf16_t* Vg = (const bf16_t*)(a.ws + WS_V); bf16_t* O = (bf16_t*)(a.ws + WS_O);
    const int tid = F.tid, lane = F.lane, wid = F.wave, fr = lane & 15, fq = lane >> 4, g = wid & 3;
    LAS unsigned char* lds = F.lds;
    LAS float* bias = (LAS float*)(lds + LDS_BIAS) + 32;
    const int kb = border ? (rlo < 128 ? 0 : 248) : rlo - 4, ke = border ? kb + 7 : rhi + 3;
    int row0[4], ws0[4], nj[4];
#pragma unroll
    for (int j = 0; j < 4; ++j) { const int s = (wid >> 2) + 2 * j;
        if (border) { row0[j] = rlo + s; ws0[j] = kb; nj[j] = (s < 4) ? 1 : 0; }
        else { const int rA = rlo + ((s - rlo) & 7); row0[j] = rA; ws0[j] = rA - 4; nj[j] = (rA > rhi) ? 0 : ((rhi - rA) >> 3) + 1; } }
    const int sg = (g == 0) ? 0 : (g == 1) ? 8 : (g == 2) ? 24 : 32;
    const int cq = 16 * g + fr, c0 = min(max(cq - 8, 0), 48);
    const int dc0 = sg + 4 * fq - cq + 15;
    BandSel bs;
    { const int lo = c0 - sg; bool v0[4];
#pragma unroll
      for (int r = 0; r < 4; ++r) { v0[r] = (4 * fq + r) >= lo; bs.fm[r] = v0[r] ? 0xFFFFFFFFu : 0u; bs.boff[r] = r + (v0[r] ? 0 : 16); }
      bs.pm01 = (v0[0] ? 0xFFFFu : 0u) | (v0[1] ? 0xFFFF0000u : 0u); bs.pm23 = (v0[2] ? 0xFFFFu : 0u) | (v0[3] ? 0xFFFF0000u : 0u); }
    const unsigned qoff = (unsigned)cq * D + h * HD + 8 * fq, ooff = (unsigned)cq * D + h * HD + 4 * fq;
    float m[4]; f32x4 l[4]; f32x4 o[4][4]; bf16x8 qf[4][2], qn[2];
    __syncthreads();
#pragma unroll
    for (int n = 0; n < 4; ++n) { const int ch = tid + NT * n, key = ch >> 3, c = ch & 7;
        const u32x4 kv = *(const u32x4*)(Kg + (size_t)(L + key) * D + h * HD + c * 8), vv = *(const u32x4*)(Vg + (size_t)(L + key) * D + h * HD + c * 8);
        *(LAS u32x4*)(lds + LDS_CK + kaddr(key, c)) = kv;
        *(LAS u32x4*)(lds + LDS_CV + (c >> 1) * (256 * 32) + key * 32 + (c & 1) * 16) = vv; }
    if (tid < 465) bias[tid] = a.rpb[h * 465 + tid] * LOG2E;
    const int key = tid >> 3, c = tid & 7;
    const unsigned kvoff = (unsigned)key * D + h * HD + c * 8;
    const unsigned ksl = kaddr(key, c), vsl = 8192 + (c >> 1) * (64 * 32) + key * 32 + (c & 1) * 16;
#pragma unroll
    for (int n = 0; n < 2; ++n) { const size_t go = (size_t)(kb + n) * GW * D + kvoff; const u32x4 kv = *(const u32x4*)(Kg + go), vv = *(const u32x4*)(Vg + go);
        *(LAS u32x4*)(lds + LDS_RING + n * SLOT + ksl) = kv; *(LAS u32x4*)(lds + LDS_RING + n * SLOT + vsl) = vv; }
#pragma unroll
    for (int j = 0; j < 4; ++j) if (nj[j] > 0 && ws0[j] == kb) { const bf16_t* qp = Q + (size_t)row0[j] * GW * D + qoff; qf[j][0] = *(const bf16x8*)qp; qf[j][1] = *(const bf16x8*)(qp + 32); }
    __syncthreads();
    int rs = 0;
    for (int kr = kb; kr <= ke; ++kr) {
        u32x4 kreg, vreg; const bool pf = kr + 2 <= ke;
        if (pf) { const size_t go = (size_t)(kr + 2) * GW * D + kvoff; kreg = *(const u32x4*)(Kg + go); vreg = *(const u32x4*)(Vg + go); }
#pragma unroll
        for (int j = 0; j < 4; ++j) { const int d = kr + 1 - ws0[j]; if (d >= 0 && d < 8 * nj[j] && (d & 7) == 0) { const bf16_t* qp = Q + (size_t)(row0[j] + d) * GW * D + qoff; qn[0] = *(const bf16x8*)qp; qn[1] = *(const bf16x8*)(qp + 32); } }
        const LAS unsigned char* slot = lds + LDS_RING + rs * SLOT;
#pragma unroll
        for (int j = 0; j < 4; ++j) { const int d = kr - ws0[j];
            if (d >= 0 && d < 8 * nj[j]) { const int i = d & 7, row = row0[j] + (d & ~7);
                if (i == 0) { m[j] = -1e30f; l[j] = (f32x4){0.f, 0.f, 0.f, 0.f};
#pragma unroll
                    for (int db = 0; db < 4; ++db) o[j][db] = (f32x4){0.f, 0.f, 0.f, 0.f};
                    if (kr != kb) { qf[j][0] = qn[0]; qf[j][1] = qn[1]; } }
                tile3(slot, sg, slot + 8192, lds + LDS_CK, i * 32, lds + LDS_CV, qf[j], m[j], l[j], o[j], bias + (kr - row + 7) * 31 + dc0, bs, lane, i == 0);
                if (i == 7) { const float inv = 1.0f / l[j][0];
                    bf16_t* orow = O + (size_t)row * GW * D;
#pragma unroll
                    for (int db = 0; db < 4; ++db) { u32x2 w; w.x = cvt_pk_bf16(o[j][db][0] * inv, o[j][db][1] * inv); w.y = cvt_pk_bf16(o[j][db][2] * inv, o[j][db][3] * inv); st8(orow + (ooff + db * 16), w); } }
            } }
        if (pf) { const int ws_ = (rs + 2 >= 3) ? rs - 1 : rs + 2; *(LAS u32x4*)(lds + LDS_RING + ws_ * SLOT + ksl) = kreg; *(LAS u32x4*)(lds + LDS_RING + ws_ * SLOT + vsl) = vreg; }
        rs = (rs == 2) ? 0 : rs + 1;
        __syncthreads();
    }
}
#ifndef ATT_STRIPS
#define ATT_STRIPS 14
#endif
__device__ __forceinline__ void attn_phase(const Frame& F, const Args& a) {
    constexpr int NS = ATT_STRIPS, NFG = 16 * NS, BASE = 248 / NS, REM = 248 % NS;
    const int u = blockIdx.x;
    if (F.G == 256 && u >= NFG) {
        const int b = u - NFG;
        if (b < 32) attn_unit(F, a, b & 15, b < 16 ? 0 : 252, b < 16 ? 3 : 255, true);
        return;
    }
    for (int unit = u; unit < NFG; unit += (F.G == 256 ? 256 : F.G)) {
        const int h = unit & 15, strip = unit >> 4;
        const int rlo = 4 + strip * BASE + (strip < REM ? strip : REM), rhi = rlo + BASE + (strip < REM ? 1 : 0) - 1;
        attn_unit(F, a, h, rlo, rhi, false);
    }
    if (F.G != 256) for (int b = u; b < 32; b += F.G) attn_unit(F, a, b & 15, b < 16 ? 0 : 252, b < 16 ? 3 : 255, true);
}
}

__device__ __forceinline__ void vec_phase(const Frame& F, const Args& a) {
    float* V = (float*)(a.ws + WS_VEC); const float* modb = (const float*)(a.ws + WS_MOD);
    for (int c = F.tid; c < D; c += NT) {
#pragma unroll
        for (int l = 0; l < 2; ++l) { const float* mod = modb + (l == 0 ? 0 : 2) * 6144; const float* ng = a.norm_g + l * 4 * D;
            V[(4 + 4 * l) * D + c] = mod[2 * D + c] * ng[D + c]; V[(5 + 4 * l) * D + c] = ng[2 * D + c] * (1.0f + mod[4 * D + c]);
            V[(6 + 4 * l) * D + c] = mod[3 * D + c]; V[(7 + 4 * l) * D + c] = mod[5 * D + c] * ng[3 * D + c]; }
        const float* mod1 = modb + 2 * 6144;
        V[12 * D + c] = a.norm_g[4 * D + c] * (1.0f + mod1[D + c]); V[13 * D + c] = mod1[c];
    }
}

namespace post {
constexpr int LDS_WR = 0;
constexpr int M_TKE = MISC_OFF + 2048;
constexpr int M_TKW = MISC_OFF + 3072;
constexpr int M_RANK = MISC_OFF + 4096;
constexpr int M_LCNT = MISC_OFF + 5120;
constexpr int M_BASE = MISC_OFF + 5248;
__device__ __forceinline__ float reduce32(float (&acc)[32], int lane) {
    float a16[16], a8[8], a4[4], a2[2];
    { const bool hi = lane & 32;
#pragma unroll
      for (int i = 0; i < 16; ++i) { const float send = hi ? acc[i] : acc[i + 16], keep = hi ? acc[i + 16] : acc[i]; a16[i] = keep + __shfl_xor(send, 32); } }
    { const bool hi = lane & 16;
#pragma unroll
      for (int i = 0; i < 8; ++i) { const float send = hi ? a16[i] : a16[i + 8], keep = hi ? a16[i + 8] : a16[i]; a8[i] = keep + __shfl_xor(send, 16); } }
    { const bool hi = lane & 8;
#pragma unroll
      for (int i = 0; i < 4; ++i) { const float send = hi ? a8[i] : a8[i + 4], keep = hi ? a8[i + 4] : a8[i]; a4[i] = keep + __shfl_xor(send, 8); } }
    { const bool hi = lane & 4;
#pragma unroll
      for (int i = 0; i < 2; ++i) { const float send = hi ? a4[i] : a4[i + 2], keep = hi ? a4[i + 2] : a4[i]; a2[i] = keep + __shfl_xor(send, 4); } }
    float v; { const bool hi = lane & 2; const float send = hi ? a2[0] : a2[1], keep = hi ? a2[1] : a2[0]; v = keep + __shfl_xor(send, 2); }
    v += __shfl_xor(v, 1);
    return v;
}
__device__ __forceinline__ float reduce16(float (&acc)[16], int lane) {
    float a8[8], a4[4], a2[2];
    { const bool hi = lane & 16;
#pragma unroll
      for (int i = 0; i < 8; ++i) { const float send = hi ? acc[i] : acc[i + 8], keep = hi ? acc[i + 8] : acc[i]; a8[i] = keep + __shfl_xor(send, 16); } }
    { const bool hi = lane & 8;
#pragma unroll
      for (int i = 0; i < 4; ++i) { const float send = hi ? a8[i] : a8[i + 4], keep = hi ? a8[i + 4] : a8[i]; a4[i] = keep + __shfl_xor(send, 8); } }
    { const bool hi = lane & 4;
#pragma unroll
      for (int i = 0; i < 2; ++i) { const float send = hi ? a4[i] : a4[i + 2], keep = hi ? a4[i + 2] : a4[i]; a2[i] = keep + __shfl_xor(send, 4); } }
    float v; { const bool hi = lane & 2; const float send = hi ? a2[0] : a2[1], keep = hi ? a2[1] : a2[0]; v = keep + __shfl_xor(send, 2); }
    v += __shfl_xor(v, 1); v += __shfl_xor(v, 32);
    return v;
}
__device__ __forceinline__ unsigned wave_max_u32(unsigned v) {
    v = max(v, (unsigned)__builtin_amdgcn_update_dpp(0, (int)v, 0xB1, 0xf, 0xf, true));
    v = max(v, (unsigned)__builtin_amdgcn_update_dpp(0, (int)v, 0x4E, 0xf, 0xf, true));
    v = max(v, (unsigned)__builtin_amdgcn_update_dpp(0, (int)v, 0x124, 0xf, 0xf, true));
    v = max(v, (unsigned)__builtin_amdgcn_update_dpp(0, (int)v, 0x128, 0xf, 0xf, true));
    v = max(v, (unsigned)__builtin_amdgcn_ds_swizzle((int)v, 0x401F));
    return max((unsigned)__builtin_amdgcn_readlane((int)v, 0), (unsigned)__builtin_amdgcn_readlane((int)v, 32));
}
__device__ __forceinline__ void top4(float v, int lane, int (&ei)[4], float (&wv)[4]) {
    const int e = ((lane >> 5) << 4) | ((lane >> 1) & 15); float val[4];
    const unsigned u = __float_as_uint(v);
    unsigned key = ((u ^ ((u >> 31) ? 0xFFFFFFFFu : 0x80000000u)) & ~31u) | (unsigned)(31 - e);
#pragma unroll
    for (int k = 0; k < 4; ++k) {
        const unsigned best = wave_max_u32(key);
        ei[k] = 31 - (int)(best & 31u);
        const unsigned kb = best & ~31u; val[k] = __uint_as_float((kb & 0x80000000u) ? (kb ^ 0x80000000u) : ~kb);
        if (key == best) key = 0u;
    }
    float s = 0.f;
#pragma unroll
    for (int k = 0; k < 4; ++k) { wv[k] = __expf(val[k] - val[0]); s += wv[k]; }
    const float inv = 1.0f / s;
#pragma unroll
    for (int k = 0; k < 4; ++k) wv[k] *= inv;
}
__device__ __forceinline__ void post_phase(const Frame& F, const Args& a, int layer, const float* xin, int nfg, bool do_lists = true) {
    const float* V = (const float*)(a.ws + WS_VEC) + (size_t)(4 + 4 * layer) * D;
    const float* wrt = a.w_router + (size_t)layer * D * NE; const float* brt = a.b_router + layer * NE;
    const rsrc_t rMX = mk_rsrc(a.ws + WS_MX, L * D * 2), rX = mk_rsrc(xin, L * D * 4), rXR = mk_rsrc(a.ws + WS_XR, L * D * 2), rH = mk_rsrc(a.ws + WS_HX2, L * D), rV = mk_rsrc(V, 3 * D * 4);
    int* list = (int*)(a.ws + WS_LIST); float* gate = (float*)(a.ws + WS_GATE); unsigned* gcnt = (unsigned*)(a.ws + WS_CTL) + CW_CNT + 64 * layer;
    LAS unsigned char* lds = F.lds; const int tid = F.tid, lane = F.lane;
    LAS int* tke = (LAS int*)(lds + M_TKE); LAS float* tkw = (LAS float*)(lds + M_TKW); LAS int* rank = (LAS int*)(lds + M_RANK); LAS int* lcnt = (LAS int*)(lds + M_LCNT); LAS int* lbase = (LAS int*)(lds + M_BASE);
    __syncthreads();
    constexpr int XT_HI = 0, XT_LO = 32768, PART = 65536;
    const int wid = F.wave, fr = lane & 15, fq = lane >> 4, et = wid & 1, kq = wid >> 1;
    bf16x8 wh[8], wl[8];
    { const bf16_t* wrt = (const bf16_t*)(a.ws + WS_WRT) + (size_t)(layer * 2) * NE * D + (size_t)(16 * et + fr) * D + kq * 256 + 8 * fq;
#pragma unroll
      for (int s_ = 0; s_ < 8; ++s_) { wh[s_] = *(const bf16x8*)(wrt + 32 * s_); wl[s_] = *(const bf16x8*)(wrt + (size_t)NE * D + 32 * s_); } }
    const int el = ((lane >> 5) << 4) | ((lane >> 1) & 15);
    const float bre = brt[el];
    constexpr int CST = 73728;
    for (int i = tid; i < 3 * D / 4; i += NT) *(LAS f32x4*)(lds + CST + i * 16) = *(const f32x4*)(V + 4 * i);
    __syncthreads();
    auto cst_row = [&](int v) { Row r;
#pragma unroll
        for (int j = 0; j < 4; ++j) r.v[j] = *(const LAS f32x4*)(lds + CST + v * 4096 + j * 1024 + lane * 16);
        return r; };
    for (int tile = blockIdx.x; tile < L / 64; tile += nfg) {
        { unsigned l_; asm volatile("v_mbcnt_lo_u32_b32 %0, -1, 0\n\tv_mbcnt_hi_u32_b32 %0, -1, %0" : "=v"(l_)); if (F.wave == 0 && l_ < 32u) lcnt[l_] = 0; }
        __syncthreads();
        u32x2 mra[4], mrb[4]; Row xna, xnb; u32x2 xra[4], xrb[4];
        { const unsigned t0 = (unsigned)(tile * 64 + 2 * wid);
          row_load_bf16_raw(rMX, t0 * D * 2, lane, mra); row_load_bf16_raw(rMX, (t0 + 1) * D * 2, lane, mrb);
          if (layer == 0) { xna = row_load_f32(rX, t0 * D * 4, lane); xnb = row_load_f32(rX, (t0 + 1) * D * 4, lane); }
          else { row_load_bf16_raw(rXR, t0 * D * 2, lane, xra); row_load_bf16_raw(rXR, (t0 + 1) * D * 2, lane, xrb); } }
        for (int b = 0; b < 4; ++b) {
            const int lr = 16 * b + 2 * wid; const unsigned t0 = (unsigned)(tile * 64 + lr);
            Row xa, xb;
            {   const Row ma = row_unpack_bf16(mra), mb = row_unpack_bf16(mrb);
                if (layer == 0) { xa = xna; xb = xnb; } else { xa = row_unpack_bf16(xra); xb = row_unpack_bf16(xrb); }
                if (b < 3) { const unsigned t1 = t0 + 16;
                    row_load_bf16_raw(rMX, t1 * D * 2, lane, mra); row_load_bf16_raw(rMX, (t1 + 1) * D * 2, lane, mrb);
                    if (layer == 0) { xna = row_load_f32(rX, t1 * D * 4, lane); xnb = row_load_f32(rX, (t1 + 1) * D * 4, lane); }
                    else { row_load_bf16_raw(rXR, t1 * D * 2, lane, xra); row_load_bf16_raw(rXR, (t1 + 1) * D * 2, lane, xrb); } }
                const float ra = rstd_of(row_sumsq(ma)), rb = rstd_of(row_sumsq(mb));
                const Row cA = cst_row(0);
#pragma unroll
                for (int j = 0; j < 4; ++j) { xa.v[j] += cA.v[j] * (ma.v[j] * ra); xb.v[j] += cA.v[j] * (mb.v[j] * rb); } }
            row_store_bf16(rXR, t0 * D * 2, lane, xa); row_store_bf16(rXR, (t0 + 1) * D * 2, lane, xb);
            { const float ra = rstd_of(row_sumsq(xa)), rb = rstd_of(row_sumsq(xb));
              const Row cB = cst_row(1), cC = cst_row(2);
#pragma unroll
              for (int j = 0; j < 4; ++j) { xa.v[j] = xa.v[j] * ra * cB.v[j] + cC.v[j]; xb.v[j] = xb.v[j] * rb * cB.v[j] + cC.v[j]; } }
            row_store_fp8(rH, t0 * D, lane, xa); row_store_fp8(rH, (t0 + 1) * D, lane, xb);
#pragma unroll
            for (int rr = 0; rr < 2; ++rr) { const Row& xr = rr ? xb : xa; const int row = 2 * wid + rr;
#pragma unroll
                for (int j = 0; j < 4; ++j) { const f32x4 v = xr.v[j];
                    u32x2 h; h.x = cvt_pk_bf16(v[0], v[1]); h.y = cvt_pk_bf16(v[2], v[3]);
                    u32x2 lo; lo.x = cvt_pk_bf16(v[0] - bf_lo(h.x), v[1] - bf_hi(h.x)); lo.y = cvt_pk_bf16(v[2] - bf_lo(h.y), v[3] - bf_hi(h.y));
                    const unsigned ad = (unsigned)row * 2048u + ((((unsigned)(lane >> 1) + 32u * j) ^ (unsigned)row) << 4) + ((unsigned)(lane & 1) << 3);
                    *(LAS u32x2*)(lds + XT_HI + ad) = h; *(LAS u32x2*)(lds + XT_LO + ad) = lo; } }
            __syncthreads();
            {   f32x4 acc = {0.f, 0.f, 0.f, 0.f};
#pragma unroll
                for (int s_ = 0; s_ < 8; ++s_) { const unsigned ad = (unsigned)fr * 2048u + ((((unsigned)(4 * (kq * 8 + s_) + fq)) ^ (unsigned)fr) << 4);
                    const bf16x8 xh = *(const LAS bf16x8*)(lds + XT_HI + ad), xl = *(const LAS bf16x8*)(lds + XT_LO + ad);
                    acc = __builtin_amdgcn_mfma_f32_16x16x32_bf16(wh[s_], xh, acc, 0, 0, 0);
                    acc = __builtin_amdgcn_mfma_f32_16x16x32_bf16(wh[s_], xl, acc, 0, 0, 0);
                    acc = __builtin_amdgcn_mfma_f32_16x16x32_bf16(wl[s_], xh, acc, 0, 0, 0); }
                LAS float* pp = (LAS float*)(lds + PART) + (kq * 2 + et) * 256 + (4 * fq) * 16 + fr;
#pragma unroll
                for (int r_ = 0; r_ < 4; ++r_) pp[r_ * 16] = acc[r_]; }
            __syncthreads();
            {   const LAS float* pp = (const LAS float*)(lds + PART) + (lane >> 5) * 256 + ((lane >> 1) & 15) * 16 + 2 * wid;
                float la = bre, lb = bre;
#pragma unroll
                for (int q_ = 0; q_ < 4; ++q_) { la += pp[q_ * 512]; lb += pp[q_ * 512 + 1]; }
                int ea[4], eb[4]; float wa[4], wb[4];
                top4(la, lane, ea, wa); top4(lb, lane, eb, wb);
                if (lane == 0) {
#pragma unroll
                    for (int k = 0; k < 4; ++k) { tke[lr * 4 + k] = ea[k]; tkw[lr * 4 + k] = wa[k]; tke[(lr + 1) * 4 + k] = eb[k]; tkw[(lr + 1) * 4 + k] = wb[k]; } } }
        }
        __syncthreads();
        if (do_lists) {
            unsigned l_; asm volatile("v_mbcnt_lo_u32_b32 %0, -1, 0\n\tv_mbcnt_hi_u32_b32 %0, -1, %0" : "=v"(l_)); const int t2 = F.wave * 64 + (int)l_;
            int e = 0;
            if (t2 < 256) { e = tke[t2]; rank[t2] = atomicAdd((int*)&lcnt[e], 1); }
            __syncthreads();
            if (t2 < 32) { const int n = lcnt[t2]; lbase[t2] = n ? (int)atomicAdd(gcnt + t2, (unsigned)n) : 0; }
            __syncthreads();
            if (t2 < 256) { const int pos = lbase[e] + rank[t2], slot = tile * 256 + t2; list[e * LIST_CAP + pos] = slot; gate[e * LIST_CAP + pos] = tkw[t2];
                if (Y_SORTED) ((int*)(a.ws + WS_POS))[slot] = (e << 16) | pos; }
            __syncthreads();
        }
    }
}
}

constexpr int M_TSTART = MISC_OFF + 256, M_CNT = MISC_OFF + 512, M_TILEE = MISC_OFF + 768;
__device__ __forceinline__ gm::MoeTab moe_tables(const Frame& F, const Args& a, int layer) {
    LAS int* tstart = (LAS int*)(F.lds + M_TSTART); LAS int* cnt = (LAS int*)(F.lds + M_CNT); LAS unsigned char* tile_e = F.lds + M_TILEE;
    const unsigned* gcnt = (const unsigned*)(a.ws + WS_CTL) + CW_CNT + 64 * layer;
    __syncthreads();
    if (F.wave == 0) {
        const int e = F.lane & 31;
        const int n = (int)__hip_atomic_load(gcnt + e, __ATOMIC_RELAXED, __HIP_MEMORY_SCOPE_AGENT), nt = (n + 255) >> 8;
        int ts = 0, tot = 0;
#pragma unroll
        for (int j = 0; j < 32; ++j) { const int v = __builtin_amdgcn_readlane(nt, j); if (j < e) ts += v; tot += v; }
        if (F.lane < 32) { cnt[e] = n; tstart[e] = ts; if (e == 31) tstart[32] = tot;
            for (int t = 0; t < nt; ++t) tile_e[ts + t] = (unsigned char)e; }
    }
    __syncthreads();
    const int T = __builtin_amdgcn_readfirstlane(tstart[32]);
    gm::MoeTab tb; tb.tstart = tstart; tb.cnt = cnt; tb.tile_e = tile_e; tb.T = T; return tb;
}

template <int layer> __device__ __forceinline__ void combine_phase(const Frame& F, const Args& a) {
    const float* V = (const float*)(a.ws + WS_VEC);
    const rsrc_t rY = mk_rsrc(a.ws + WS_Y, Y_SORTED ? (unsigned)ACT_ROWS * D : (unsigned)L * 4 * D * (Y_FP8 ? 1 : 2)), rO = mk_rsrc(a.out, L * D * 4), rXR = mk_rsrc(a.ws + WS_XR, L * D * 2), rHX = mk_rsrc(a.ws + WS_HX, L * D * 2), rV = mk_rsrc(V, 16 * D * 4);
    const int lane = F.lane, gw = F.vcu * NWAVES + F.wave, NGW = F.G * NWAVES;
    const Row cD = row_load_f32(rV, (7 + 4 * layer) * D * 4, lane);
    Row cE, cF;
    if (layer == 0) { cE = row_load_f32(rV, 12 * D * 4, lane); cF = row_load_f32(rV, 13 * D * 4, lane); }
#if Y_FP8 && Y_SORTED
    struct Raw { unsigned y[4][4]; u32x2 x[4]; };
    auto load_raw = [&](int rowv, int ii, int t, Raw& r) {
#pragma unroll
        for (int k = 0; k < 4; ++k) { const unsigned row = (unsigned)__builtin_amdgcn_readlane(rowv, 4 * ii + k);
#pragma unroll
            for (int j = 0; j < 4; ++j) r.y[k][j] = (unsigned)__builtin_amdgcn_raw_buffer_load_b32(rY, 4 * lane, ((((row >> 8) << 2) + j) << 16) + ((row & 255u) << 8), ROW_LD_NT); }
#elif Y_FP8
    struct Raw { unsigned y[4][4]; u32x2 x[4]; };
    auto load_raw = [&](int t, Raw& r) {
#pragma unroll
        for (int k = 0; k < 4; ++k)
#pragma unroll
            for (int j = 0; j < 4; ++j) r.y[k][j] = (unsigned)__builtin_amdgcn_raw_buffer_load_b32(rY, 4 * lane, ((unsigned)t * 4 + k) * D + 256 * j, 0);
#else
    struct Raw { u32x2 y[4][4]; u32x2 x[4]; };
    auto load_raw = [&](int t, Raw& r) {
#pragma unroll
        for (int k = 0; k < 4; ++k) row_load_bf16_raw(rY, ((unsigned)t * 4 + k) * D * 2, lane, r.y[k]);
#endif
        row_load_bf16_raw(rXR, (unsigned)t * D * 2, lane, r.x);
    };
    auto finish = [&](int t, const Raw& r) {
        Row f, x = row_unpack_bf16(r.x);
#pragma unroll
        for (int j = 0; j < 4; ++j) { f.v[j] = (f32x4){0.f, 0.f, 0.f, 0.f};
#pragma unroll
            for (int k = 0; k < 4; ++k) {
#if Y_FP8
                const f32x2 a_ = __builtin_amdgcn_cvt_pk_f32_fp8((int)r.y[k][j], false), b_ = __builtin_amdgcn_cvt_pk_f32_fp8((int)r.y[k][j], true); f.v[j] += (f32x4){a_[0], a_[1], b_[0], b_[1]};
#else
                const u32x2 w = r.y[k][j]; f.v[j] += (f32x4){bf_lo(w.x), bf_hi(w.x), bf_lo(w.y), bf_hi(w.y)};
#endif
            } }
#if Y_FP8
#pragma unroll
        for (int j = 0; j < 4; ++j) f.v[j] = f.v[j] * 0.25f;
#endif
        const float rs = rstd_of(row_sumsq(f));
#pragma unroll
        for (int j = 0; j < 4; ++j) x.v[j] += cD.v[j] * (f.v[j] * rs);
        if (layer == 0) row_store_bf16(rXR, (unsigned)t * D * 2, lane, x); else row_store_f32(rO, (unsigned)t * D * 4, lane, x);
        if (layer == 0) { const float r2 = rstd_of(row_sumsq(x));
#pragma unroll
            for (int j = 0; j < 4; ++j) x.v[j] = x.v[j] * r2 * cE.v[j] + cF.v[j];
            row_store_bf16(rHX, (unsigned)t * D * 2, lane, x); }
    };
#if Y_FP8 && Y_SORTED
    const int* posp = (const int*)(a.ws + WS_POS); const LAS int* tstart = (const LAS int*)(F.lds + M_TSTART);
#pragma unroll 1
    for (int i0 = 0; gw + i0 * NGW < L; i0 += 16) {
        int rowv = 0; { const int t_ = gw + (i0 + (lane >> 2)) * NGW; if (t_ < L) { const int pv = posp[4 * t_ + (lane & 3)]; rowv = (tstart[pv >> 16] << 8) + (pv & 0xffff); } }
#pragma unroll 1
        for (int ii = 0; ii < 16; ii += 2) { const int t0 = gw + (i0 + ii) * NGW, t1 = t0 + NGW; if (t0 >= L) break;
            Raw ra, rb; load_raw(rowv, ii, t0, ra); if (t1 < L) load_raw(rowv, ii + 1, t1, rb); finish(t0, ra); if (t1 < L) finish(t1, rb); }
    }
#else
    int t = gw;
    for (; t + NGW < L; t += 2 * NGW) { Raw ra, rb; load_raw(t, ra); load_raw(t + NGW, rb); finish(t, ra); finish(t + NGW, rb); }
    for (; t < L; t += NGW) { Raw ra; load_raw(t, ra); finish(t, ra); }
#endif
}

__device__ __forceinline__ void diff_phase(const Frame& F, const Args& a) {
    const bf16_t* HX = (const bf16_t*)(a.ws + WS_HX); bf16_t* DF = (bf16_t*)(a.ws + WS_O);
    const int cg = F.tid & 127, rg = F.tid >> 7, g = cg >> 5, hs = 1 << g;
    for (int tile = blockIdx.x; tile < L / 64; tile += F.G) {
        const int t0 = tile * 64 + rg * 16;
        float sum[8];
#pragma unroll
        for (int i = 0; i < 8; ++i) sum[i] = 0.f;
        const int lo0 = max(t0 - hs, 0), hi0 = min(t0 + hs, L);
        for (int u = lo0; u < hi0; ++u) { const u32x4 w = *(const u32x4*)(HX + (size_t)u * D + cg * 8);
            sum[0] += bf_lo(w.x); sum[1] += bf_hi(w.x); sum[2] += bf_lo(w.y); sum[3] += bf_hi(w.y); sum[4] += bf_lo(w.z); sum[5] += bf_hi(w.z); sum[6] += bf_lo(w.w); sum[7] += bf_hi(w.w); }
        for (int t = t0; t < t0 + 16; ++t) {
            const int lo = max(t - hs, 0), hi = min(t + hs, L); const float ic = 1.0f / (float)(hi - lo);
            const u32x4 w = *(const u32x4*)(HX + (size_t)t * D + cg * 8);
            const float cv[8] = {bf_lo(w.x), bf_hi(w.x), bf_lo(w.y), bf_hi(w.y), bf_lo(w.z), bf_hi(w.z), bf_lo(w.w), bf_hi(w.w)};
            u32x4 o; o.x = cvt_pk_bf16(sum[0] * ic - cv[0], sum[1] * ic - cv[1]); o.y = cvt_pk_bf16(sum[2] * ic - cv[2], sum[3] * ic - cv[3]);
            o.z = cvt_pk_bf16(sum[4] * ic - cv[4], sum[5] * ic - cv[5]); o.w = cvt_pk_bf16(sum[6] * ic - cv[6], sum[7] * ic - cv[7]);
            st16(DF + (size_t)t * D + cg * 8, o);
            if (t + hs < L) { const u32x4 e = *(const u32x4*)(HX + (size_t)(t + hs) * D + cg * 8);
                sum[0] += bf_lo(e.x); sum[1] += bf_hi(e.x); sum[2] += bf_lo(e.y); sum[3] += bf_hi(e.y); sum[4] += bf_lo(e.z); sum[5] += bf_hi(e.z); sum[6] += bf_lo(e.w); sum[7] += bf_hi(e.w); }
            if (t - hs >= 0) { const u32x4 e = *(const u32x4*)(HX + (size_t)(t - hs) * D + cg * 8);
                sum[0] -= bf_lo(e.x); sum[1] -= bf_hi(e.x); sum[2] -= bf_lo(e.y); sum[3] -= bf_hi(e.y); sum[4] -= bf_lo(e.z); sum[5] -= bf_hi(e.z); sum[6] -= bf_lo(e.w); sum[7] -= bf_hi(e.w); }
        }
    }
}

__device__ __forceinline__ void diff_tile(const Frame& F, const Args& a, int pm, int g) {
    const bf16_t* HX = (const bf16_t*)(a.ws + WS_HX); bf16_t* DF = (bf16_t*)(a.ws + WS_O);
    const int col = g * 256 + (F.tid & 31) * 8, hs = 1 << g, t0 = pm * 256 + (F.tid >> 5) * 16;
    float sum[8];
#pragma unroll
    for (int i = 0; i < 8; ++i) sum[i] = 0.f;
    const int lo0 = max(t0 - hs, 0), hi0 = min(t0 + hs, L);
    for (int u = lo0; u < hi0; ++u) { const u32x4 w = *(const u32x4*)(HX + (size_t)u * D + col);
        sum[0] += bf_lo(w.x); sum[1] += bf_hi(w.x); sum[2] += bf_lo(w.y); sum[3] += bf_hi(w.y); sum[4] += bf_lo(w.z); sum[5] += bf_hi(w.z); sum[6] += bf_lo(w.w); sum[7] += bf_hi(w.w); }
    for (int t = t0; t < t0 + 16; ++t) {
        const int lo = max(t - hs, 0), hi = min(t + hs, L); const float ic = 1.0f / (float)(hi - lo);
        const u32x4 w = *(const u32x4*)(HX + (size_t)t * D + col);
        const float cv[8] = {bf_lo(w.x), bf_hi(w.x), bf_lo(w.y), bf_hi(w.y), bf_lo(w.z), bf_hi(w.z), bf_lo(w.w), bf_hi(w.w)};
        u32x4 o; o.x = cvt_pk_bf16(sum[0] * ic - cv[0], sum[1] * ic - cv[1]); o.y = cvt_pk_bf16(sum[2] * ic - cv[2], sum[3] * ic - cv[3]);
        o.z = cvt_pk_bf16(sum[4] * ic - cv[4], sum[5] * ic - cv[5]); o.w = cvt_pk_bf16(sum[6] * ic - cv[6], sum[7] * ic - cv[7]);
        st16(DF + (size_t)t * D + col, o);
        if (t + hs < L) { const u32x4 e = *(const u32x4*)(HX + (size_t)(t + hs) * D + col);
            sum[0] += bf_lo(e.x); sum[1] += bf_hi(e.x); sum[2] += bf_lo(e.y); sum[3] += bf_hi(e.y); sum[4] += bf_lo(e.z); sum[5] += bf_hi(e.z); sum[6] += bf_lo(e.w); sum[7] += bf_hi(e.w); }
        if (t - hs >= 0) { const u32x4 e = *(const u32x4*)(HX + (size_t)(t - hs) * D + col);
            sum[0] -= bf_lo(e.x); sum[1] -= bf_hi(e.x); sum[2] -= bf_lo(e.y); sum[3] -= bf_hi(e.y); sum[4] -= bf_lo(e.z); sum[5] -= bf_hi(e.z); sum[6] -= bf_lo(e.w); sum[7] -= bf_hi(e.w); }
    }
}

constexpr int N_PHASES = 15;
__global__ void __launch_bounds__(NT, 2) mk_fwd(Args args) {
    extern __shared__ __attribute__((aligned(16))) unsigned char lds_raw[];
    Frame F; F.lds = (LAS unsigned char*)lds_raw; F.tid = 0; F.lane = 0; F.wave = __builtin_amdgcn_readfirstlane(threadIdx.x >> 6);
    F.G = gridDim.x; { const int bx = blockIdx.x; F.vcu = (F.G % 8 == 0) ? (bx % 8) * (F.G / 8) + bx / 8 : bx; }
    volatile LAS unsigned* MISC = (volatile LAS unsigned*)(F.lds + MISC_OFF);
    if (threadIdx.x < 16) MISC[threadIdx.x] = 0u;
    __syncthreads();
    const int lo = args.ph_lo, hi = args.ph_hi;
    unsigned* ctl = (unsigned*)(args.ws + WS_CTL);
    XcdBarrier bar; bar.bar = ctl + CW_BAR; bar.x = 0; bar.st = nullptr;
    if (hi - lo > 1) bar = xcd_barrier_post(ctl + CW_BAR, MISC + 8, threadIdx.x == 0);
#ifndef P0_CONV_WGS
#define P0_CONV_WGS 0
#endif
#ifndef PROBE_BAR2
#define PROBE_BAR2 0
#endif
#ifndef POST_FG
#define POST_FG 256
#endif
#ifndef CTX_IN_P1
#define CTX_IN_P1 0
#endif
#ifndef MOE_EXTRA_ROUNDS
#define MOE_EXTRA_ROUNDS 0
#endif
#ifndef FUSE_DIFF
#define FUSE_DIFF 1
#endif
#ifndef BG_STOP_NUM
#define BG_STOP_NUM 1
#define BG_STOP_DEN 1
#endif
#ifndef BG_MASK
#define BG_MASK 0xffff
#endif
#ifndef PROBE_DUP
#define PROBE_DUP 0
#endif
#ifndef STAGGER
#define STAGGER 0
#endif

#define REPS(k) (((PROBE_DUP >> (k)) & 1) ? 2 : 1)
#ifndef PH_MASK
#define PH_MASK 0x7fff
#endif
#define IN(k) (((PH_MASK >> (k)) & 1) && lo <= (k) && (k) < hi)
#define PHASE_FRAME() Frame Fp = F; { unsigned l_; asm volatile("v_mbcnt_lo_u32_b32 %0, -1, 0\n\tv_mbcnt_hi_u32_b32 %0, -1, %0" : "=v"(l_)); Fp.lane = (int)l_; Fp.tid = F.wave * 64 + (int)l_; }
#define SEAM(k) do { if (IN(k) && IN((k) + 1)) { unsigned l_; asm volatile("v_mbcnt_lo_u32_b32 %0, -1, 0\n\tv_mbcnt_hi_u32_b32 %0, -1, %0" : "=v"(l_)); xcd_barrier(bar, F.wave == 0 && l_ == 0u); if (PROBE_BAR2) xcd_barrier(bar, F.wave == 0 && l_ == 0u); } } while (0)
    unsigned char* ws = args.ws;
    bf16_t* HX = (bf16_t*)(ws + WS_HX);
    const float* mod0 = (const float*)(ws + WS_MOD);

    if (IN(0)) for (int rep_ = 0; rep_ < REPS(0); ++rep_) { PHASE_FRAME(); p0_adaln(Fp, args); p0_router_weights(Fp, args); p0_convert_small(Fp, args); if ((int)blockIdx.x < P0_CONV_WGS) { bg_convert(Fp, args, 0, 0, 0u, false); bg_convert(Fp, args, 1, 0, 0u, false); } }
    SEAM(0);
    const bool ctx_p1 = CTX_IN_P1 && !QKV_FP8 && F.G == 256;
    if (IN(1)) for (int rep_ = 0; rep_ < REPS(1); ++rep_) { PHASE_FRAME();
        if (ctx_p1) {
            if (blockIdx.x >= 248) {
                modulate_rows(Fp, args.ctx, CTX, args.norm_g, mod0 + 6144, mod0 + 6144 + D, HX + (size_t)L * D, Fp.wave, NWAVES);
                asm volatile("s_waitcnt vmcnt(0)" ::: "memory"); __syncthreads();
                gm::OneProb P{(const char*)HX, (const char*)(ws + WS_WQKV), 2048u, 2048u, 1024, L / 256, 4 + ((int)blockIdx.x - 248), (size_t)256 * 2048};
                gm::EpiBf16 E{(bf16_t*)(ws + WS_Q), D, nullptr, nullptr, D, (size_t)(WS_K - WS_Q) / 2, QSCALE, 256, 1.f};
                gm::gemm_phase(Fp.lds, Fp.tid, P, E);
            } else {
                modulate_rows(Fp, args.x, L, args.norm_g, mod0, mod0 + D, HX, (int)blockIdx.x * NWAVES + Fp.wave, 248 * NWAVES);
                if (blockIdx.x == 247) vec_phase(Fp, args);
            }
        } else {
            modulate_rows<QKV_FP8 != 0>(Fp, args.x, L, args.norm_g, mod0, mod0 + D, HX, Fp.vcu * NWAVES + Fp.wave, (int)F.G * NWAVES);
            modulate_rows<QKV_FP8 != 0>(Fp, args.ctx, CTX, args.norm_g, mod0 + 6144, mod0 + 6144 + D, QKV_FP8 ? (void*)((unsigned char*)HX + (size_t)L * D) : (void*)(HX + (size_t)L * D), Fp.vcu * NWAVES + Fp.wave, (int)F.G * NWAVES);
            if (blockIdx.x == gridDim.x - 1) vec_phase(Fp, args);
        }
    }
    SEAM(1);
    if (IN(2)) for (int rep_ = 0; rep_ < REPS(2); ++rep_) { PHASE_FRAME();
        const int nMq = ctx_p1 ? L / 256 : MQ / 256, NU = nMq * 12; const int Gf = min((int)F.G, (NU + ((NU + F.G - 1) / F.G) - 1) / ((NU + F.G - 1) / F.G));
        if ((int)blockIdx.x < Gf) {
#if QKV_FP8
            gm::DenseProbT<true> P{(const char*)HX, (const char*)(ws + WS_WQKV), 1024u, 1024u, 1024, nMq, 12, Gf, (int)blockIdx.x, 0, (size_t)256 * 1024};
            gm::EpiBf16 E{(bf16_t*)(ws + WS_Q), D, nullptr, nullptr, D, (size_t)(WS_K - WS_Q) / 2, QSCALE, 256, 0.015625f};
#else
            gm::DenseProb P{(const char*)HX, (const char*)(ws + WS_WQKV), 2048u, 2048u, 1024, nMq, 12, Gf, (int)blockIdx.x, 0, (size_t)256 * 2048};
            gm::EpiBf16 E{(bf16_t*)(ws + WS_Q), D, nullptr, nullptr, D, (size_t)(WS_K - WS_Q) / 2, QSCALE, 256, 1.f};
#endif
            gm::gemm_phase(Fp.lds, Fp.tid, P, E);
        }
        if ((BG_MASK >> 2) & 1) { PHASE_FRAME(); bg_convert(Fp, args, 0, 2, (unsigned)max(1, Gf * BG_STOP_NUM / BG_STOP_DEN), (int)blockIdx.x < Gf); }
    }
    SEAM(2);
    if (IN(3)) for (int rep_ = 0; rep_ < REPS(3); ++rep_) { PHASE_FRAME(); na::attn_phase(Fp, args);
        if (F.G == 256 && ((BG_MASK >> 3) & 1)) { PHASE_FRAME(); bg_convert(Fp, args, 0, 3, (unsigned)max(1, 16 * ATT_STRIPS * BG_STOP_NUM / BG_STOP_DEN), (int)blockIdx.x < 16 * ATT_STRIPS); } }
    SEAM(3);
    if (IN(4)) for (int rep_ = 0; rep_ < REPS(4); ++rep_) { PHASE_FRAME();
        gm::DenseProb P{(const char*)(ws + WS_O), (const char*)(ws + WS_WO), 2048u, 2048u, 1024, L / 256, 4, F.G, (int)blockIdx.x, 0, (size_t)256 * 2048};
        gm::EpiBf16 E{(bf16_t*)(ws + WS_MX), D, nullptr, nullptr, 0, 0, 1.f, 256, 1.f};
        gm::gemm_phase(Fp.lds, Fp.tid, P, E);
    }
    SEAM(4);
    if (IN(5)) for (int rep_ = 0; rep_ < REPS(5); ++rep_) { const int nfg = (F.G == 256) ? POST_FG : (int)F.G;
        if ((int)blockIdx.x < nfg) { PHASE_FRAME(); post::post_phase(Fp, args, 0, args.x, nfg, rep_ == REPS(5) - 1); }
        { PHASE_FRAME(); bg_convert(Fp, args, 0, 5, 0u, false); } }
    SEAM(5);
    if (IN(6)) for (int rep_ = 0; rep_ < REPS(6); ++rep_) { PHASE_FRAME();
        const gm::MoeTab tb = moe_tables(Fp, args, 0);
        const int NU = tb.T * 8, rounds = (NU + F.G - 1) / F.G + MOE_EXTRA_ROUNDS, Gf = min((int)F.G, (NU + rounds - 1) / rounds);
        if ((int)blockIdx.x < Gf) {
            const bool hot_ = PROBE_HOT == 1 && REPS(6) == 2 && rep_ == 0; const unsigned ld_ = hot_ ? 0u : 1024u;
            gm::MoeProb<true> P{(const char*)(ws + WS_HX2), (const char*)(ws + WS_WUP), ld_, ld_, 1024, 8, Gf, (int)blockIdx.x, tb, (const int*)(ws + WS_LIST), hot_ ? (size_t)0 : (size_t)2048 * 1024, hot_ ? (size_t)0 : (size_t)256 * 1024};
            gm::EpiSwiglu E{ws + WS_ACT, args.b_up};
#if PROBE_NOEPI
            E.skip = REPS(6) == 2 && rep_ == 0;
#endif
            gm::gemm_phase(Fp.lds, Fp.tid, P, E);
        }
        if ((BG_MASK >> 6) & 1) { PHASE_FRAME(); bg_convert(Fp, args, 1, 6, (unsigned)max(1, Gf * BG_STOP_NUM / BG_STOP_DEN), (int)blockIdx.x < Gf); }
    }
    SEAM(6);
    if (IN(7)) for (int rep_ = 0; rep_ < REPS(7); ++rep_) { PHASE_FRAME();
        const gm::MoeTab tb = moe_tables(Fp, args, 0);
        const int NU = tb.T * 4, rounds = (NU + F.G - 1) / F.G + MOE_EXTRA_ROUNDS, Gf = min((int)F.G, (NU + rounds - 1) / rounds);
        if (STAGGER && (blockIdx.x & 1)) for (int i_ = 0; i_ < STAGGER; ++i_) __builtin_amdgcn_s_sleep(64);
        if ((int)blockIdx.x < Gf) {
            const bool hot_ = PROBE_HOT == 1 && REPS(7) == 2 && rep_ == 0; const unsigned ld_ = hot_ ? 0u : 1024u;
            gm::MoeProb<false> P{(const char*)(ws + WS_ACT), (const char*)(ws + WS_WDN), ld_, ld_, 1024, 4, Gf, (int)blockIdx.x, tb, (const int*)(ws + WS_LIST), hot_ ? (size_t)0 : (size_t)1024 * 1024, hot_ ? (size_t)0 : (size_t)256 * 1024};
#if PROBE_HOT == 2
            P.same = REPS(7) == 2 && rep_ == 0;
#endif
            gm::EpiDown E{ws + WS_Y, args.b_down, (const float*)(ws + WS_GATE), (const int*)(ws + WS_LIST), tb, Fp.lds};
#if PROBE_NOEPI
            E.skip = REPS(7) == 2 && rep_ == 0;
#endif
            gm::gemm_phase(Fp.lds, Fp.tid, P, E);
        }
        if ((BG_MASK >> 7) & 1) { PHASE_FRAME(); bg_convert(Fp, args, 1, 7, (unsigned)max(1, Gf * BG_STOP_NUM / BG_STOP_DEN), (int)blockIdx.x < Gf); }
    }
    SEAM(7);
    if (IN(8)) for (int rep_ = 0; rep_ < REPS(8); ++rep_) { PHASE_FRAME(); if (Y_SORTED) (void)moe_tables(Fp, args, 0); combine_phase<0>(Fp, args); }
    SEAM(8);
    if (!FUSE_DIFF) { if (IN(9)) for (int rep_ = 0; rep_ < REPS(9); ++rep_) { PHASE_FRAME(); diff_phase(Fp, args); }
        SEAM(9); }
    if (IN(10)) for (int rep_ = 0; rep_ < REPS(10); ++rep_) { PHASE_FRAME();
        gm::DenseProb P{(const char*)(ws + WS_O), (const char*)(ws + WS_WPOOL), 2048u, 512u, 256, L / 256, 4, F.G, (int)blockIdx.x, 512, (size_t)256 * 512};
        if (FUSE_DIFF) {
            gm::Unit u_; for (int i_ = 0; P.next(i_, u_); ++i_) diff_tile(Fp, args, u_.pm, u_.pn);
            asm volatile("s_waitcnt vmcnt(0)" ::: "memory"); __syncthreads();
        }
        gm::EpiBf16 E{(bf16_t*)(ws + WS_MX), D, args.pool_b, args.pool_scale, 0, 0, 1.f, 256, 1.f};
        gm::gemm_phase(Fp.lds, Fp.tid, P, E);
    }
    SEAM(10);
    if (IN(11)) for (int rep_ = 0; rep_ < REPS(11); ++rep_) { const int nfg = (F.G == 256) ? POST_FG : (int)F.G;
        if ((int)blockIdx.x < nfg) { PHASE_FRAME(); post::post_phase(Fp, args, 1, args.x, nfg); }
        { PHASE_FRAME(); bg_convert(Fp, args, 1, 11, 0u, false); } }
    SEAM(11);
    if (IN(12)) for (int rep_ = 0; rep_ < REPS(12); ++rep_) { PHASE_FRAME();
        const gm::MoeTab tb = moe_tables(Fp, args, 1);
        gm::MoeProb<true> P{(const char*)(ws + WS_HX2), (const char*)(ws + WS_WUP) + (size_t)32 * 2048 * 1024, 1024u, 1024u, 1024, 8, F.G, (int)blockIdx.x, tb, (const int*)(ws + WS_LIST), (size_t)2048 * 1024, (size_t)256 * 1024};
        gm::EpiSwiglu E{ws + WS_ACT, args.b_up + 32 * 2048};
        gm::gemm_phase(Fp.lds, Fp.tid, P, E);
    }
    SEAM(12);
    if (IN(13)) for (int rep_ = 0; rep_ < REPS(13); ++rep_) { PHASE_FRAME();
        const gm::MoeTab tb = moe_tables(Fp, args, 1);
        if (STAGGER && (blockIdx.x & 1)) for (int i_ = 0; i_ < STAGGER; ++i_) __builtin_amdgcn_s_sleep(64);
        gm::MoeProb<false> P{(const char*)(ws + WS_ACT), (const char*)(ws + WS_WDN) + (size_t)32 * 1024 * 1024, 1024u, 1024u, 1024, 4, F.G, (int)blockIdx.x, tb, (const int*)(ws + WS_LIST), (size_t)1024 * 1024, (size_t)256 * 1024};
        gm::EpiDown E{ws + WS_Y, args.b_down + 32 * D, (const float*)(ws + WS_GATE), (const int*)(ws + WS_LIST), tb, Fp.lds};
        gm::gemm_phase(Fp.lds, Fp.tid, P, E);
    }
    SEAM(13);
    if (IN(14)) for (int rep_ = 0; rep_ < REPS(14); ++rep_) { PHASE_FRAME(); if (Y_SORTED) (void)moe_tables(Fp, args, 1); combine_phase<1>(Fp, args); }
#undef IN
#undef SEAM
#undef PHASE_FRAME
}

extern "C" void kernel_launch(void* const* d_in, const int* in_sizes, int n_in, void* d_out, int out_size, void* d_ws, size_t ws_size, hipStream_t stream) {
    static int grid = 0;
    if (grid == 0) {
        if (n_in != 19 || in_sizes[0] != L * D || out_size != L * D || ws_size < WS_END) { fprintf(stderr, "kernel_launch: unexpected problem (n_in %d, in0 %d, out %d, ws %zu); nothing launched\n", n_in, n_in > 0 ? in_sizes[0] : -1, out_size, ws_size); grid = -1; return; }
        int dev = 0, cus = 0, per_cu = 0;
        if (hipGetDevice(&dev) != hipSuccess || hipDeviceGetAttribute(&cus, hipDeviceAttributeMultiprocessorCount, dev) != hipSuccess) { grid = -1; return; }
        if (hipFuncSetAttribute((const void*)mk_fwd, hipFuncAttributeMaxDynamicSharedMemorySize, LDS_BYTES) != hipSuccess) { fprintf(stderr, "kernel_launch: hipFuncSetAttribute failed\n"); grid = -1; return; }
        if (hipOccupancyMaxActiveBlocksPerMultiprocessor(&per_cu, (const void*)mk_fwd, NT, LDS_BYTES) != hipSuccess || per_cu < 1) fprintf(stderr, "kernel_launch: occupancy query reports %d workgroups per CU\n", per_cu);
        (void)hipGetLastError();
        grid = cus;
    }
    if (grid < 0) return;
    (void)hipMemsetAsync((char*)d_ws + WS_CTL, 0, CTL_ZERO_BYTES, stream);
    Args a{};
    a.x = (const float*)d_in[0]; a.c = (const float*)d_in[1]; a.ctx = (const float*)d_in[2]; a.c_ctx = (const float*)d_in[3]; a.ada_w = (const float*)d_in[4]; a.ada_b = (const float*)d_in[5];
    a.norm_g = (const float*)d_in[6]; a.w_qkv = (const float*)d_in[7]; a.w_o = (const float*)d_in[8]; a.rpb = (const float*)d_in[9]; a.pool_w = (const float*)d_in[10]; a.pool_b = (const float*)d_in[11];
    a.pool_scale = (const float*)d_in[12]; a.w_router = (const float*)d_in[13]; a.b_router = (const float*)d_in[14]; a.w_up = (const float*)d_in[15]; a.b_up = (const float*)d_in[16];
    a.w_down = (const float*)d_in[17]; a.b_down = (const float*)d_in[18];
    a.out = (float*)d_out; a.ws = (unsigned char*)d_ws;
#if MK_ONE_LAUNCH
    a.ph_lo = 0; a.ph_hi = N_PHASES;
    hipLaunchKernelGGL(mk_fwd, dim3(grid), dim3(NT), LDS_BYTES, stream, a);
#else
    for (int p = 0; p < N_PHASES; ++p) { a.ph_lo = p; a.ph_hi = p + 1; hipLaunchKernelGGL(mk_fwd, dim3(grid), dim3(NT), LDS_BYTES, stream, a); }
#endif
}
```

```cpp
#include <hip/hip_runtime.h>
#include <cstdio>
#include <cstdint>

#ifndef Y_FP8
#define Y_FP8 1
#endif
#ifndef MK_ONE_LAUNCH
#define MK_ONE_LAUNCH 1
#ifndef PROBE_HOT
#define PROBE_HOT 0
#endif
#ifndef PROBE_NT5
#define PROBE_NT5 0
#endif
#ifndef NO_HX
#define NO_HX 1
#endif
#ifndef DRAIN_PRE
#define DRAIN_PRE 1
#endif
#ifndef PROBE_NOEPI
#define PROBE_NOEPI 0
#endif
#ifndef QKV_FP8
#define QKV_FP8 1
#endif
#endif

#define GAS __attribute__((address_space(1)))
#define LAS __attribute__((address_space(3)))
typedef unsigned short bf16_t;
typedef short bf16x8 __attribute__((ext_vector_type(8)));
typedef short s16x4 __attribute__((ext_vector_type(4)));
typedef float f32x4 __attribute__((ext_vector_type(4)));
typedef float f32x2 __attribute__((ext_vector_type(2)));
typedef unsigned u32x4 __attribute__((ext_vector_type(4)));
typedef unsigned u32x2 __attribute__((ext_vector_type(2)));
typedef int v8i __attribute__((ext_vector_type(8)));
typedef int v4i __attribute__((ext_vector_type(4)));

constexpr int L = 16384, D = 1024, CTX = 256, NH = 16, HD = 64, NE = 32, GW = 64;
constexpr int MQ = L + CTX;
constexpr float RMS_EPS = 1e-6f;
constexpr float LOG2E = 1.4426950408889634f;
constexpr float QSCALE = 0.125f * LOG2E;
constexpr int NWAVES = 8, NT = 512;

constexpr size_t MiB = 1u << 20;
constexpr size_t WS_CTL = 0, CTL_ZERO_BYTES = 128 * 1024;
constexpr size_t WS_MOD = 1 * MiB;
constexpr size_t WS_POS = 1 * MiB + 256 * 1024;
constexpr size_t WS_VEC = 1 * MiB + 512 * 1024;
constexpr size_t WS_WRT = 1 * MiB + 768 * 1024;
constexpr size_t WS_WQKV = 2 * MiB;
constexpr size_t WS_WO = 8 * MiB;
constexpr size_t WS_WPOOL = 10 * MiB;
constexpr size_t WS_LIST = 12 * MiB;
constexpr size_t WS_GATE = 14 * MiB;
constexpr size_t WS_HX = 16 * MiB;
constexpr size_t WS_Q = 50 * MiB, WS_K = 83 * MiB, WS_V = 116 * MiB;
constexpr size_t WS_O = 150 * MiB;
constexpr size_t WS_MX = 182 * MiB;
constexpr size_t WS_HX2 = 214 * MiB;
constexpr size_t WS_ACT = 256 * MiB;
constexpr size_t WS_Y = 408 * MiB;
constexpr size_t WS_WUP = 544 * MiB;
constexpr size_t WS_WDN = 816 * MiB;
constexpr size_t WS_XR = 952 * MiB;
constexpr size_t WS_END = 984 * MiB;
constexpr int CW_BAR = 4096;
constexpr int CW_CNT = 16384;
constexpr int CW_Q = 20480;
constexpr int CW_DONE = 24576;
constexpr int ACT_ROWS = 73728, LIST_CAP = 16384;

constexpr int RING_BYTES = 131072;
constexpr int MISC_OFF = RING_BYTES;
constexpr int M_PRE = MISC_OFF + 8192;
#ifndef Y_SORTED
#define Y_SORTED 1
#endif
#ifndef EPI_STAGE
#define EPI_STAGE 1
#endif
constexpr int STG0 = 3 * 16384;
constexpr int STG1 = 147456;
constexpr int LDS_BYTES = EPI_STAGE ? 163840 : 147456;

#define LDS_WAIT() asm volatile("s_waitcnt lgkmcnt(0)" ::: "memory")
#define VM_WAIT() asm volatile("s_waitcnt vmcnt(0)" ::: "memory")

typedef __bf16 bf16x2_t __attribute__((ext_vector_type(2)));
__device__ __forceinline__ unsigned cvt_pk_bf16(float lo, float hi) { const f32x2 v = {lo, hi}; return __builtin_bit_cast(unsigned, __builtin_convertvector(v, bf16x2_t)); }
__device__ __forceinline__ float clamp448(float v) { return __builtin_amdgcn_fmed3f(v, -448.0f, 448.0f); }
__device__ __forceinline__ unsigned cvt_pk4_fp8(float a, float b, float c, float d) { int w = __builtin_amdgcn_cvt_pk_fp8_f32(a, b, 0, false); w = __builtin_amdgcn_cvt_pk_fp8_f32(c, d, w, true); return (unsigned)w; }
__device__ __forceinline__ unsigned cvt_pk4_fp8_sat(float a, float b, float c, float d) { return cvt_pk4_fp8(clamp448(a), clamp448(b), clamp448(c), clamp448(d)); }
__device__ __forceinline__ float bf_lo(unsigned u) { return __uint_as_float(u << 16); }
__device__ __forceinline__ float bf_hi(unsigned u) { return __uint_as_float(u & 0xffff0000u); }
#ifndef WT_STORES
#define WT_STORES 0
#endif
__device__ __forceinline__ void st16(void* p, u32x4 v) {
#if WT_STORES
    asm volatile("global_store_dwordx4 %0, %1, off sc1\n\ts_nop 1" :: "v"(p), "v"(v) : "memory");
#else
    *(u32x4*)p = v;
#endif
}
#ifndef ROW_NT
#define ROW_NT 2
#endif
#ifndef ROW_LD_NT
#define ROW_LD_NT 0
#endif
#ifndef CONV_NT
#define CONV_NT 1
#endif
#ifndef STAGE_NT
#define STAGE_NT 1
#endif
#ifndef NT_DOWN
#define NT_DOWN 0
#endif
__device__ __forceinline__ void st16nt(void* p, u32x4 v) { __builtin_nontemporal_store(v, (u32x4*)p); }
__device__ __forceinline__ void st8(void* p, u32x2 v) {
#if 0
    asm volatile("global_store_dwordx2 %0, %1, off sc1\n\ts_nop 1" :: "v"(p), "v"(v) : "memory");
#else
    *(u32x2*)p = v;
#endif
}
__device__ __forceinline__ void st4(void* p, unsigned v) {
#if 0
    asm volatile("global_store_dword %0, %1, off sc1\n\ts_nop 1" :: "v"(p), "v"(v) : "memory");
#else
    *(unsigned*)p = v;
#endif
}
__device__ __forceinline__ float wave_sum(float v) {
    v += __builtin_bit_cast(float, __builtin_amdgcn_update_dpp(0, __builtin_bit_cast(int, v), 0xB1, 0xf, 0xf, true));
    v += __builtin_bit_cast(float, __builtin_amdgcn_update_dpp(0, __builtin_bit_cast(int, v), 0x4E, 0xf, 0xf, true));
    v += __builtin_bit_cast(float, __builtin_amdgcn_update_dpp(0, __builtin_bit_cast(int, v), 0x124, 0xf, 0xf, true));
    v += __builtin_bit_cast(float, __builtin_amdgcn_update_dpp(0, __builtin_bit_cast(int, v), 0x128, 0xf, 0xf, true));
    v += __builtin_bit_cast(float, __builtin_amdgcn_ds_swizzle(__builtin_bit_cast(int, v), 0x401F));
    return __builtin_bit_cast(float, __builtin_amdgcn_readlane(__builtin_bit_cast(int, v), 0)) + __builtin_bit_cast(float, __builtin_amdgcn_readlane(__builtin_bit_cast(int, v), 32));
}

#define XB_TMO      128
#define XB_XCNT(j)  (256  + 64 * (j))
#define XB_XSUB(j)  (1280 + 64 * (j))
#define XB_XGEN(j)  (2304 + 64 * (j))
#define XB_TOP      3328
#define XB_TOPGEN   3392
#define XCD_BAR_WORDS 3456
#define XB_SPIN_CAP (1u << 18)
__device__ __forceinline__ unsigned xb_ld(unsigned* p)              { return __hip_atomic_load(p, __ATOMIC_RELAXED, __HIP_MEMORY_SCOPE_AGENT); }
__device__ __forceinline__ unsigned xb_add(unsigned* p, unsigned v) { return __hip_atomic_fetch_add(p, v, __ATOMIC_RELAXED, __HIP_MEMORY_SCOPE_AGENT); }
__device__ __forceinline__ unsigned xb_xcc_id() { return (unsigned)__builtin_amdgcn_s_getreg((3 << 11) | 20) & 0xFu; }
#define XB_SPIN(cond, bar) do { unsigned _sp = 0; while (cond) { __builtin_amdgcn_s_sleep(1); \
    if ((++_sp & 255u) == 0u) { if (xb_ld(&(bar)[XB_TMO])) break; if (_sp > XB_SPIN_CAP) { atomicAdd(&(bar)[XB_TMO], 1u); break; } } } } while (0)
struct XcdBarrier { unsigned* bar; unsigned x; volatile LAS unsigned* st; };
__device__ __forceinline__ XcdBarrier xcd_barrier_post(unsigned* bar, volatile LAS unsigned* st, bool leader) {
    XcdBarrier b; b.bar = bar; b.x = xb_xcc_id(); b.st = st;
    if (leader) (void)xb_add(&bar[XB_XCNT(b.x)], 1u);
    return b;
}
__device__ __forceinline__ void xcd_barrier_complete(unsigned* bar, unsigned x, unsigned& nloc, unsigned& nx) {
    const unsigned G = gridDim.x * gridDim.y * gridDim.z;
    unsigned sum, cnt, mine, sp = 0u;
    for (;;) {
        sum = 0u; cnt = 0u; mine = 0u;
#pragma unroll
        for (unsigned j = 0; j < 16; ++j) { const unsigned c = xb_ld(&bar[XB_XCNT(j)]); sum += c; cnt += (c > 0u) ? 1u : 0u; mine = (j == x) ? c : mine; }
        if (sum == G) break;
        __builtin_amdgcn_s_sleep(1);
        if ((++sp & 255u) == 0u) { if (xb_ld(&bar[XB_TMO])) break; if (sp > XB_SPIN_CAP) { atomicAdd(&bar[XB_TMO], 1u); break; } }
    }
    nloc = mine > 0u ? mine : 1u; nx = cnt > 0u ? cnt : 1u;
}
__device__ __forceinline__ void xcd_barrier(const XcdBarrier& b, bool leader) {
    asm volatile("s_waitcnt vmcnt(0)" ::: "memory");
    __syncthreads();
    if (leader) {
        unsigned* bar = b.bar;
        __builtin_amdgcn_s_waitcnt(0);
        unsigned nloc = b.st[0], nx = b.st[1];
        if (nloc == 0u) { xcd_barrier_complete(bar, b.x, nloc, nx); b.st[0] = nloc; b.st[1] = nx; }
        const unsigned old = xb_add(&bar[XB_XSUB(b.x)], 1u);
        const unsigned gen = old / nloc;
        if (old + 1u == (gen + 1u) * nloc) {
            __builtin_amdgcn_fence(__ATOMIC_RELEASE, "agent");
            asm volatile("s_waitcnt vmcnt(0)" ::: "memory");
            const unsigned og = xb_add(&bar[XB_TOP], 1u);
            const unsigned tg = og / nx;
            if (og + 1u == (tg + 1u) * nx) xb_add(&bar[XB_TOPGEN], 1u);
            else XB_SPIN(xb_ld(&bar[XB_TOPGEN]) == tg, bar);
            __builtin_amdgcn_fence(__ATOMIC_ACQUIRE, "agent");
            xb_add(&bar[XB_XGEN(b.x)], 1u);
            asm volatile("s_waitcnt vmcnt(0)" ::: "memory");
        } else {
            XB_SPIN(xb_ld(&bar[XB_XGEN(b.x)]) == gen, bar);
            __builtin_amdgcn_fence(__ATOMIC_ACQUIRE, "agent");
            asm volatile("s_waitcnt vmcnt(0)" ::: "memory");
        }
    }
    __syncthreads();
}

#ifndef HALF_SKIP
#define HALF_SKIP 1
#endif
#ifndef LAZY_CLAMP
#define LAZY_CLAMP 1
#endif
#ifndef K_ROT
#define K_ROT 0
#endif
namespace gm {
constexpr int BM = 256, BK = 64, HALF = 128, HTB = HALF * BK * 2, STAGE_BYTES = 8 * HTB, NXCD = 8, WGM = 8;
__device__ __forceinline__ int lds_byte(int r, int c) { const int st = (r >> 4) * 2 + (c >> 5), rr = r & 15, cc = c & 31, ob = rr * 64 + cc * 2; return st * 1024 + (ob ^ (((ob >> 9) & 1) << 5)); }
__device__ __forceinline__ void stage_rc(int b, int& R, int& C) { const int st = b / 1024, sb = b % 1024, swz = sb ^ (((sb >> 9) & 1) << 5); R = (st >> 1) * 16 + swz / 64; C = (st & 1) * 32 + (swz % 64) / 2; }
__device__ __forceinline__ int perm32(int rho) { const int n = rho >> 4, i = rho & 15; return 8 * (i >> 2) + 4 * n + (i & 3); }

struct Unit { int pm, pn, e, aux, rot, nv; const char* Ab; const char* Bb; };

__device__ __forceinline__ bool static_order(int i, int G, int c, int nM, int nN, int& pm, int& pn) {
    const int nwg = nM * nN; const int Lx = i * G + c; if (Lx >= nwg) return false;
    int wgid = Lx; { const int q = nwg / NXCD, r = nwg % NXCD, xcd = wgid % NXCD, off = wgid / NXCD; wgid = (xcd < r ? xcd * (q + 1) : r * (q + 1) + (xcd - r) * q) + off; }
    const int nig = WGM * nN, gid = wgid / nig, fm = gid * WGM, gsz = (nM - fm) < WGM ? (nM - fm) : WGM;
    pm = fm + ((wgid % nig) % gsz); pn = (wgid % nig) / gsz; return true;
}

template <class Prob, class Epi>
__device__ __forceinline__ void gemm_phase(LAS unsigned char* lds, const int tid, const Prob& P, const Epi& E) {
    const int wid = __builtin_amdgcn_readfirstlane(tid >> 6), lane = tid & 63, wr = wid >> 2, wc = wid & 3, fr = lane & 15, fq = lane >> 4;
    const int nt = Prob::FP8 ? P.K / 128 : P.K / BK;
    int Rl[2], Cl[2]; unsigned offB[2];
#pragma unroll
    for (int i = 0; i < 2; ++i) { int R, C; stage_rc(tid * 16 + i * 8192, R, C); const int Rb = (R & ~31) + perm32(R & 31); Rl[i] = R; Cl[i] = C; offB[i] = (unsigned)Rb * P.ldb + (unsigned)C * 2u; }
    const size_t hB = (size_t)HALF * P.ldb;
    const unsigned ldsw = (unsigned)wid * 1024u;
    const int aoff = lds_byte(wr * 64 + fr, fq * 8), boff = lds_byte(wc * 32 + fr, fq * 8);
#define GM_SA(b, h) (((b) * 2 + (h)) * HTB)
#define GM_SB(b, h) ((4 + (b) * 2 + (h)) * HTB)
#define GM_STAGE(bufoff, gbase, voff, kb) do { _Pragma("unroll") for (int _i = 0; _i < 2; ++_i)   \
        __builtin_amdgcn_global_load_lds((const unsigned*)((const char*)(gbase) + ((voff)[_i] + (unsigned)(kb))), (LAS unsigned*)(lds + (bufoff) + ldsw + _i * 8192), 16, 0, 0); } while (0)
#define GM_LD8(addr) __builtin_shufflevector(*(const LAS v4i*)(addr), *(const LAS v4i*)((addr) + 1024), 0, 1, 2, 3, 4, 5, 6, 7)
#define GM_LDA(dst, b, h) do { _Pragma("unroll") for (int m = 0; m < 4; ++m) dst[m] = GM_LD8(lds + GM_SA(b, h) + aoff + m * 2048); } while (0)
#define GM_LDB(dst, b, h) do { _Pragma("unroll") for (int n = 0; n < 2; ++n) dst[n] = GM_LD8(lds + GM_SB(b, h) + boff + n * 2048); } while (0)
#define GM_LO(x) __builtin_bit_cast(bf16x8, __builtin_shufflevector(x, x, 0, 1, 2, 3))
#define GM_HI(x) __builtin_bit_cast(bf16x8, __builtin_shufflevector(x, x, 4, 5, 6, 7))
#define GM_MMA(ai, bj, At, Bt) do { __builtin_amdgcn_s_setprio(1); _Pragma("unroll") for (int m = 0; m < 4; ++m) _Pragma("unroll") for (int n = 0; n < 2; ++n) { \
        if (Prob::FP8)   \
            acc[ai][bj][m][n] = __builtin_amdgcn_mfma_scale_f32_16x16x128_f8f6f4(Bt[n], At[m], acc[ai][bj][m][n], 0, 0, 0, 0, 0, 0); \
        else { acc[ai][bj][m][n] = __builtin_amdgcn_mfma_f32_16x16x32_bf16(GM_LO(Bt[n]), GM_LO(At[m]), acc[ai][bj][m][n], 0, 0, 0); \
               acc[ai][bj][m][n] = __builtin_amdgcn_mfma_f32_16x16x32_bf16(GM_HI(Bt[n]), GM_HI(At[m]), acc[ai][bj][m][n], 0, 0, 0); } } \
        __builtin_amdgcn_s_setprio(0); } while (0)
#define GM_WAIT_V(n) asm volatile("s_waitcnt vmcnt(" #n ")" ::: "memory")
#define GM_WAIT_L(n) asm volatile("s_waitcnt lgkmcnt(" #n ")" ::: "memory")
#define GM_BAR __builtin_amdgcn_s_barrier()
#define GM_SCHED __builtin_amdgcn_sched_barrier(0)
    Unit cur, nxt; int ui = 0;
    if (!P.next(0, cur)) return;
    unsigned offC[2][2];
    P.a_off(cur, Rl, Cl, offC);
    f32x4 acc[2][2][4][2];
#pragma unroll
    for (int a = 0; a < 2; ++a)
#pragma unroll
        for (int b = 0; b < 2; ++b)
#pragma unroll
            for (int m = 0; m < 4; ++m)
#pragma unroll
                for (int n = 0; n < 2; ++n) acc[a][b][m][n] = (f32x4){0.f, 0.f, 0.f, 0.f};
    v8i At[4], B0[2], B1[2];
    typename Epi::Pre pre;
    const char* cA = cur.Ab; const char* cB = cur.Bb;
    const int ntm = nt - 1;
#define GM_KB(t_, r_) ((((t_) + (r_)) & ntm) << 7)
    { const int p0 = GM_KB(0, cur.rot), p1 = GM_KB(1, cur.rot);
    GM_STAGE(GM_SB(0, 0), cB, offB, p0); GM_STAGE(GM_SB(0, 1), cB + hB, offB, p0); GM_STAGE(GM_SA(0, 0), cA, offC[0], p0); GM_STAGE(GM_SA(0, 1), cA, offC[1], p0);
    if (wr == 1) GM_BAR;
    GM_WAIT_V(2); GM_BAR;
    GM_STAGE(GM_SB(1, 0), cB, offB, p1); GM_STAGE(GM_SA(1, 0), cA, offC[0], p1); GM_STAGE(GM_SB(1, 1), cB + hB, offB, p1); }
    GM_WAIT_V(6); GM_BAR;
    for (;;) {
        const bool has_next = P.next(ui + 1, nxt);
        unsigned offN[2][2] = {{0u, 0u}, {0u, 0u}};
        if (Prob::GATHER) { if (has_next) P.a_raw(nxt, Rl, offN); }
        const char* nA = has_next ? nxt.Ab : cA; const char* nB = has_next ? nxt.Bb : cB; const int rc = cur.rot, rn = has_next ? nxt.rot : rc;
        const int nvw = (Prob::FP8 && HALF_SKIP) ? cur.nv - 64 * wr : BM; const bool do0 = nvw > 0, do1 = nvw > HALF;
        for (int t = 0; t < nt; t += 2) {
            const bool last = (t == nt - 2);
            if (Epi::HAS_PRE) { if (last) { unsigned l_; asm volatile("v_mbcnt_lo_u32_b32 %0, -1, 0\n\tv_mbcnt_hi_u32_b32 %0, -1, %0" : "=v"(l_)); E.pre_load(pre, cur, wr, wc, (int)(l_ & 15u), (int)(l_ >> 4)); } }
            const char* ab = last ? nA : cA; const char* bb = last ? nB : cB;
            const int k1 = GM_KB(t + 1, rc), k2 = last ? GM_KB(0, rn) : GM_KB(t + 2, rc), k3 = last ? GM_KB(1, rn) : GM_KB(t + 3, rc);
            if (do0) { GM_LDB(B0, 0, 0); GM_LDB(B1, 0, 1); } GM_SCHED; if (do0) GM_LDA(At, 0, 0); GM_STAGE(GM_SA(1, 1), cA, offC[1], k1);
            if (Prob::GATHER) { if (last && has_next) {
#pragma unroll
                for (int h = 0; h < 2; ++h)
#pragma unroll
                    for (int i = 0; i < 2; ++i) offC[h][i] = (offN[h][i] >> 2) * P.lda + (unsigned)Cl[i] * 2u; } }
            GM_WAIT_V(8); GM_WAIT_L(0); GM_BAR; if (do0) { GM_MMA(0, 0, At, B0); GM_MMA(0, 1, At, B1); } GM_BAR; GM_SCHED;
            if (do1) GM_LDA(At, 0, 1); GM_STAGE(GM_SB(0, 0), bb, offB, k2); GM_STAGE(GM_SB(0, 1), bb + hB, offB, k2); GM_STAGE(GM_SA(0, 0), ab, offC[0], k2);
            GM_WAIT_V(8); GM_WAIT_L(0); GM_BAR; if (do1) { GM_MMA(1, 0, At, B0); GM_MMA(1, 1, At, B1); } GM_BAR; GM_SCHED;
            if (do0) { GM_LDB(B0, 1, 0); GM_LDB(B1, 1, 1); } GM_SCHED; if (do0) GM_LDA(At, 1, 0); GM_STAGE(GM_SA(0, 1), ab, offC[1], k2);
            GM_WAIT_V(8); GM_WAIT_L(0); GM_BAR; if (do0) { GM_MMA(0, 0, At, B0); GM_MMA(0, 1, At, B1); } GM_BAR; GM_SCHED;
            if (do1) GM_LDA(At, 1, 1); GM_STAGE(GM_SB(1, 0), bb, offB, k3); GM_STAGE(GM_SB(1, 1), bb + hB, offB, k3); GM_STAGE(GM_SA(1, 0), ab, offC[0], k3);
            GM_WAIT_V(8); GM_WAIT_L(0); GM_BAR; if (do1) { GM_MMA(1, 0, At, B0); GM_MMA(1, 1, At, B1); } GM_BAR; GM_SCHED;
        }
        if (wr == 0) GM_BAR;
        { unsigned l_; asm volatile("v_mbcnt_lo_u32_b32 %0, -1, 0\n\tv_mbcnt_hi_u32_b32 %0, -1, %0" : "=v"(l_));
          E(acc, cur, wr, wc, (int)(l_ & 15u), (int)(l_ >> 4), pre); }
        if (!has_next) break;
#pragma unroll
        for (int a = 0; a < 2; ++a)
#pragma unroll
            for (int b = 0; b < 2; ++b)
#pragma unroll
                for (int m = 0; m < 4; ++m)
#pragma unroll
                    for (int n = 0; n < 2; ++n) acc[a][b][m][n] = (f32x4){0.f, 0.f, 0.f, 0.f};
        cur = nxt; cA = nA; cB = nB; ++ui;
        if (wr == 1) GM_BAR;
    }
    GM_WAIT_V(0);
    GM_BAR;
#undef GM_SA
#undef GM_KB
#undef GM_SB
#undef GM_STAGE
#undef GM_LDA
#undef GM_LDB
#undef GM_LD8
#undef GM_LO
#undef GM_HI
#undef GM_MMA
#undef GM_WAIT_V
#undef GM_WAIT_L
#undef GM_BAR
#undef GM_SCHED
}

template <bool FP8_> struct DenseProbT {
    static constexpr bool GATHER = false, FP8 = FP8_;
    __device__ __forceinline__ void a_raw(const Unit&, const int (&)[2], unsigned (&)[2][2]) const {}
    const char* A; const char* B; unsigned lda, ldb; int K, nM, nN, G, c;
    int a_col_per_pn;
    size_t b_per_pn;
    __device__ __forceinline__ bool next(int i, Unit& u) const {
        int pm, pn; if (!static_order(i, G, c, nM, nN, pm, pn)) return false;
        u.pm = pm; u.pn = pn; u.e = 0; u.aux = 0; u.nv = BM; u.rot = K_ROT ? pm + 2 * pn : 0; u.Ab = A + (size_t)pm * BM * lda + (size_t)pn * a_col_per_pn; u.Bb = B + (size_t)pn * b_per_pn; return true;
    }
    __device__ __forceinline__ void a_off(const Unit&, const int (&Rl)[2], const int (&Cl)[2], unsigned (&off)[2][2]) const {
#pragma unroll
        for (int h = 0; h < 2; ++h)
#pragma unroll
            for (int i = 0; i < 2; ++i) off[h][i] = (unsigned)(h * HALF + Rl[i]) * lda + (unsigned)Cl[i] * 2u;
    }
};
using DenseProb = DenseProbT<false>;
struct OneProb {
    static constexpr bool GATHER = false, FP8 = false;
    __device__ __forceinline__ void a_raw(const Unit&, const int (&)[2], unsigned (&)[2][2]) const {}
    const char* A; const char* B; unsigned lda, ldb; int K, pm, pn; size_t b_per_pn;
    __device__ __forceinline__ bool next(int i, Unit& u) const { if (i != 0) return false; u.pm = pm; u.pn = pn; u.e = 0; u.aux = 0; u.rot = 0; u.nv = BM; u.Ab = A + (size_t)pm * BM * lda; u.Bb = B + (size_t)pn * b_per_pn; return true; }
    __device__ __forceinline__ void a_off(const Unit&, const int (&Rl)[2], const int (&Cl)[2], unsigned (&off)[2][2]) const {
#pragma unroll
        for (int h = 0; h < 2; ++h)
#pragma unroll
            for (int i = 0; i < 2; ++i) off[h][i] = (unsigned)(h * HALF + Rl[i]) * lda + (unsigned)Cl[i] * 2u;
    }
};
struct MoeTab { LAS int* tstart; LAS int* cnt; LAS unsigned char* tile_e; int T; };
template <bool GATHER_> struct MoeProb {
    static constexpr bool GATHER = GATHER_, gather = GATHER_, FP8 = true;
    const char* A; const char* B; unsigned lda, ldb; int K, nN, G, c; MoeTab tb; const int* list; size_t b_per_e, b_per_pn;
#if PROBE_HOT == 2
    bool same = false;
#endif
    __device__ __forceinline__ bool next(int i, Unit& u) const {
        int pm, pn; if (!static_order(i, G, c, tb.T, nN, pm, pn)) return false;
        const int e = __builtin_amdgcn_readfirstlane((int)tb.tile_e[pm]);
        u.pm = pm; u.pn = pn; u.e = e; u.rot = K_ROT ? pm + 2 * pn : 0; u.aux = (pm - __builtin_amdgcn_readfirstlane(tb.tstart[e])) * BM;
        u.nv = HALF_SKIP ? min(__builtin_amdgcn_readfirstlane(tb.cnt[e]) - u.aux, BM) : BM;
        u.Ab = gather ? A : A + (size_t)pm * BM * lda; u.Bb = B + (size_t)e * b_per_e + (size_t)pn * b_per_pn;
#if PROBE_HOT == 2
        if (same) { u.Ab = A; u.Bb = B; }
#endif
        return true;
    }
    __device__ __forceinline__ void a_raw(const Unit& u, const int (&Rl)[2], unsigned (&raw)[2][2]) const {
        const int n = __builtin_amdgcn_readfirstlane(tb.cnt[u.e]);
#pragma unroll
        for (int h = 0; h < 2; ++h)
#pragma unroll
            for (int i = 0; i < 2; ++i) { const int p = u.aux + h * HALF + Rl[i]; raw[h][i] = (p < n) ? (unsigned)list[u.e * LIST_CAP + p] : 0u; }
    }
    __device__ __forceinline__ void a_off(const Unit& u, const int (&Rl)[2], const int (&Cl)[2], unsigned (&off)[2][2]) const {
        if (gather) {
            const int n = __builtin_amdgcn_readfirstlane(tb.cnt[u.e]);
#pragma unroll
            for (int h = 0; h < 2; ++h)
#pragma unroll
                for (int i = 0; i < 2; ++i) { const int p = u.aux + h * HALF + Rl[i]; int tok = 0; if (p < n) tok = list[u.e * LIST_CAP + p] >> 2; off[h][i] = (unsigned)tok * lda + (unsigned)Cl[i] * 2u; }
        } else {
#pragma unroll
            for (int h = 0; h < 2; ++h)
#pragma unroll
                for (int i = 0; i < 2; ++i) off[h][i] = (unsigned)(h * HALF + Rl[i]) * lda + (unsigned)Cl[i] * 2u;
        }
    }
};

struct EpiBf16 {
    struct Pre {}; static constexpr bool HAS_PRE = false; __device__ __forceinline__ void pre_load(Pre&, const Unit&, int, int, int, int) const {}
    bf16_t* O; int ldc; const float* bias; const float* cscale; int split_cols; size_t split_stride; float scale0; int col_per_pn; float mul;
    __device__ __forceinline__ void operator()(const f32x4 (&acc)[2][2][4][2], const Unit& u, int wr, int wc, int fr, int fq, const Pre&) const {
        const int row0 = u.pm * BM + wr * 64 + fr; int colt = u.pn * col_per_pn; bf16_t* base = O;
        float sc = mul; if (split_cols) { const int t = colt / split_cols; base += (size_t)t * split_stride; colt -= t * split_cols; if (t == 0) sc = scale0 * mul; }
        const int col0 = colt + wc * 32 + 8 * fq, bcol0 = u.pn * col_per_pn + wc * 32 + 8 * fq;
        f32x4 bv[2][2], sv[2][2];
#pragma unroll
        for (int bj = 0; bj < 2; ++bj)
#pragma unroll
            for (int n = 0; n < 2; ++n) { bv[bj][n] = bias ? *(const f32x4*)(bias + bcol0 + bj * HALF + 4 * n) : (f32x4){0.f, 0.f, 0.f, 0.f};
                                          sv[bj][n] = cscale ? *(const f32x4*)(cscale + bcol0 + bj * HALF + 4 * n) : (f32x4){1.f, 1.f, 1.f, 1.f}; }
#pragma unroll
        for (int ai = 0; ai < 2; ++ai)
#pragma unroll
            for (int m = 0; m < 4; ++m) { bf16_t* rowp = base + (size_t)(row0 + ai * HALF + m * 16) * ldc + col0;
#pragma unroll
                for (int bj = 0; bj < 2; ++bj) { f32x4 v0 = (acc[ai][bj][m][0] + bv[bj][0]) * sv[bj][0] * sc, v1 = (acc[ai][bj][m][1] + bv[bj][1]) * sv[bj][1] * sc;
                    u32x4 w; w.x = cvt_pk_bf16(v0[0], v0[1]); w.y = cvt_pk_bf16(v0[2], v0[3]); w.z = cvt_pk_bf16(v1[0], v1[1]); w.w = cvt_pk_bf16(v1[2], v1[3]);
                    st16(rowp + bj * HALF, w); } }
    }
};
struct EpiSwiglu {
    struct Pre { f32x4 bgl[2], bln[2]; }; static constexpr bool HAS_PRE = true;
    unsigned char* act; const float* bup;
#if PROBE_NOEPI
    bool skip = false;
#endif
    __device__ __forceinline__ void pre_load(Pre& p, const Unit& u, int, int wc, int, int fq) const {
        const float* bg = bup + (size_t)u.e * 2048 + u.pn * HALF + wc * 32 + 8 * fq;
#pragma unroll
        for (int n = 0; n < 2; ++n) { p.bgl[n] = *(const f32x4*)(bg + 4 * n); p.bln[n] = *(const f32x4*)(bg + 1024 + 4 * n); }
    }
    template <bool CLAMP>
    __device__ __forceinline__ float run(const f32x4 (&acc)[2][2][4][2], const Unit& u, int wr, int wc, int fr, int fq, const Pre& pr) const {
        const int row0 = u.pm * BM + wr * 64 + fr, col0 = u.pn * HALF + wc * 32 + 8 * fq;
        const f32x4 (&bgl)[2] = pr.bgl; const f32x4 (&bln)[2] = pr.bln;
        float mx = 0.f;
#pragma unroll
        for (int ai = 0; ai < 2; ++ai) { if (HALF_SKIP && ai * HALF + wr * 64 >= u.nv) break;
#pragma unroll
            for (int m = 0; m < 4; ++m) {
                float o[8];
#pragma unroll
                for (int n = 0; n < 2; ++n)
#pragma unroll
                    for (int jp = 0; jp < 2; ++jp) {
                        const f32x2 a0 = {acc[ai][0][m][n][2 * jp], acc[ai][0][m][n][2 * jp + 1]}, a1 = {acc[ai][1][m][n][2 * jp], acc[ai][1][m][n][2 * jp + 1]};
                        const f32x2 bg2 = {bgl[n][2 * jp], bgl[n][2 * jp + 1]}, bl2 = {bln[n][2 * jp], bln[n][2 * jp + 1]};
                        f32x2 g = a0 * 0.015625f + bg2, l = a1 * 0.015625f + bl2;
                        if (CLAMP) { g.x = fminf(g.x, 7.0f); g.y = fminf(g.y, 7.0f); l.x = __builtin_amdgcn_fmed3f(l.x, -7.0f, 7.0f); l.y = __builtin_amdgcn_fmed3f(l.y, -7.0f, 7.0f); }
                        else { mx = fmaxf(fmaxf(mx, g.x), g.y); mx = fmaxf(fmaxf(mx, fabsf(l.x)), fabsf(l.y)); }
                        const f32x2 t = g * (-1.702f * LOG2E);
                        f32x2 e; e.x = __builtin_amdgcn_exp2f(t.x); e.y = __builtin_amdgcn_exp2f(t.y);
                        const f32x2 d = e + 1.0f;
                        f32x2 r; r.x = __builtin_amdgcn_rcpf(d.x); r.y = __builtin_amdgcn_rcpf(d.y);
                        const f32x2 gr = g * r, oo = gr * l + gr;
                        o[n * 4 + 2 * jp] = oo.x; o[n * 4 + 2 * jp + 1] = oo.y;
                    }
                u32x2 w; w.x = cvt_pk4_fp8(o[0], o[1], o[2], o[3]); w.y = cvt_pk4_fp8(o[4], o[5], o[6], o[7]);
                st8(act + (size_t)(row0 + ai * HALF + m * 16) * D + col0, w);
            } }
        return mx;
    }
    __device__ __forceinline__ void operator()(const f32x4 (&acc)[2][2][4][2], const Unit& u, int wr, int wc, int fr, int fq, const Pre& pr) const {
#if PROBE_NOEPI == 1
        if (skip) return;
#endif
#if LAZY_CLAMP
        const float mx = run<false>(acc, u, wr, wc, fr, fq, pr);
        if (__builtin_amdgcn_ballot_w64(!(mx <= 7.0f)) != 0ull) { asm volatile("" ::: "memory"); (void)run<true>(acc, u, wr, wc, fr, fq, pr); }
#else
        (void)run<true>(acc, u, wr, wc, fr, fq, pr);
#endif
    }
};
struct EpiDown {
    struct Pre {}; static constexpr bool HAS_PRE = true;
    unsigned char* Y; const float* bdn; const float* gate; const int* list; MoeTab tb; LAS unsigned char* lds;
#if PROBE_NOEPI
    bool skip = false;
#endif
    __device__ __forceinline__ void pre_load(Pre&, const Unit& u, int wr, int wc, int fr, int fq) const {
        const int w = wr * 4 + wc, lane = fq * 16 + fr;
        const unsigned* src = (w < 4 ? (const unsigned*)list : (const unsigned*)gate) + (u.e * LIST_CAP + u.aux + (w & 3) * 64 + lane);
        __builtin_amdgcn_global_load_lds(src, (LAS unsigned*)(lds + M_PRE + w * 256), 4, 0, 0);
        if (w < 4) __builtin_amdgcn_global_load_lds((const unsigned*)(bdn + (size_t)u.e * D + u.pn * BM + w * 64 + lane), (LAS unsigned*)(lds + M_PRE + 2048 + w * 256), 4, 0, 0);
    }
    __device__ __forceinline__ void operator()(const f32x4 (&acc)[2][2][4][2], const Unit& u, int wr, int wc, int fr, int fq, const Pre&) const {
#if PROBE_NOEPI == 1
        if (skip) return;
#endif
        const int n = __builtin_amdgcn_readfirstlane(tb.cnt[u.e]);
        const int col0 = u.pn * BM + wc * 32 + 8 * fq;
        const LAS int* ps = (const LAS int*)(lds + M_PRE); const LAS float* pg = (const LAS float*)(lds + M_PRE + 1024); const LAS float* pb = (const LAS float*)(lds + M_PRE + 2048) + wc * 32 + 8 * fq;
        f32x4 bv[2][2];
#pragma unroll
        for (int bj = 0; bj < 2; ++bj)
#pragma unroll
            for (int nn = 0; nn < 2; ++nn) bv[bj][nn] = *(const LAS f32x4*)(pb + bj * HALF + 4 * nn);
#if Y_FP8 && EPI_STAGE
        { const int lane = fq * 16 + fr, w = wr * 4 + wc;
        unsigned char* ybase = Y + u.pn * BM + (lane & 15) * 16;
#pragma unroll
        for (int p = 0; p < 4; ++p) { if (HALF_SKIP && (p >> 1) * HALF >= u.nv) break;
            const int ai = p >> 1, mh = p & 1;
            LAS unsigned char* stg = lds + ((p & 1) ? STG1 : STG0);
            if (!(HALF_SKIP && ai * HALF + wr * 64 >= u.nv))
#pragma unroll
            for (int mm = 0; mm < 2; ++mm) { const int m = 2 * mh + mm, lr = wr * 32 + mm * 16 + fr;
                const float g16 = pg[ai * HALF + wr * 64 + m * 16 + fr] * 4.0f;
#pragma unroll
                for (int bj = 0; bj < 2; ++bj) { const f32x4 v0 = (acc[ai][bj][m][0] * 0.015625f + bv[bj][0]) * g16, v1 = (acc[ai][bj][m][1] * 0.015625f + bv[bj][1]) * g16;
                    u32x2 wv; wv.x = cvt_pk4_fp8(v0[0], v0[1], v0[2], v0[3]); wv.y = cvt_pk4_fp8(v1[0], v1[1], v1[2], v1[3]);
                    const int chunk = bj * 8 + wc * 2 + (fq >> 1);
                    *(LAS u32x2*)(stg + lr * 256 + ((chunk ^ (lr & 15)) << 4) + (fq & 1) * 8) = wv; } }
            LDS_WAIT(); __builtin_amdgcn_s_barrier();
#pragma unroll
            for (int k = 0; k < 2; ++k) { const int lr = k * 32 + w * 4 + (lane >> 4), j = lane & 15;
                const u32x4 v = *(const LAS u32x4*)(stg + lr * 256 + ((j ^ (lr & 15)) << 4));
                const int q = ai * HALF + (lr >> 5) * 64 + (2 * mh + ((lr >> 4) & 1)) * 16 + (lr & 15);
#if Y_SORTED
#if PROBE_NOEPI == 3
                const int sl = (!skip && u.aux + q < n) ? u.pm * BM + q : -1;
                if (skip) asm volatile("" :: "v"(v.x), "v"(v.y), "v"(v.z), "v"(v.w));
#else
                const int sl = (u.aux + q < n) ? u.pm * BM + q : -1;
#endif
#else
                const int sl = (u.aux + q < n) ? ps[q] : -1;
#endif
#if Y_SORTED
                if (sl >= 0) { unsigned char* dst = Y + ((size_t)(u.pm * 4 + u.pn) << 16) + q * 256 + (lane & 15) * 16;
                    if (STAGE_NT) st16nt(dst, v); else st16(dst, v); } }
#else
                if (sl >= 0) { if (STAGE_NT) st16nt(ybase + (size_t)sl * D, v); else st16(ybase + (size_t)sl * D, v); } }
#endif
        } }
#elif Y_FP8
#pragma unroll
        for (int ai = 0; ai < 2; ++ai) {
            float g16[4];
#pragma unroll
            for (int m = 0; m < 4; ++m) g16[m] = pg[ai * HALF + wr * 64 + m * 16 + fr] * 4.0f;
            const int q = ai * HALF + wr * 64 + fq * 16 + fr;
#if PROBE_NOEPI == 2
            const int sl = skip ? u.pm * BM + q : ((u.aux + q < n) ? ps[q] : -1);
#elif PROBE_NOEPI == 3
            const int sl = skip ? -1 : ((u.aux + q < n) ? ps[q] : -1);
#elif PROBE_NOEPI == 4
            const int sl = skip ? 65536 + (blockIdx.x * 8 + (q & 7)) : ((u.aux + q < n) ? ps[q] : -1);
#else
            const int sl = (u.aux + q < n) ? ps[q] : -1;
#endif
            unsigned W[2][4][2];
#pragma unroll
            for (int bj = 0; bj < 2; ++bj)
#pragma unroll
                for (int m = 0; m < 4; ++m) { const f32x4 v0 = (acc[ai][bj][m][0] * 0.015625f + bv[bj][0]) * g16[m], v1 = (acc[ai][bj][m][1] * 0.015625f + bv[bj][1]) * g16[m];
                    W[bj][m][0] = cvt_pk4_fp8(v0[0], v0[1], v0[2], v0[3]); W[bj][m][1] = cvt_pk4_fp8(v1[0], v1[1], v1[2], v1[3]); }
#pragma unroll
            for (int bj = 0; bj < 2; ++bj)
#pragma unroll
                for (int d = 0; d < 2; ++d) {
                    u32x2 r;
                    r = __builtin_amdgcn_permlane32_swap(W[bj][0][d], W[bj][2][d], false, false); W[bj][0][d] = r[0]; W[bj][2][d] = r[1];
                    r = __builtin_amdgcn_permlane32_swap(W[bj][1][d], W[bj][3][d], false, false); W[bj][1][d] = r[0]; W[bj][3][d] = r[1];
                    r = __builtin_amdgcn_permlane16_swap(W[bj][0][d], W[bj][1][d], false, false); W[bj][0][d] = r[0]; W[bj][1][d] = r[1];
                    r = __builtin_amdgcn_permlane16_swap(W[bj][2][d], W[bj][3][d], false, false); W[bj][2][d] = r[0]; W[bj][3][d] = r[1];
                }
#if PROBE_NOEPI == 5
            if (skip) {
                unsigned char* rp = Y + (size_t)(u.pm * 4 + u.pn) * 65536 + (wr * 4 + wc) * 8192 + ai * 4096 + (fq * 16 + fr) * 16;
#pragma unroll
                for (int bj = 0; bj < 2; ++bj) {
#if PROBE_NT5
                    st16nt(rp + bj * 2048, (u32x4){W[bj][0][0], W[bj][0][1], W[bj][1][0], W[bj][1][1]}); st16nt(rp + bj * 2048 + 1024, (u32x4){W[bj][2][0], W[bj][2][1], W[bj][3][0], W[bj][3][1]});
#else
                    st16(rp + bj * 2048, (u32x4){W[bj][0][0], W[bj][0][1], W[bj][1][0], W[bj][1][1]}); st16(rp + bj * 2048 + 1024, (u32x4){W[bj][2][0], W[bj][2][1], W[bj][3][0], W[bj][3][1]});
#endif
                }
            } else
#endif
            if (sl >= 0) {
                unsigned char* rowp = Y + (size_t)sl * D + u.pn * BM + wc * 32;
#pragma unroll
                for (int bj = 0; bj < 2; ++bj) {
                    if (NT_DOWN) { st16nt(rowp + bj * HALF, (u32x4){W[bj][0][0], W[bj][0][1], W[bj][1][0], W[bj][1][1]}); st16nt(rowp + bj * HALF + 16, (u32x4){W[bj][2][0], W[bj][2][1], W[bj][3][0], W[bj][3][1]}); }
                    else { st16(rowp + bj * HALF, (u32x4){W[bj][0][0], W[bj][0][1], W[bj][1][0], W[bj][1][1]}); st16(rowp + bj * HALF + 16, (u32x4){W[bj][2][0], W[bj][2][1], W[bj][3][0], W[bj][3][1]}); } }
            }
            asm volatile("" ::: "memory");
        }
#else
#pragma unroll
        for (int ai = 0; ai < 2; ++ai) {
            int slot[4]; float gt[4];
#pragma unroll
            for (int i = 0; i < 4; ++i) { const int q = ai * HALF + wr * 64 + i * 16 + fr; slot[i] = (u.aux + q < n) ? ps[q] : -1; gt[i] = pg[q]; }
#pragma unroll
            for (int m = 0; m < 4; ++m) {
                const int sl = slot[m];
                if (sl >= 0) {
                    bf16_t* rowp = (bf16_t*)Y + (size_t)sl * D + col0; const float g1 = gt[m];
#pragma unroll
                    for (int bj = 0; bj < 2; ++bj) { const f32x4 v0 = (acc[ai][bj][m][0] * 0.015625f + bv[bj][0]) * g1, v1 = (acc[ai][bj][m][1] * 0.015625f + bv[bj][1]) * g1;
                        u32x4 w; w.x = cvt_pk_bf16(v0[0], v0[1]); w.y = cvt_pk_bf16(v0[2], v0[3]); w.z = cvt_pk_bf16(v1[0], v1[1]); w.w = cvt_pk_bf16(v1[2], v1[3]);
                        st16(rowp + bj * HALF, w); }
                }
            }
            asm volatile("" ::: "memory");
        }
#endif
    }
};
}

struct Args {
    const float* x; const float* c; const float* ctx; const float* c_ctx; const float* ada_w; const float* ada_b; const float* norm_g;
    const float* w_qkv; const float* w_o; const float* rpb; const float* pool_w; const float* pool_b; const float* pool_scale;
    const float* w_router; const float* b_router; const float* w_up; const float* b_up; const float* w_down; const float* b_down;
    float* out; unsigned char* ws; int ph_lo, ph_hi;
};

struct Frame {
    LAS unsigned char* lds; int tid, lane, wave, G, vcu;
};

struct Row { f32x4 v[4]; };
typedef __amdgpu_buffer_rsrc_t rsrc_t;
__device__ __forceinline__ rsrc_t mk_rsrc(const void* p, unsigned bytes) { return __builtin_amdgcn_make_buffer_rsrc((void*)p, (short)0, (int)bytes, 0x00020000); }
__device__ __forceinline__ Row row_load_f32(rsrc_t rs, unsigned soff, int lane) { Row r;
#pragma unroll
    for (int j = 0; j < 4; ++j) r.v[j] = __builtin_bit_cast(f32x4, __builtin_amdgcn_raw_buffer_load_b128(rs, 16 * lane, soff + 1024 * j, ROW_LD_NT));
    return r; }
__device__ __forceinline__ void row_load_bf16_raw(rsrc_t rs, unsigned soff, int lane, u32x2 (&w)[4]) {
#pragma unroll
    for (int j = 0; j < 4; ++j) w[j] = __builtin_bit_cast(u32x2, __builtin_amdgcn_raw_buffer_load_b64(rs, 8 * lane, soff + 512 * j, ROW_LD_NT)); }
__device__ __forceinline__ Row row_unpack_bf16(const u32x2 (&w)[4]) { Row r;
#pragma unroll
    for (int j = 0; j < 4; ++j) r.v[j] = (f32x4){bf_lo(w[j].x), bf_hi(w[j].x), bf_lo(w[j].y), bf_hi(w[j].y)};
    return r; }
__device__ __forceinline__ Row row_load_bf16(rsrc_t rs, unsigned soff, int lane) { u32x2 w[4]; row_load_bf16_raw(rs, soff, lane, w); return row_unpack_bf16(w); }
__device__ __forceinline__ void row_store_f32(rsrc_t rs, unsigned soff, int lane, const Row& r) {
#pragma unroll
    for (int j = 0; j < 4; ++j) __builtin_amdgcn_raw_buffer_store_b128(__builtin_bit_cast(u32x4, r.v[j]), rs, 16 * lane, soff + 1024 * j, ROW_NT); }
__device__ __forceinline__ void row_store_bf16(rsrc_t rs, unsigned soff, int lane, const Row& r) {
#pragma unroll
    for (int j = 0; j < 4; ++j) { u32x2 w; w.x = cvt_pk_bf16(r.v[j][0], r.v[j][1]); w.y = cvt_pk_bf16(r.v[j][2], r.v[j][3]); __builtin_amdgcn_raw_buffer_store_b64(w, rs, 8 * lane, soff + 512 * j, ROW_NT); } }
__device__ __forceinline__ void row_store_fp8(rsrc_t rs, unsigned soff, int lane, const Row& r) {
#pragma unroll
    for (int j = 0; j < 4; ++j) __builtin_amdgcn_raw_buffer_store_b32(cvt_pk4_fp8_sat(r.v[j][0], r.v[j][1], r.v[j][2], r.v[j][3]), rs, 4 * lane, soff + 256 * j, ROW_NT); }
__device__ __forceinline__ float row_sumsq(const Row& r) { float s = 0.f;
#pragma unroll
    for (int j = 0; j < 4; ++j) s += (r.v[j][0] * r.v[j][0] + r.v[j][1] * r.v[j][1]) + (r.v[j][2] * r.v[j][2] + r.v[j][3] * r.v[j][3]);
    return wave_sum(s); }
__device__ __forceinline__ float rstd_of(float ss) { return 1.0f / sqrtf(ss * (1.0f / D) + RMS_EPS); }

__device__ __forceinline__ float silu_f(float v) { return v / (1.0f + __expf(-v)); }
__device__ __forceinline__ void p0_adaln(const Frame& F, const Args& a) {
    LAS f32x4* red = (LAS f32x4*)F.lds;
    float* mod = (float*)(a.ws + WS_MOD);
    for (int it = F.vcu; it < 256; it += F.G) {
        const int layer = it >> 7, cb = it & 127, cl = F.tid & 15, ks = F.tid >> 4;
        f32x4 a0 = {0.f, 0.f, 0.f, 0.f}, a1 = {0.f, 0.f, 0.f, 0.f};
        if (cl < 12) {
            const float* wp = a.ada_w + ((size_t)layer * D + ks * 32) * 6144 + cb * 48 + cl * 4;
#pragma unroll 16
            for (int kk = 0; kk < 32; ++kk) { const f32x4 w = *(const f32x4*)(wp + (size_t)kk * 6144); const float s0 = silu_f(a.c[ks * 32 + kk]), s1 = silu_f(a.c_ctx[ks * 32 + kk]); a0 += w * s0; a1 += w * s1; }
        }
        red[ks * 16 + cl] = a0; red[512 + ks * 16 + cl] = a1;
        __syncthreads();
        if (F.tid < 32) { const int which = F.tid >> 4, c4 = F.tid & 15;
            if (c4 < 12) { f32x4 s = {0.f, 0.f, 0.f, 0.f};
#pragma unroll
                for (int k2 = 0; k2 < 32; ++k2) s += red[which * 512 + k2 * 16 + c4];
                const int col = cb * 48 + c4 * 4; s += *(const f32x4*)(a.ada_b + layer * 6144 + col);
                if (which == 0) *(f32x4*)(mod + (layer == 0 ? 0 : 2) * 6144 + col) = s;
                else if (layer == 0) *(f32x4*)(mod + 6144 + col) = s; } }
        __syncthreads();
    }
}
struct TItem { const float* src; bf16_t* dst; int N, ldwt; };
__device__ __forceinline__ void titem_load(const TItem& t, f32x4 (&v)[16], int lane) {
    const float* src = t.src + (size_t)(lane >> 4) * t.N + 4 * (lane & 15);
#pragma unroll
    for (int i = 0; i < 16; ++i) v[i] = __builtin_nontemporal_load((const f32x4*)(src + (size_t)(4 * i) * t.N));
}
__device__ __forceinline__ void titem_finish(const TItem& t, const f32x4 (&v)[16], LAS float* scr, int lane) {
    const int lk = lane >> 4, n4 = lane & 15;
#pragma unroll
    for (int i = 0; i < 16; ++i) { const int k = 4 * i + lk; *(LAS f32x4*)(scr + k * 64 + ((4 * n4) ^ (4 * (k >> 3)))) = v[i]; }
    LDS_WAIT(); asm volatile("" ::: "memory");
    const int c = lane & 7;
#pragma unroll
    for (int j = 0; j < 8; ++j) { const int n = (lane >> 3) + 8 * j; const LAS float* sp = scr + (8 * c) * 64 + (n ^ (4 * c));
        u32x4 o; o.x = cvt_pk_bf16(sp[0 * 64], sp[1 * 64]); o.y = cvt_pk_bf16(sp[2 * 64], sp[3 * 64]); o.z = cvt_pk_bf16(sp[4 * 64], sp[5 * 64]); o.w = cvt_pk_bf16(sp[6 * 64], sp[7 * 64]);
        *(u32x4*)(t.dst + (size_t)n * t.ldwt + 8 * c) = o; }
    LDS_WAIT(); asm volatile("" ::: "memory");
}
struct TItem8 { const float* src; unsigned char* dst; int N, ldwt; };
__device__ __forceinline__ void titem8_load(const TItem8& t, f32x4 (&v)[16], int lane) {
    const float* src = t.src + (size_t)(4 * (lane >> 3)) * t.N + 4 * (lane & 7);
#pragma unroll
    for (int i = 0; i < 16; ++i) v[i] = __builtin_nontemporal_load((const f32x4*)(src + (size_t)(32 * (i >> 2) + (i & 3)) * t.N));
}
__device__ __forceinline__ void titem8_finish(const TItem8& t, const f32x4 (&v)[16], LAS float* scr, int lane) {
    const int lk = lane >> 3, n4 = lane & 7;
    LAS unsigned* sc = (LAS unsigned*)scr;
#pragma unroll
    for (int j = 0; j < 4; ++j) {
        unsigned d[4];
#pragma unroll
        for (int m = 0; m < 4; ++m) { const f32x4 w = v[4 * j + m] * 64.0f; d[m] = cvt_pk4_fp8(w[0], w[1], w[2], w[3]); }
        const unsigned x0 = __builtin_amdgcn_perm(d[1], d[0], 0x05010400u), x1 = __builtin_amdgcn_perm(d[1], d[0], 0x07030602u);
        const unsigned y0 = __builtin_amdgcn_perm(d[3], d[2], 0x05010400u), y1 = __builtin_amdgcn_perm(d[3], d[2], 0x07030602u);
        unsigned tb[4];
        tb[0] = __builtin_amdgcn_perm(y0, x0, 0x05040100u); tb[1] = __builtin_amdgcn_perm(y0, x0, 0x07060302u);
        tb[2] = __builtin_amdgcn_perm(y1, x1, 0x05040100u); tb[3] = __builtin_amdgcn_perm(y1, x1, 0x07060302u);
#pragma unroll
        for (int b = 0; b < 4; ++b) sc[(4 * n4 + b) * 32 + ((8 * j + lk) ^ (4 * n4))] = tb[b];
    }
    LDS_WAIT(); asm volatile("" ::: "memory");
    const int c = lane & 7;
#pragma unroll
    for (int p = 0; p < 4; ++p) { const int n = 8 * p + (lane >> 3);
        const u32x4 o = *(const LAS u32x4*)(sc + n * 32 + 4 * (c ^ (n >> 2)));
        if (CONV_NT) __builtin_nontemporal_store(o, (u32x4*)(t.dst + (size_t)n * t.ldwt + 16 * c)); else *(u32x4*)(t.dst + (size_t)n * t.ldwt + 16 * c) = o; }
    LDS_WAIT(); asm volatile("" ::: "memory");
}
__device__ __forceinline__ void transpose_item(const float* W, int N, bf16_t* WT, int ldwt, int k0, int n0, int drow0, LAS float* scr, int lane) {
    const TItem t{W + (size_t)k0 * N + n0, WT + (size_t)drow0 * ldwt + k0, N, ldwt};
    f32x4 v[16]; titem_load(t, v, lane); titem_finish(t, v, scr, lane);
}
__device__ __forceinline__ void p0_router_weights(const Frame& F, const Args& a) {
    bf16_t* wrt = (bf16_t*)(a.ws + WS_WRT);
    for (int i = blockIdx.x * NT + F.tid; i < 2 * NE * D; i += F.G * NT) { const int l = i / (NE * D), r = i % (NE * D), e = r / D, k = r % D;
        const float w = a.w_router[((size_t)l * D + k) * NE + e]; const unsigned hb = cvt_pk_bf16(w, 0.f) & 0xffffu; const float lo = w - __uint_as_float(hb << 16);
        wrt[((size_t)(l * 2 + 0) * NE + e) * D + k] = (bf16_t)hb; wrt[((size_t)(l * 2 + 1) * NE + e) * D + k] = (bf16_t)(cvt_pk_bf16(lo, 0.f) & 0xffffu); }
}
__device__ __forceinline__ void p0_convert_small(const Frame& F, const Args& a) {
    LAS float* scr = (LAS float*)(F.lds + F.wave * 16384);
    const int gw = F.wave * F.G + F.vcu, NGW = F.G * NWAVES;
    constexpr int I_QKV = 16 * 48, I_O = 16 * 16, I_POOL = 4 * 4 * 4, NITEMS = I_QKV + I_O + I_POOL;
    bf16_t* wqkv = (bf16_t*)(a.ws + WS_WQKV); bf16_t* wo = (bf16_t*)(a.ws + WS_WO); bf16_t* wpool = (bf16_t*)(a.ws + WS_WPOOL);
    for (int it = gw; it < NITEMS; it += NGW) {
        int r = it;
#if QKV_FP8
        if (r < I_QKV) { const int kb = r / 96, nb = r % 96; const TItem8 t{a.w_qkv + (size_t)(kb * 128) * 3072 + nb * 32, (unsigned char*)wqkv + (size_t)(nb * 32) * 1024 + kb * 128, 3072, 1024};
            f32x4 v[16]; titem8_load(t, v, F.lane); titem8_finish(t, v, scr, F.lane); continue; } r -= I_QKV;
#else
        if (r < I_QKV) { const int kb = r / 48, nb = r % 48; transpose_item(a.w_qkv, 3072, wqkv, 1024, kb * 64, nb * 64, nb * 64, scr, F.lane); continue; } r -= I_QKV;
#endif
        if (r < I_O) { const int kb = r / 16, nb = r % 16; transpose_item(a.w_o, 1024, wo, 1024, kb * 64, nb * 64, nb * 64, scr, F.lane); continue; } r -= I_O;
        { const int g = r / 16, q = r % 16, kb = q / 4, nb = q % 4; transpose_item(a.pool_w + (size_t)g * 65536, 256, wpool + (size_t)g * 65536, 256, kb * 64, nb * 64, nb * 64, scr, F.lane); }
    }
}
constexpr int CV_UP1 = 16 * 32, CV_UP = 32 * CV_UP1, CV_DN1 = 16 * 16, CV_DN = 32 * CV_DN1, CV_ITEMS = CV_UP + CV_DN, CV_CHUNK = 8, CV_NCHUNK = CV_ITEMS / CV_CHUNK;
__device__ __forceinline__ TItem8 cv_item(const Args& a, int layer, int r) {
    unsigned char* wup = a.ws + WS_WUP + (size_t)layer * 32 * 2048 * 1024; unsigned char* wdn = a.ws + WS_WDN + (size_t)layer * 32 * 1024 * 1024;
    const float* sup = a.w_up + (size_t)layer * 32 * 1024 * 2048; const float* sdn = a.w_down + (size_t)layer * 32 * 1024 * 1024;
    if (r < CV_UP) { const int mat = r / CV_UP1, q = r % CV_UP1, kb = q / 64, nb = q % 64, n0 = nb * 32;
        const int drow = (n0 < 1024) ? ((n0 >> 7) * 256 + (n0 & 127)) : (((n0 - 1024) >> 7) * 256 + 128 + ((n0 - 1024) & 127));
        return TItem8{sup + (size_t)mat * 1024 * 2048 + (size_t)(kb * 128) * 2048 + n0, wup + (size_t)mat * 2048 * 1024 + (size_t)drow * 1024 + kb * 128, 2048, 1024}; }
    r -= CV_UP; const int mat = r / CV_DN1, q = r % CV_DN1, kb = q / 32, nb = q % 32;
    return TItem8{sdn + (size_t)mat * 1024 * 1024 + (size_t)(kb * 128) * 1024 + nb * 32, wdn + (size_t)mat * 1024 * 1024 + (size_t)(nb * 32) * 1024 + kb * 128, 1024, 1024};
}
struct BgPre { unsigned c0, c1; int have; };
__device__ __forceinline__ void bg_prefetch(const Frame& F, const Args& a, int layer, BgPre& p) {
    unsigned* q = (unsigned*)(a.ws + WS_CTL) + CW_Q + 64 * layer;
    volatile LAS unsigned* sh = (volatile LAS unsigned*)(F.lds + MISC_OFF + 64);
    if (F.tid == 0) { const unsigned ia = __hip_atomic_fetch_add(q, 2u, __ATOMIC_RELAXED, __HIP_MEMORY_SCOPE_AGENT); sh[0] = ia; sh[1] = ia + 1u; }
    __syncthreads();
    p.c0 = sh[0]; p.c1 = sh[1];
    __syncthreads();
    p.have = 1;
}
template <bool PRE = false>
__device__ __forceinline__ void bg_convert(const Frame& F, const Args& a, int layer, int phase, unsigned Gf, bool fg, BgPre& prer) {
    unsigned* ctl = (unsigned*)(a.ws + WS_CTL); unsigned* q = ctl + CW_Q + 64 * layer; unsigned* done = ctl + CW_DONE + 64 * phase;
    volatile LAS unsigned* sh = (volatile LAS unsigned*)(F.lds + MISC_OFF + 64);
    LAS float* scr = (LAS float*)(F.lds + F.wave * 16384);
    const unsigned NC = (unsigned)CV_NCHUNK;
    __syncthreads();
    if (fg && F.tid == 0) __hip_atomic_fetch_add(done, 1u, __ATOMIC_RELAXED, __HIP_MEMORY_SCOPE_AGENT);
    unsigned ia = NC, ib = NC, dn = 0u, c0, c1;
    f32x4 va[16], vb[16];
    const bool pre_ = PRE && prer.have != 0;
    if (pre_) { c0 = prer.c0; c1 = prer.c1; }
    else {
        if (F.tid == 0) { if (Gf != 0u) dn = __hip_atomic_load(done, __ATOMIC_RELAXED, __HIP_MEMORY_SCOPE_AGENT);
            if (Gf == 0u || dn < Gf) { ia = __hip_atomic_fetch_add(q, 2u, __ATOMIC_RELAXED, __HIP_MEMORY_SCOPE_AGENT); ib = ia + 1u; }
            sh[0] = ia; sh[1] = ib; }
        __syncthreads();
        c0 = sh[0]; c1 = sh[1];
        __syncthreads();
    }
    if (c0 >= NC) return;
    TItem8 ta = cv_item(a, layer, (int)c0 * CV_CHUNK + F.wave), tb = ta;
    titem8_load(ta, va, F.lane);
    for (;;) {
        if (c1 < NC) { tb = cv_item(a, layer, (int)c1 * CV_CHUNK + F.wave); titem8_load(tb, vb, F.lane); }
        unsigned nx = NC;
        if (F.tid == 0) { const bool stop = (Gf != 0u) && (dn >= Gf); if (!stop) nx = __hip_atomic_fetch_add(q, 1u, __ATOMIC_RELAXED, __HIP_MEMORY_SCOPE_AGENT);
            if (Gf != 0u) dn = __hip_atomic_load(done, __ATOMIC_RELAXED, __HIP_MEMORY_SCOPE_AGENT); }
        titem8_finish(ta, va, scr, F.lane);
        if (c1 >= NC) break;
        if (F.tid == 0) sh[0] = nx;
        __syncthreads();
        c0 = sh[0];
        __syncthreads();
        if (c0 < NC) { ta = cv_item(a, layer, (int)c0 * CV_CHUNK + F.wave); titem8_load(ta, va, F.lane); }
        nx = NC;
        if (F.tid == 0) { const bool stop = (Gf != 0u) && (dn >= Gf); if (!stop) nx = __hip_atomic_fetch_add(q, 1u, __ATOMIC_RELAXED, __HIP_MEMORY_SCOPE_AGENT);
            if (Gf != 0u) dn = __hip_atomic_load(done, __ATOMIC_RELAXED, __HIP_MEMORY_SCOPE_AGENT); }
        titem8_finish(tb, vb, scr, F.lane);
        if (c0 >= NC) break;
        if (F.tid == 0) sh[0] = nx;
        __syncthreads();
        c1 = sh[0];
        __syncthreads();
    }
    __syncthreads();
}

template <bool OUT8 = false>
__device__ __forceinline__ void modulate_rows(const Frame& F, const float* x, int nrows, const float* g, const float* shift, const float* scale, void* out, int gw, int NGW) {
    const int lane = F.lane;
    const rsrc_t rx = mk_rsrc(x, (unsigned)nrows * D * 4), ro = mk_rsrc(out, (unsigned)nrows * D * (OUT8 ? 1 : 2));
    Row rn; if (gw < nrows) rn = row_load_f32(rx, (unsigned)gw * D * 4, lane);
    Row gs = row_load_f32(mk_rsrc(g, D * 4), 0, lane), sh = row_load_f32(mk_rsrc(shift, D * 4), 0, lane); { const Row sc = row_load_f32(mk_rsrc(scale, D * 4), 0, lane);
#pragma unroll
        for (int j = 0; j < 4; ++j) gs.v[j] = gs.v[j] * (sc.v[j] + 1.0f); }
    for (int m = gw; m < nrows; m += NGW) {
        Row r = rn; if (m + NGW < nrows) rn = row_load_f32(rx, (unsigned)(m + NGW) * D * 4, lane);
        const float rs = rstd_of(row_sumsq(r));
#pragma unroll
        for (int j = 0; j < 4; ++j) r.v[j] = r.v[j] * rs * gs.v[j] + sh.v[j];
        if (OUT8) row_store_fp8(ro, (unsigned)m * D, lane, r); else row_store_bf16(ro, (unsigned)m * D * 2, lane, r);
    }
}

namespace na {
constexpr int LDS_CK = 0, LDS_CV = 32768, LDS_RING = 65536, SLOT = 16384, LDS_BIAS = LDS_RING + 3 * SLOT;
__device__ __forceinline__ unsigned kaddr(int key, int c) { return (unsigned)(key * 128 + ((c ^ ((key >> 1) & 7)) << 4)); }
__device__ __forceinline__ s16x4 vtr(const LAS unsigned char* p) { typedef short v4i16_t __attribute__((ext_vector_type(4)));
    return __builtin_bit_cast(s16x4, __builtin_amdgcn_ds_read_tr16_b64_v4i16((LAS v4i16_t*)p)); }

template <bool LOCAL>
__device__ __forceinline__ void tile(const LAS unsigned char* kimg, int key0, const LAS unsigned char* vimg, int vstride, const bf16x8 (&qf)[2], float& m, float& l, f32x4 (&o)[4],
                                     const LAS float* brow, unsigned valid, int lane) {
    const int fr = lane & 15, fq = lane >> 4;
    f32x4 s[2];
#pragma unroll
    for (int kb = 0; kb < 2; ++kb) {
        const int key = key0 + kb * 16 + fr;
        const bf16x8 k0 = *(const LAS bf16x8*)(kimg + kaddr(key, fq)), k1 = *(const LAS bf16x8*)(kimg + kaddr(key, 4 + fq));
        s[kb] = __builtin_amdgcn_mfma_f32_16x16x32_bf16(k0, qf[0], (f32x4){0.f, 0.f, 0.f, 0.f}, 0, 0, 0);
        s[kb] = __builtin_amdgcn_mfma_f32_16x16x32_bf16(k1, qf[1], s[kb], 0, 0, 0);
    }
    if (LOCAL) {
#pragma unroll
        for (int kb = 0; kb < 2; ++kb)
#pragma unroll
            for (int r = 0; r < 4; ++r) { const float b = brow[kb * 16 + r]; s[kb][r] = ((valid >> (kb * 4 + r)) & 1u) ? s[kb][r] + b : -1e30f; }
    }
    float mt = fmaxf(fmaxf(fmaxf(s[0][0], s[0][1]), fmaxf(s[0][2], s[0][3])), fmaxf(fmaxf(s[1][0], s[1][1]), fmaxf(s[1][2], s[1][3])));
    mt = fmaxf(mt, __shfl_xor(mt, 16)); mt = fmaxf(mt, __shfl_xor(mt, 32));
    const float mn = fmaxf(m, mt), alpha = __builtin_amdgcn_exp2f(m - mn);
    m = mn;
    float p[8]; float ps = 0.f;
#pragma unroll
    for (int kb = 0; kb < 2; ++kb)
#pragma unroll
        for (int r = 0; r < 4; ++r) { p[kb * 4 + r] = __builtin_amdgcn_exp2f(s[kb][r] - mn); ps += p[kb * 4 + r]; }
    l = l * alpha + ps;
    u32x4 pw; pw.x = cvt_pk_bf16(p[0], p[1]); pw.y = cvt_pk_bf16(p[2], p[3]); pw.z = cvt_pk_bf16(p[4], p[5]); pw.w = cvt_pk_bf16(p[6], p[7]);
    const bf16x8 pb = __builtin_bit_cast(bf16x8, pw);
    const int q = fr >> 2, pp = fr & 3;
#pragma unroll
    for (int db = 0; db < 4; ++db) {
        const LAS unsigned char* vb = vimg + db * vstride + (key0 + 4 * fq + q) * 32 + pp * 8;
        const s16x4 lo = vtr(vb), hi = vtr(vb + 16 * 32);
        const bf16x8 vf = (bf16x8){lo[0], lo[1], lo[2], lo[3], hi[0], hi[1], hi[2], hi[3]};
        o[db] = o[db] * alpha;
        o[db] = __builtin_amdgcn_mfma_f32_16x16x32_bf16(vf, pb, o[db], 0, 0, 0);
    }
}

__device__ __forceinline__ void tile2(const LAS unsigned char* kloc, int key0, const LAS unsigned char* vloc, const LAS unsigned char* kctx, int ckey0, const LAS unsigned char* vctx,
                                      const bf16x8 (&qf)[2], float& m, f32x4& l, f32x4 (&o)[4], const LAS float* brow, unsigned valid, int lane) {
    const int fr = lane & 15, fq = lane >> 4;
    f32x4 s[4];
#pragma unroll
    for (int kb = 0; kb < 2; ++kb) {
        const int key = key0 + kb * 16 + fr, ck = ckey0 + kb * 16 + fr;
        const bf16x8 k0 = *(const LAS bf16x8*)(kloc + kaddr(key, fq)), k1 = *(const LAS bf16x8*)(kloc + kaddr(key, 4 + fq));
        const bf16x8 c0 = *(const LAS bf16x8*)(kctx + kaddr(ck, fq)), c1 = *(const LAS bf16x8*)(kctx + kaddr(ck, 4 + fq));
        s[kb] = __builtin_amdgcn_mfma_f32_16x16x32_bf16(k0, qf[0], (f32x4){0.f, 0.f, 0.f, 0.f}, 0, 0, 0);
        s[kb] = __builtin_amdgcn_mfma_f32_16x16x32_bf16(k1, qf[1], s[kb], 0, 0, 0);
        s[2 + kb] = __builtin_amdgcn_mfma_f32_16x16x32_bf16(c0, qf[0], (f32x4){0.f, 0.f, 0.f, 0.f}, 0, 0, 0);
        s[2 + kb] = __builtin_amdgcn_mfma_f32_16x16x32_bf16(c1, qf[1], s[2 + kb], 0, 0, 0);
    }
#pragma unroll
    for (int kb = 0; kb < 2; ++kb)
#pragma unroll
        for (int r = 0; r < 4; ++r) { const float b = brow[kb * 16 + r]; s[kb][r] = ((valid >> (kb * 4 + r)) & 1u) ? s[kb][r] + b : -1e30f; }
    float mt = fmaxf(fmaxf(fmaxf(s[0][0], s[0][1]), fmaxf(s[0][2], s[0][3])), fmaxf(fmaxf(s[1][0], s[1][1]), fmaxf(s[1][2], s[1][3])));
    mt = fmaxf(mt, fmaxf(fmaxf(fmaxf(s[2][0], s[2][1]), fmaxf(s[2][2], s[2][3])), fmaxf(fmaxf(s[3][0], s[3][1]), fmaxf(s[3][2], s[3][3]))));
    mt = fmaxf(mt, __shfl_xor(mt, 16)); mt = fmaxf(mt, __shfl_xor(mt, 32));
    if (__builtin_amdgcn_ballot_w64(mt > m + 8.0f) != 0ull) {
        const float mn = fmaxf(m, mt), alpha = __builtin_amdgcn_exp2f(m - mn);
        m = mn; l = l * alpha;
#pragma unroll
        for (int db = 0; db < 4; ++db) o[db] = o[db] * alpha;
    }
    float p[16];
#pragma unroll
    for (int t = 0; t < 4; ++t)
#pragma unroll
        for (int r = 0; r < 4; ++r) p[t * 4 + r] = __builtin_amdgcn_exp2f(s[t][r] - m);
    u32x4 pw; pw.x = cvt_pk_bf16(p[0], p[1]); pw.y = cvt_pk_bf16(p[2], p[3]); pw.z = cvt_pk_bf16(p[4], p[5]); pw.w = cvt_pk_bf16(p[6], p[7]);
    u32x4 pc; pc.x = cvt_pk_bf16(p[8], p[9]); pc.y = cvt_pk_bf16(p[10], p[11]); pc.z = cvt_pk_bf16(p[12], p[13]); pc.w = cvt_pk_bf16(p[14], p[15]);
    const bf16x8 pb = __builtin_bit_cast(bf16x8, pw), pcb = __builtin_bit_cast(bf16x8, pc);
    { const bf16x8 ones = (bf16x8){0x3F80, 0x3F80, 0x3F80, 0x3F80, 0x3F80, 0x3F80, 0x3F80, 0x3F80};
      l = __builtin_amdgcn_mfma_f32_16x16x32_bf16(ones, pb, l, 0, 0, 0); l = __builtin_amdgcn_mfma_f32_16x16x32_bf16(ones, pcb, l, 0, 0, 0); }
    const int q = fr >> 2, pp = fr & 3;
#pragma unroll
    for (int db = 0; db < 4; ++db) {
        const LAS unsigned char* vb = vloc + db * (64 * 32) + (key0 + 4 * fq + q) * 32 + pp * 8;
        const LAS unsigned char* vc = vctx + db * (256 * 32) + (ckey0 + 4 * fq + q) * 32 + pp * 8;
        const s16x4 lo = vtr(vb), hi = vtr(vb + 16 * 32), clo = vtr(vc), chi = vtr(vc + 16 * 32);
        const bf16x8 vf = (bf16x8){lo[0], lo[1], lo[2], lo[3], hi[0], hi[1], hi[2], hi[3]}, cf = (bf16x8){clo[0], clo[1], clo[2], clo[3], chi[0], chi[1], chi[2], chi[3]};
        o[db] = __builtin_amdgcn_mfma_f32_16x16x32_bf16(vf, pb, o[db], 0, 0, 0);
        o[db] = __builtin_amdgcn_mfma_f32_16x16x32_bf16(cf, pcb, o[db], 0, 0, 0);
    }
}

struct BandSel { unsigned fm[4]; int boff[4]; unsigned pm01, pm23; };
__device__ __forceinline__ void tile3(const LAS unsigned char* kloc, int key0, const LAS unsigned char* vloc, const LAS unsigned char* kctx, int ckey0, const LAS unsigned char* vctx,
                                      const bf16x8 (&qf)[2], float& m, f32x4& l, f32x4 (&o)[4], const LAS float* brow, const BandSel& bs, int lane, bool first) {
    const int fr = lane & 15, fq = lane >> 4;
    f32x4 s[4];
    const float nm = -m; const f32x4 nm4 = {nm, nm, nm, nm};
#pragma unroll
    for (int kb = 0; kb < 2; ++kb) {
        const int key = key0 + kb * 16 + fr, ck = ckey0 + kb * 16 + fr;
        const bf16x8 k0 = *(const LAS bf16x8*)(kloc + kaddr(key, fq)), k1 = *(const LAS bf16x8*)(kloc + kaddr(key, 4 + fq));
        const bf16x8 c0 = *(const LAS bf16x8*)(kctx + kaddr(ck, fq)), c1 = *(const LAS bf16x8*)(kctx + kaddr(ck, 4 + fq));
        s[kb] = __builtin_amdgcn_mfma_f32_16x16x32_bf16(k0, qf[0], nm4, 0, 0, 0);
        s[kb] = __builtin_amdgcn_mfma_f32_16x16x32_bf16(k1, qf[1], s[kb], 0, 0, 0);
        s[2 + kb] = __builtin_amdgcn_mfma_f32_16x16x32_bf16(c0, qf[0], nm4, 0, 0, 0);
        s[2 + kb] = __builtin_amdgcn_mfma_f32_16x16x32_bf16(c1, qf[1], s[2 + kb], 0, 0, 0);
    }
    float sl[4];
#pragma unroll
    for (int r = 0; r < 4; ++r) { const unsigned a_ = __float_as_uint(s[0][r]), b_ = __float_as_uint(s[1][r]); sl[r] = __uint_as_float((a_ & bs.fm[r]) | (b_ & ~bs.fm[r])) + brow[bs.boff[r]]; }
    if (first) {
        float mt = fmaxf(fmaxf(sl[0], sl[1]), fmaxf(sl[2], sl[3]));
        mt = fmaxf(mt, fmaxf(fmaxf(fmaxf(s[2][0], s[2][1]), fmaxf(s[2][2], s[2][3])), fmaxf(fmaxf(s[3][0], s[3][1]), fmaxf(s[3][2], s[3][3]))));
        mt = fmaxf(mt, __shfl_xor(mt, 16)); mt = fmaxf(mt, __shfl_xor(mt, 32));
        m = mt;
#pragma unroll
        for (int r = 0; r < 4; ++r) { sl[r] -= mt; s[2][r] -= mt; s[3][r] -= mt; }
    }
    float pl[4], pcx[8];
#pragma unroll
    for (int r = 0; r < 4; ++r) pl[r] = __builtin_amdgcn_exp2f(sl[r]);
#pragma unroll
    for (int t = 0; t < 2; ++t)
#pragma unroll
        for (int r = 0; r < 4; ++r) pcx[t * 4 + r] = __builtin_amdgcn_exp2f(s[2 + t][r]);
    const unsigned pk01 = cvt_pk_bf16(pl[0], pl[1]), pk23 = cvt_pk_bf16(pl[2], pl[3]);
    u32x4 pw; pw.x = pk01 & bs.pm01; pw.y = pk23 & bs.pm23; pw.z = pk01 & ~bs.pm01; pw.w = pk23 & ~bs.pm23;
    u32x4 pc; pc.x = cvt_pk_bf16(pcx[0], pcx[1]); pc.y = cvt_pk_bf16(pcx[2], pcx[3]); pc.z = cvt_pk_bf16(pcx[4], pcx[5]); pc.w = cvt_pk_bf16(pcx[6], pcx[7]);
    const bf16x8 pb = __builtin_bit_cast(bf16x8, pw), pcb = __builtin_bit_cast(bf16x8, pc);
    { const bf16x8 ones = (bf16x8){0x3F80, 0x3F80, 0x3F80, 0x3F80, 0x3F80, 0x3F80, 0x3F80, 0x3F80};
      l = __builtin_amdgcn_mfma_f32_16x16x32_bf16(ones, pb, l, 0, 0, 0); l = __builtin_amdgcn_mfma_f32_16x16x32_bf16(ones, pcb, l, 0, 0, 0); }
    const int q = fr >> 2, pp = fr & 3;
#pragma unroll
    for (int db = 0; db < 4; ++db) {
        const LAS unsigned char* vb = vloc + db * (64 * 32) + (key0 + 4 * fq + q) * 32 + pp * 8;
        const LAS unsigned char* vc = vctx + db * (256 * 32) + (ckey0 + 4 * fq + q) * 32 + pp * 8;
        const s16x4 lo = vtr(vb), hi = vtr(vb + 16 * 32), clo = vtr(vc), chi = vtr(vc + 16 * 32);
        const bf16x8 vf = (bf16x8){lo[0], lo[1], lo[2], lo[3], hi[0], hi[1], hi[2], hi[3]}, cf = (bf16x8){clo[0], clo[1], clo[2], clo[3], chi[0], chi[1], chi[2], chi[3]};
        o[db] = __builtin_amdgcn_mfma_f32_16x16x32_bf16(vf, pb, o[db], 0, 0, 0);
        o[db] = __builtin_amdgcn_mfma_f32_16x16x32_bf16(cf, pcb, o[db], 0, 0, 0);
    }
}

__device__ __forceinline__ void attn_unit(const Frame& F, const Args& a, int h, int rlo, int rhi, bool border) {
    const bf16_t* Q = (const bf16_t*)(a.ws + WS_Q); const bf16_t* Kg = (const bf16_t*)(a.ws + WS_K); const bf16_t* Vg = (const bf16_t*)(a.ws + WS_V); bf16_t* O = (bf16_t*)(a.ws + WS_O);
    const int tid = F.tid, lane = F.lane, wid = F.wave, fr = lane & 15, fq = lane >> 4, g = wid & 3;
    LAS unsigned char* lds = F.lds;
    LAS float* bias = (LAS float*)(lds + LDS_BIAS) + 32;
    const int kb = border ? (rlo < 128 ? 0 : 248) : rlo - 4, ke = border ? kb + 7 : rhi + 3;
    int row0[4], ws0[4], nj[4];
#pragma unroll
    for (int j = 0; j < 4; ++j) { const int s = (wid >> 2) + 2 * j;
        if (border) { row0[j] = rlo + s; ws0[j] = kb; nj[j] = (s < 4) ? 1 : 0; }
        else { const int rA = rlo + ((s - rlo) & 7); row0[j] = rA; ws0[j] = rA - 4; nj[j] = (rA > rhi) ? 0 : ((rhi - rA) >> 3) + 1; } }
    const int sg = (g == 0) ? 0 : (g == 1) ? 8 : (g == 2) ? 24 : 32;
    const int cq = 16 * g + fr, c0 = min(max(cq - 8, 0), 48);
    const int dc0 = sg + 4 * fq - cq + 15;
    BandSel bs;
    { const int lo = c0 - sg; bool v0[4];
#pragma unroll
      for (int r = 0; r < 4; ++r) { v0[r] = (4 * fq + r) >= lo; bs.fm[r] = v0[r] ? 0xFFFFFFFFu : 0u; bs.boff[r] = r + (v0[r] ? 0 : 16); }
      bs.pm01 = (v0[0] ? 0xFFFFu : 0u) | (v0[1] ? 0xFFFF0000u : 0u); bs.pm23 = (v0[2] ? 0xFFFFu : 0u) | (v0[3] ? 0xFFFF0000u : 0u); }
    const unsigned qoff = (unsigned)cq * D + h * HD + 8 * fq, ooff = (unsigned)cq * D + h * HD + 4 * fq;
    float m[4]; f32x4 l[4]; f32x4 o[4][4]; bf16x8 qf[4][2], qn[2];
    __syncthreads();
#pragma unroll
    for (int n = 0; n < 4; ++n) { const int ch = tid + NT * n, key = ch >> 3, c = ch & 7;
        const u32x4 kv = *(const u32x4*)(Kg + (size_t)(L + key) * D + h * HD + c * 8), vv = *(const u32x4*)(Vg + (size_t)(L + key) * D + h * HD + c * 8);
        *(LAS u32x4*)(lds + LDS_CK + kaddr(key, c)) = kv;
        *(LAS u32x4*)(lds + LDS_CV + (c >> 1) * (256 * 32) + key * 32 + (c & 1) * 16) = vv; }
    if (tid < 465) bias[tid] = a.rpb[h * 465 + tid] * LOG2E;
    const int key = tid >> 3, c = tid & 7;
    const unsigned kvoff = (unsigned)key * D + h * HD + c * 8;
    const unsigned ksl = kaddr(key, c), vsl = 8192 + (c >> 1) * (64 * 32) + key * 32 + (c & 1) * 16;
#pragma unroll
    for (int n = 0; n < 2; ++n) { const size_t go = (size_t)(kb + n) * GW * D + kvoff; const u32x4 kv = *(const u32x4*)(Kg + go), vv = *(const u32x4*)(Vg + go);
        *(LAS u32x4*)(lds + LDS_RING + n * SLOT + ksl) = kv; *(LAS u32x4*)(lds + LDS_RING + n * SLOT + vsl) = vv; }
#pragma unroll
    for (int j = 0; j < 4; ++j) if (nj[j] > 0 && ws0[j] == kb) { const bf16_t* qp = Q + (size_t)row0[j] * GW * D + qoff; qf[j][0] = *(const bf16x8*)qp; qf[j][1] = *(const bf16x8*)(qp + 32); }
    __syncthreads();
    int rs = 0;
    for (int kr = kb; kr <= ke; ++kr) {
        u32x4 kreg, vreg; const bool pf = kr + 2 <= ke;
        if (pf) { const size_t go = (size_t)(kr + 2) * GW * D + kvoff; kreg = *(const u32x4*)(Kg + go); vreg = *(const u32x4*)(Vg + go); }
#pragma unroll
        for (int j = 0; j < 4; ++j) { const int d = kr + 1 - ws0[j]; if (d >= 0 && d < 8 * nj[j] && (d & 7) == 0) { const bf16_t* qp = Q + (size_t)(row0[j] + d) * GW * D + qoff; qn[0] = *(const bf16x8*)qp; qn[1] = *(const bf16x8*)(qp + 32); } }
        const LAS unsigned char* slot = lds + LDS_RING + rs * SLOT;
#pragma unroll
        for (int j = 0; j < 4; ++j) { const int d = kr - ws0[j];
            if (d >= 0 && d < 8 * nj[j]) { const int i = d & 7, row = row0[j] + (d & ~7);
                if (i == 0) { m[j] = 0.f; l[j] = (f32x4){0.f, 0.f, 0.f, 0.f};
#pragma unroll
                    for (int db = 0; db < 4; ++db) o[j][db] = (f32x4){0.f, 0.f, 0.f, 0.f};
                    if (kr != kb) { qf[j][0] = qn[0]; qf[j][1] = qn[1]; } }
                tile3(slot, sg, slot + 8192, lds + LDS_CK, (kr & 7) * 32, lds + LDS_CV, qf[j], m[j], l[j], o[j], bias + (kr - row + 7) * 31 + dc0, bs, lane, i == 0);
                if (i == 7) { const float inv = 1.0f / l[j][0];
                    bf16_t* orow = O + (size_t)row * GW * D;
#pragma unroll
                    for (int db = 0; db < 4; ++db) { u32x2 w; w.x = cvt_pk_bf16(o[j][db][0] * inv, o[j][db][1] * inv); w.y = cvt_pk_bf16(o[j][db][2] * inv, o[j][db][3] * inv); st8(orow + (ooff + db * 16), w); } }
            } }
        if (pf) { const int ws_ = (rs + 2 >= 3) ? rs - 1 : rs + 2; *(LAS u32x4*)(lds + LDS_RING + ws_ * SLOT + ksl) = kreg; *(LAS u32x4*)(lds + LDS_RING + ws_ * SLOT + vsl) = vreg; }
        rs = (rs == 2) ? 0 : rs + 1;
        __syncthreads();
    }
}
#ifndef ATT_STRIPS
#define ATT_STRIPS 14
#endif
__device__ __forceinline__ void attn_phase(const Frame& F, const Args& a) {
    constexpr int NS = ATT_STRIPS, NFG = 16 * NS, BASE = 248 / NS, REM = 248 % NS;
    const int u = blockIdx.x;
    if (F.G == 256 && u >= NFG) {
        const int b = u - NFG;
        if (b < 32) attn_unit(F, a, b & 15, b < 16 ? 0 : 252, b < 16 ? 3 : 255, true);
        return;
    }
    for (int unit = u; unit < NFG; unit += (F.G == 256 ? 256 : F.G)) {
        const int h = unit & 15, strip = unit >> 4;
        const int rlo = 4 + strip * BASE + (strip < REM ? strip : REM), rhi = rlo + BASE + (strip < REM ? 1 : 0) - 1;
        attn_unit(F, a, h, rlo, rhi, false);
    }
    if (F.G != 256) for (int b = u; b < 32; b += F.G) attn_unit(F, a, b & 15, b < 16 ? 0 : 252, b < 16 ? 3 : 255, true);
}
}

__device__ __forceinline__ void vec_phase(const Frame& F, const Args& a) {
    float* V = (float*)(a.ws + WS_VEC); const float* modb = (const float*)(a.ws + WS_MOD);
    for (int c = F.tid; c < D; c += NT) {
#pragma unroll
        for (int l = 0; l < 2; ++l) { const float* mod = modb + (l == 0 ? 0 : 2) * 6144; const float* ng = a.norm_g + l * 4 * D;
            V[(4 + 4 * l) * D + c] = mod[2 * D + c] * ng[D + c]; V[(5 + 4 * l) * D + c] = ng[2 * D + c] * (1.0f + mod[4 * D + c]);
            V[(6 + 4 * l) * D + c] = mod[3 * D + c]; V[(7 + 4 * l) * D + c] = mod[5 * D + c] * ng[3 * D + c]; }
        const float* mod1 = modb + 2 * 6144;
        V[12 * D + c] = a.norm_g[4 * D + c] * (1.0f + mod1[D + c]); V[13 * D + c] = mod1[c];
    }
}

namespace post {
constexpr int LDS_WR = 0;
constexpr int M_TKE = MISC_OFF + 2048;
constexpr int M_TKW = MISC_OFF + 3072;
constexpr int M_RANK = MISC_OFF + 4096;
constexpr int M_LCNT = MISC_OFF + 5120;
constexpr int M_BASE = MISC_OFF + 5248;
__device__ __forceinline__ float reduce32(float (&acc)[32], int lane) {
    float a16[16], a8[8], a4[4], a2[2];
    { const bool hi = lane & 32;
#pragma unroll
      for (int i = 0; i < 16; ++i) { const float send = hi ? acc[i] : acc[i + 16], keep = hi ? acc[i + 16] : acc[i]; a16[i] = keep + __shfl_xor(send, 32); } }
    { const bool hi = lane & 16;
#pragma unroll
      for (int i = 0; i < 8; ++i) { const float send = hi ? a16[i] : a16[i + 8], keep = hi ? a16[i + 8] : a16[i]; a8[i] = keep + __shfl_xor(send, 16); } }
    { const bool hi = lane & 8;
#pragma unroll
      for (int i = 0; i < 4; ++i) { const float send = hi ? a8[i] : a8[i + 4], keep = hi ? a8[i + 4] : a8[i]; a4[i] = keep + __shfl_xor(send, 8); } }
    { const bool hi = lane & 4;
#pragma unroll
      for (int i = 0; i < 2; ++i) { const float send = hi ? a4[i] : a4[i + 2], keep = hi ? a4[i + 2] : a4[i]; a2[i] = keep + __shfl_xor(send, 4); } }
    float v; { const bool hi = lane & 2; const float send = hi ? a2[0] : a2[1], keep = hi ? a2[1] : a2[0]; v = keep + __shfl_xor(send, 2); }
    v += __shfl_xor(v, 1);
    return v;
}
__device__ __forceinline__ float reduce16(float (&acc)[16], int lane) {
    float a8[8], a4[4], a2[2];
    { const bool hi = lane & 16;
#pragma unroll
      for (int i = 0; i < 8; ++i) { const float send = hi ? acc[i] : acc[i + 8], keep = hi ? acc[i + 8] : acc[i]; a8[i] = keep + __shfl_xor(send, 16); } }
    { const bool hi = lane & 8;
#pragma unroll
      for (int i = 0; i < 4; ++i) { const float send = hi ? a8[i] : a8[i + 4], keep = hi ? a8[i + 4] : a8[i]; a4[i] = keep + __shfl_xor(send, 8); } }
    { const bool hi = lane & 4;
#pragma unroll
      for (int i = 0; i < 2; ++i) { const float send = hi ? a4[i] : a4[i + 2], keep = hi ? a4[i + 2] : a4[i]; a2[i] = keep + __shfl_xor(send, 4); } }
    float v; { const bool hi = lane & 2; const float send = hi ? a2[0] : a2[1], keep = hi ? a2[1] : a2[0]; v = keep + __shfl_xor(send, 2); }
    v += __shfl_xor(v, 1); v += __shfl_xor(v, 32);
    return v;
}
__device__ __forceinline__ unsigned wave_max_u32(unsigned v) {
    v = max(v, (unsigned)__builtin_amdgcn_update_dpp(0, (int)v, 0xB1, 0xf, 0xf, true));
    v = max(v, (unsigned)__builtin_amdgcn_update_dpp(0, (int)v, 0x4E, 0xf, 0xf, true));
    v = max(v, (unsigned)__builtin_amdgcn_update_dpp(0, (int)v, 0x124, 0xf, 0xf, true));
    v = max(v, (unsigned)__builtin_amdgcn_update_dpp(0, (int)v, 0x128, 0xf, 0xf, true));
    v = max(v, (unsigned)__builtin_amdgcn_ds_swizzle((int)v, 0x401F));
    return max((unsigned)__builtin_amdgcn_readlane((int)v, 0), (unsigned)__builtin_amdgcn_readlane((int)v, 32));
}
__device__ __forceinline__ void top4(float v, int lane, int (&ei)[4], float (&wv)[4]) {
    const int e = ((lane >> 5) << 4) | ((lane >> 1) & 15); float val[4];
    const unsigned u = __float_as_uint(v);
    unsigned key = ((u ^ ((u >> 31) ? 0xFFFFFFFFu : 0x80000000u)) & ~31u) | (unsigned)(31 - e);
#pragma unroll
    for (int k = 0; k < 4; ++k) {
        const unsigned best = wave_max_u32(key);
        ei[k] = 31 - (int)(best & 31u);
        const unsigned kb = best & ~31u; val[k] = __uint_as_float((kb & 0x80000000u) ? (kb ^ 0x80000000u) : ~kb);
        if (key == best) key = 0u;
    }
    float s = 0.f;
#pragma unroll
    for (int k = 0; k < 4; ++k) { wv[k] = __expf(val[k] - val[0]); s += wv[k]; }
    const float inv = 1.0f / s;
#pragma unroll
    for (int k = 0; k < 4; ++k) wv[k] *= inv;
}
__device__ __forceinline__ void post_phase(const Frame& F, const Args& a, int layer, const float* xin, int nfg, bool do_lists, BgPre& pre) {
    const float* V = (const float*)(a.ws + WS_VEC) + (size_t)(4 + 4 * layer) * D;
    const float* wrt = a.w_router + (size_t)layer * D * NE; const float* brt = a.b_router + layer * NE;
    const rsrc_t rMX = mk_rsrc(a.ws + WS_MX, L * D * 2), rX = mk_rsrc(xin, L * D * 4), rXR = mk_rsrc(a.ws + WS_XR, L * D * 2), rH = mk_rsrc(a.ws + WS_HX2, L * D), rV = mk_rsrc(V, 3 * D * 4);
    int* list = (int*)(a.ws + WS_LIST); float* gate = (float*)(a.ws + WS_GATE); unsigned* gcnt = (unsigned*)(a.ws + WS_CTL) + CW_CNT + 64 * layer;
    LAS unsigned char* lds = F.lds; const int tid = F.tid, lane = F.lane;
    LAS int* tke = (LAS int*)(lds + M_TKE); LAS float* tkw = (LAS float*)(lds + M_TKW); LAS int* rank = (LAS int*)(lds + M_RANK); LAS int* lcnt = (LAS int*)(lds + M_LCNT); LAS int* lbase = (LAS int*)(lds + M_BASE);
    __syncthreads();
    constexpr int XT_HI = 0, XT_LO = 32768, PART = 65536;
    const int wid = F.wave, fr = lane & 15, fq = lane >> 4, et = wid & 1, kq = wid >> 1;
    u32x2 mra[4], mrb[4]; Row xna, xnb; u32x2 xra[4], xrb[4];
    auto first_loads = [&](int tile) { const unsigned t0 = (unsigned)(tile * 64 + 2 * wid);
          row_load_bf16_raw(rMX, t0 * D * 2, lane, mra); row_load_bf16_raw(rMX, (t0 + 1) * D * 2, lane, mrb);
          if (layer == 0) { xna = row_load_f32(rX, t0 * D * 4, lane); xnb = row_load_f32(rX, (t0 + 1) * D * 4, lane); }
          else { row_load_bf16_raw(rXR, t0 * D * 2, lane, xra); row_load_bf16_raw(rXR, (t0 + 1) * D * 2, lane, xrb); } };
    if ((int)blockIdx.x < L / 64) first_loads(blockIdx.x);
    bf16x8 wh[8], wl[8];
    { const bf16_t* wrt = (const bf16_t*)(a.ws + WS_WRT) + (size_t)(layer * 2) * NE * D + (size_t)(16 * et + fr) * D + kq * 256 + 8 * fq;
#pragma unroll
      for (int s_ = 0; s_ < 8; ++s_) { wh[s_] = *(const bf16x8*)(wrt + 32 * s_); wl[s_] = *(const bf16x8*)(wrt + (size_t)NE * D + 32 * s_); } }
    const int el = ((lane >> 5) << 4) | ((lane >> 1) & 15);
    const float bre = brt[el];
    constexpr int CST = 73728;
    for (int i = tid; i < 3 * D / 4; i += NT) *(LAS f32x4*)(lds + CST + i * 16) = *(const f32x4*)(V + 4 * i);
    __syncthreads();
    auto cst_row = [&](int v) { Row r;
#pragma unroll
        for (int j = 0; j < 4; ++j) r.v[j] = *(const LAS f32x4*)(lds + CST + v * 4096 + j * 1024 + lane * 16);
        return r; };
    for (int tile = blockIdx.x; tile < L / 64; tile += nfg) {
        { unsigned l_; asm volatile("v_mbcnt_lo_u32_b32 %0, -1, 0\n\tv_mbcnt_hi_u32_b32 %0, -1, %0" : "=v"(l_)); if (F.wave == 0 && l_ < 32u) lcnt[l_] = 0; }
        __syncthreads();
        if (tile != (int)blockIdx.x) first_loads(tile);
        for (int b = 0; b < 4; ++b) {
            const int lr = 16 * b + 2 * wid; const unsigned t0 = (unsigned)(tile * 64 + lr);
            Row xa, xb;
            {   const Row ma = row_unpack_bf16(mra), mb = row_unpack_bf16(mrb);
                if (layer == 0) { xa = xna; xb = xnb; } else { xa = row_unpack_bf16(xra); xb = row_unpack_bf16(xrb); }
                if (b < 3) { const unsigned t1 = t0 + 16;
                    row_load_bf16_raw(rMX, t1 * D * 2, lane, mra); row_load_bf16_raw(rMX, (t1 + 1) * D * 2, lane, mrb);
                    if (layer == 0) { xna = row_load_f32(rX, t1 * D * 4, lane); xnb = row_load_f32(rX, (t1 + 1) * D * 4, lane); }
                    else { row_load_bf16_raw(rXR, t1 * D * 2, lane, xra); row_load_bf16_raw(rXR, (t1 + 1) * D * 2, lane, xrb); } }
                const float ra = rstd_of(row_sumsq(ma)), rb = rstd_of(row_sumsq(mb));
                const Row cA = cst_row(0);
#pragma unroll
                for (int j = 0; j < 4; ++j) { xa.v[j] += cA.v[j] * (ma.v[j] * ra); xb.v[j] += cA.v[j] * (mb.v[j] * rb); } }
            row_store_bf16(rXR, t0 * D * 2, lane, xa); row_store_bf16(rXR, (t0 + 1) * D * 2, lane, xb);
            { const float ra = rstd_of(row_sumsq(xa)), rb = rstd_of(row_sumsq(xb));
              const Row cB = cst_row(1), cC = cst_row(2);
#pragma unroll
              for (int j = 0; j < 4; ++j) { xa.v[j] = xa.v[j] * ra * cB.v[j] + cC.v[j]; xb.v[j] = xb.v[j] * rb * cB.v[j] + cC.v[j]; } }
            row_store_fp8(rH, t0 * D, lane, xa); row_store_fp8(rH, (t0 + 1) * D, lane, xb);
#pragma unroll
            for (int rr = 0; rr < 2; ++rr) { const Row& xr = rr ? xb : xa; const int row = 2 * wid + rr;
#pragma unroll
                for (int j = 0; j < 4; ++j) { const f32x4 v = xr.v[j];
                    u32x2 h; h.x = cvt_pk_bf16(v[0], v[1]); h.y = cvt_pk_bf16(v[2], v[3]);
                    u32x2 lo; lo.x = cvt_pk_bf16(v[0] - bf_lo(h.x), v[1] - bf_hi(h.x)); lo.y = cvt_pk_bf16(v[2] - bf_lo(h.y), v[3] - bf_hi(h.y));
                    const unsigned ad = (unsigned)row * 2048u + ((((unsigned)(lane >> 1) + 32u * j) ^ (unsigned)row) << 4) + ((unsigned)(lane & 1) << 3);
                    *(LAS u32x2*)(lds + XT_HI + ad) = h; *(LAS u32x2*)(lds + XT_LO + ad) = lo; } }
            __syncthreads();
            {   f32x4 acc = {0.f, 0.f, 0.f, 0.f};
#pragma unroll
                for (int s_ = 0; s_ < 8; ++s_) { const unsigned ad = (unsigned)fr * 2048u + ((((unsigned)(4 * (kq * 8 + s_) + fq)) ^ (unsigned)fr) << 4);
                    const bf16x8 xh = *(const LAS bf16x8*)(lds + XT_HI + ad), xl = *(const LAS bf16x8*)(lds + XT_LO + ad);
                    acc = __builtin_amdgcn_mfma_f32_16x16x32_bf16(wh[s_], xh, acc, 0, 0, 0);
                    acc = __builtin_amdgcn_mfma_f32_16x16x32_bf16(wh[s_], xl, acc, 0, 0, 0);
                    acc = __builtin_amdgcn_mfma_f32_16x16x32_bf16(wl[s_], xh, acc, 0, 0, 0); }
                LAS float* pp = (LAS float*)(lds + PART) + (kq * 2 + et) * 256 + (4 * fq) * 16 + fr;
#pragma unroll
                for (int r_ = 0; r_ < 4; ++r_) pp[r_ * 16] = acc[r_]; }
            __syncthreads();
            {   const LAS float* pp = (const LAS float*)(lds + PART) + (lane >> 5) * 256 + ((lane >> 1) & 15) * 16 + 2 * wid;
                float la = bre, lb = bre;
#pragma unroll
                for (int q_ = 0; q_ < 4; ++q_) { la += pp[q_ * 512]; lb += pp[q_ * 512 + 1]; }
                int ea[4], eb[4]; float wa[4], wb[4];
                top4(la, lane, ea, wa); top4(lb, lane, eb, wb);
                if (lane == 0) {
#pragma unroll
                    for (int k = 0; k < 4; ++k) { tke[lr * 4 + k] = ea[k]; tkw[lr * 4 + k] = wa[k]; tke[(lr + 1) * 4 + k] = eb[k]; tkw[(lr + 1) * 4 + k] = wb[k]; } } }
        }
        __syncthreads();
        if (DRAIN_PRE && do_lists && tile + nfg >= L / 64) { unsigned l_; asm volatile("v_mbcnt_lo_u32_b32 %0, -1, 0\n\tv_mbcnt_hi_u32_b32 %0, -1, %0" : "=v"(l_)); Frame Fq = F; Fq.lane = (int)l_; Fq.tid = F.wave * 64 + (int)l_;
            bg_prefetch(Fq, a, layer, pre); }
        if (do_lists) {
            unsigned l_; asm volatile("v_mbcnt_lo_u32_b32 %0, -1, 0\n\tv_mbcnt_hi_u32_b32 %0, -1, %0" : "=v"(l_)); const int t2 = F.wave * 64 + (int)l_;
            int e = 0;
            if (t2 < 256) { e = tke[t2]; rank[t2] = atomicAdd((int*)&lcnt[e], 1); }
            __syncthreads();
            if (t2 < 32) { const int n = lcnt[t2]; lbase[t2] = n ? (int)atomicAdd(gcnt + t2, (unsigned)n) : 0; }
            __syncthreads();
            if (t2 < 256) { const int pos = lbase[e] + rank[t2], slot = tile * 256 + t2; list[e * LIST_CAP + pos] = slot; gate[e * LIST_CAP + pos] = tkw[t2];
                if (Y_SORTED) ((int*)(a.ws + WS_POS))[slot] = (e << 16) | pos; }
            __syncthreads();
        }
    }
}
}

constexpr int M_TSTART = MISC_OFF + 256, M_CNT = MISC_OFF + 512, M_TILEE = MISC_OFF + 768;
__device__ __forceinline__ gm::MoeTab moe_tables(const Frame& F, const Args& a, int layer, bool reuse = false) {
    LAS int* tstart = (LAS int*)(F.lds + M_TSTART); LAS int* cnt = (LAS int*)(F.lds + M_CNT); LAS unsigned char* tile_e = F.lds + M_TILEE;
    const unsigned* gcnt = (const unsigned*)(a.ws + WS_CTL) + CW_CNT + 64 * layer;
    __syncthreads();
    if (!reuse && F.wave == 0) {
        const int e = F.lane & 31;
        const int n = (int)__hip_atomic_load(gcnt + e, __ATOMIC_RELAXED, __HIP_MEMORY_SCOPE_AGENT), nt = (n + 255) >> 8;
        int ts = 0, tot = 0;
#pragma unroll
        for (int j = 0; j < 32; ++j) { const int v = __builtin_amdgcn_readlane(nt, j); if (j < e) ts += v; tot += v; }
        if (F.lane < 32) { cnt[e] = n; tstart[e] = ts; if (e == 31) tstart[32] = tot;
            for (int t = 0; t < nt; ++t) tile_e[ts + t] = (unsigned char)e; }
    }
    __syncthreads();
    const int T = __builtin_amdgcn_readfirstlane(tstart[32]);
    gm::MoeTab tb; tb.tstart = tstart; tb.cnt = cnt; tb.tile_e = tile_e; tb.T = T; return tb;
}

template <int layer> __device__ __forceinline__ void combine_phase(const Frame& F, const Args& a) {
    const float* V = (const float*)(a.ws + WS_VEC);
    const rsrc_t rY = mk_rsrc(a.ws + WS_Y, Y_SORTED ? (unsigned)ACT_ROWS * D : (unsigned)L * 4 * D * (Y_FP8 ? 1 : 2)), rO = mk_rsrc(a.out, L * D * 4), rXR = mk_rsrc(a.ws + WS_XR, L * D * 2), rHX = mk_rsrc(a.ws + WS_HX, L * D * 2), rV = mk_rsrc(V, 16 * D * 4);
    const int lane = F.lane, gw = F.vcu * NWAVES + F.wave, NGW = F.G * NWAVES;
    const Row cD = row_load_f32(rV, (7 + 4 * layer) * D * 4, lane);
    Row cE, cF;
    if (layer == 0) { cE = row_load_f32(rV, 12 * D * 4, lane); cF = row_load_f32(rV, 13 * D * 4, lane); }
#if Y_FP8 && Y_SORTED
    struct Raw { unsigned y[4][4]; u32x2 x[4]; };
    auto load_raw = [&](int rowv, int ii, int t, Raw& r) {
#pragma unroll
        for (int k = 0; k < 4; ++k) { const unsigned row = (unsigned)__builtin_amdgcn_readlane(rowv, 4 * ii + k);
#pragma unroll
            for (int j = 0; j < 4; ++j) r.y[k][j] = (unsigned)__builtin_amdgcn_raw_buffer_load_b32(rY, 4 * lane, ((((row >> 8) << 2) + j) << 16) + ((row & 255u) << 8), ROW_LD_NT); }
#elif Y_FP8
    struct Raw { unsigned y[4][4]; u32x2 x[4]; };
    auto load_raw = [&](int t, Raw& r) {
#pragma unroll
        for (int k = 0; k < 4; ++k)
#pragma unroll
            for (int j = 0; j < 4; ++j) r.y[k][j] = (unsigned)__builtin_amdgcn_raw_buffer_load_b32(rY, 4 * lane, ((unsigned)t * 4 + k) * D + 256 * j, 0);
#else
    struct Raw { u32x2 y[4][4]; u32x2 x[4]; };
    auto load_raw = [&](int t, Raw& r) {
#pragma unroll
        for (int k = 0; k < 4; ++k) row_load_bf16_raw(rY, ((unsigned)t * 4 + k) * D * 2, lane, r.y[k]);
#endif
        row_load_bf16_raw(rXR, (unsigned)t * D * 2, lane, r.x);
    };
    auto finish = [&](int t, const Raw& r) {
        Row f, x = row_unpack_bf16(r.x);
#pragma unroll
        for (int j = 0; j < 4; ++j) { f.v[j] = (f32x4){0.f, 0.f, 0.f, 0.f};
#pragma unroll
            for (int k = 0; k < 4; ++k) {
#if Y_FP8
                const f32x2 a_ = __builtin_amdgcn_cvt_pk_f32_fp8((int)r.y[k][j], false), b_ = __builtin_amdgcn_cvt_pk_f32_fp8((int)r.y[k][j], true); f.v[j] += (f32x4){a_[0], a_[1], b_[0], b_[1]};
#else
                const u32x2 w = r.y[k][j]; f.v[j] += (f32x4){bf_lo(w.x), bf_hi(w.x), bf_lo(w.y), bf_hi(w.y)};
#endif
            } }
#if Y_FP8
#pragma unroll
        for (int j = 0; j < 4; ++j) f.v[j] = f.v[j] * 0.25f;
#endif
        const float rs = rstd_of(row_sumsq(f));
#pragma unroll
        for (int j = 0; j < 4; ++j) x.v[j] += cD.v[j] * (f.v[j] * rs);
        if (layer == 0) row_store_bf16(rXR, (unsigned)t * D * 2, lane, x); else row_store_f32(rO, (unsigned)t * D * 4, lane, x);
        if (layer == 0) { const float r2 = rstd_of(row_sumsq(x));
#if NO_HX
            if (lane == 0) ((float*)(a.ws + WS_HX))[t] = r2;
#else
#pragma unroll
            for (int j = 0; j < 4; ++j) x.v[j] = x.v[j] * r2 * cE.v[j] + cF.v[j];
            row_store_bf16(rHX, (unsigned)t * D * 2, lane, x);
#endif
        }
    };
#if Y_FP8 && Y_SORTED
    const int* posp = (const int*)(a.ws + WS_POS); const LAS int* tstart = (const LAS int*)(F.lds + M_TSTART);
#pragma unroll 1
    for (int i0 = 0; gw + i0 * NGW < L; i0 += 16) {
        int rowv = 0; { const int t_ = gw + (i0 + (lane >> 2)) * NGW; if (t_ < L) { const int pv = posp[4 * t_ + (lane & 3)]; rowv = (tstart[pv >> 16] << 8) + (pv & 0xffff); } }
#pragma unroll 1
        for (int ii = 0; ii < 16; ii += 2) { const int t0 = gw + (i0 + ii) * NGW, t1 = t0 + NGW; if (t0 >= L) break;
            Raw ra, rb; load_raw(rowv, ii, t0, ra); if (t1 < L) load_raw(rowv, ii + 1, t1, rb); finish(t0, ra); if (t1 < L) finish(t1, rb); }
    }
#else
    int t = gw;
    for (; t + NGW < L; t += 2 * NGW) { Raw ra, rb; load_raw(t, ra); load_raw(t + NGW, rb); finish(t, ra); finish(t + NGW, rb); }
    for (; t < L; t += NGW) { Raw ra; load_raw(t, ra); finish(t, ra); }
#endif
}

__device__ __forceinline__ void diff_phase(const Frame& F, const Args& a) {
    const bf16_t* HX = (const bf16_t*)(a.ws + WS_HX); bf16_t* DF = (bf16_t*)(a.ws + WS_O);
    const int cg = F.tid & 127, rg = F.tid >> 7, g = cg >> 5, hs = 1 << g;
    for (int tile = blockIdx.x; tile < L / 64; tile += F.G) {
        const int t0 = tile * 64 + rg * 16;
        float sum[8];
#pragma unroll
        for (int i = 0; i < 8; ++i) sum[i] = 0.f;
        const int lo0 = max(t0 - hs, 0), hi0 = min(t0 + hs, L);
        for (int u = lo0; u < hi0; ++u) { const u32x4 w = *(const u32x4*)(HX + (size_t)u * D + cg * 8);
            sum[0] += bf_lo(w.x); sum[1] += bf_hi(w.x); sum[2] += bf_lo(w.y); sum[3] += bf_hi(w.y); sum[4] += bf_lo(w.z); sum[5] += bf_hi(w.z); sum[6] += bf_lo(w.w); sum[7] += bf_hi(w.w); }
        for (int t = t0; t < t0 + 16; ++t) {
            const int lo = max(t - hs, 0), hi = min(t + hs, L); const float ic = 1.0f / (float)(hi - lo);
            const u32x4 w = *(const u32x4*)(HX + (size_t)t * D + cg * 8);
            const float cv[8] = {bf_lo(w.x), bf_hi(w.x), bf_lo(w.y), bf_hi(w.y), bf_lo(w.z), bf_hi(w.z), bf_lo(w.w), bf_hi(w.w)};
            u32x4 o; o.x = cvt_pk_bf16(sum[0] * ic - cv[0], sum[1] * ic - cv[1]); o.y = cvt_pk_bf16(sum[2] * ic - cv[2], sum[3] * ic - cv[3]);
            o.z = cvt_pk_bf16(sum[4] * ic - cv[4], sum[5] * ic - cv[5]); o.w = cvt_pk_bf16(sum[6] * ic - cv[6], sum[7] * ic - cv[7]);
            st16(DF + (size_t)t * D + cg * 8, o);
            if (t + hs < L) { const u32x4 e = *(const u32x4*)(HX + (size_t)(t + hs) * D + cg * 8);
                sum[0] += bf_lo(e.x); sum[1] += bf_hi(e.x); sum[2] += bf_lo(e.y); sum[3] += bf_hi(e.y); sum[4] += bf_lo(e.z); sum[5] += bf_hi(e.z); sum[6] += bf_lo(e.w); sum[7] += bf_hi(e.w); }
            if (t - hs >= 0) { const u32x4 e = *(const u32x4*)(HX + (size_t)(t - hs) * D + cg * 8);
                sum[0] -= bf_lo(e.x); sum[1] -= bf_hi(e.x); sum[2] -= bf_lo(e.y); sum[3] -= bf_hi(e.y); sum[4] -= bf_lo(e.z); sum[5] -= bf_hi(e.z); sum[6] -= bf_lo(e.w); sum[7] -= bf_hi(e.w); }
        }
    }
}

template <int HS> __device__ __forceinline__ void diff_tile_t(const Frame& F, const Args& a, int pm, int g) {
#if NO_HX
    const bf16_t* HX = (const bf16_t*)(a.ws + WS_XR); const float* RS = (const float*)(a.ws + WS_HX);
#else
    const bf16_t* HX = (const bf16_t*)(a.ws + WS_HX);
#endif
    bf16_t* DF = (bf16_t*)(a.ws + WS_O);
    const int col = g * 256 + (F.tid & 31) * 8, t0 = pm * 256 + (F.tid >> 5) * 16;
    auto ld = [&](int u) { const int uc = min(max(u, 0), L - 1); return *(const u32x4*)(HX + (size_t)uc * D + col); };
#if NO_HX
    auto lr = [&](int u) { const int uc = min(max(u, 0), L - 1); return RS[uc]; };
    float ce[8]; { const float* cep = (const float*)(a.ws + WS_VEC) + 12 * D + col; const f32x4 c0 = *(const f32x4*)cep, c1 = *(const f32x4*)(cep + 4);
        ce[0] = c0[0]; ce[1] = c0[1]; ce[2] = c0[2]; ce[3] = c0[3]; ce[4] = c1[0]; ce[5] = c1[1]; ce[6] = c1[2]; ce[7] = c1[3]; }
#else
    auto lr = [&](int) { return 1.0f; };
#endif
    auto fma8 = [&](float (&s_)[8], const u32x4& w, float f) { s_[0] += f * bf_lo(w.x); s_[1] += f * bf_hi(w.x); s_[2] += f * bf_lo(w.y); s_[3] += f * bf_hi(w.y); s_[4] += f * bf_lo(w.z); s_[5] += f * bf_hi(w.z); s_[6] += f * bf_lo(w.w); s_[7] += f * bf_hi(w.w); };
    float sum[8];
#pragma unroll
    for (int i = 0; i < 8; ++i) sum[i] = 0.f;
    constexpr int NI = 2 * HS;
    u32x4 w[NI], c[4], e[4], lv[4]; float rw[NI], rc[4], re[4], rl[4];
#pragma unroll
    for (int i = 0; i < NI; ++i) { w[i] = ld(t0 - HS + i); rw[i] = lr(t0 - HS + i); }
#pragma unroll
    for (int i = 0; i < 4; ++i) { const int t = t0 + i; c[i] = ld(t); e[i] = ld(t + HS); lv[i] = ld(t - HS); rc[i] = lr(t); re[i] = lr(t + HS); rl[i] = lr(t - HS); }
#pragma unroll
    for (int i = 0; i < NI; ++i) { const int u = t0 - HS + i; fma8(sum, w[i], (u >= 0 && u < L) ? rw[i] : 0.f); }
#pragma unroll
    for (int b = 0; b < 4; ++b) {
        if (b > 0) {
#pragma unroll
            for (int i = 0; i < 4; ++i) { const int t = t0 + 4 * b + i; c[i] = ld(t); e[i] = ld(t + HS); lv[i] = ld(t - HS); rc[i] = lr(t); re[i] = lr(t + HS); rl[i] = lr(t - HS); } }
#pragma unroll
        for (int i = 0; i < 4; ++i) { const int t = t0 + 4 * b + i;
            const int lo = max(t - HS, 0), hi = min(t + HS, L); const float ic = 1.0f / (float)(hi - lo);
            const u32x4 wc_ = c[i]; const float rt = rc[i];
            const float cv[8] = {bf_lo(wc_.x) * rt, bf_hi(wc_.x) * rt, bf_lo(wc_.y) * rt, bf_hi(wc_.y) * rt, bf_lo(wc_.z) * rt, bf_hi(wc_.z) * rt, bf_lo(wc_.w) * rt, bf_hi(wc_.w) * rt};
            float dv[8];
#pragma unroll
            for (int k = 0; k < 8; ++k) { dv[k] = sum[k] * ic - cv[k];
#if NO_HX
                dv[k] *= ce[k];
#endif
            }
            u32x4 o; o.x = cvt_pk_bf16(dv[0], dv[1]); o.y = cvt_pk_bf16(dv[2], dv[3]); o.z = cvt_pk_bf16(dv[4], dv[5]); o.w = cvt_pk_bf16(dv[6], dv[7]);
            st16(DF + (size_t)t * D + col, o);
            fma8(sum, e[i], (t + HS < L) ? re[i] : 0.f); fma8(sum, lv[i], (t - HS >= 0) ? -rl[i] : 0.f); } }
}
__device__ __forceinline__ void diff_tile(const Frame& F, const Args& a, int pm, int g) {
    if (g == 0) diff_tile_t<1>(F, a, pm, g); else if (g == 1) diff_tile_t<2>(F, a, pm, g); else if (g == 2) diff_tile_t<4>(F, a, pm, g); else diff_tile_t<8>(F, a, pm, g);
}

constexpr int N_PHASES = 15;
__global__ void __launch_bounds__(NT, 2) mk_fwd(Args args) {
    extern __shared__ __attribute__((aligned(16))) unsigned char lds_raw[];
    Frame F; F.lds = (LAS unsigned char*)lds_raw; F.tid = 0; F.lane = 0; F.wave = __builtin_amdgcn_readfirstlane(threadIdx.x >> 6);
    F.G = gridDim.x; { const int bx = blockIdx.x; F.vcu = (F.G % 8 == 0) ? (bx % 8) * (F.G / 8) + bx / 8 : bx; }
    volatile LAS unsigned* MISC = (volatile LAS unsigned*)(F.lds + MISC_OFF);
    if (threadIdx.x < 16) MISC[threadIdx.x] = 0u;
    __syncthreads();
    const int lo = args.ph_lo, hi = args.ph_hi;
    unsigned* ctl = (unsigned*)(args.ws + WS_CTL);
    XcdBarrier bar; bar.bar = ctl + CW_BAR; bar.x = 0; bar.st = nullptr;
    if (hi - lo > 1) bar = xcd_barrier_post(ctl + CW_BAR, MISC + 8, threadIdx.x == 0);
#ifndef P0_CONV_WGS
#define P0_CONV_WGS 0
#endif
#ifndef PROBE_BAR2
#define PROBE_BAR2 0
#endif
#ifndef POST_FG
#define POST_FG 256
#endif
#ifndef CTX_IN_P1
#define CTX_IN_P1 0
#endif
#ifndef MOE_EXTRA_ROUNDS
#define MOE_EXTRA_ROUNDS 0
#endif
#ifndef FUSE_DIFF
#define FUSE_DIFF 1
#endif
#ifndef BG_STOP_NUM
#define BG_STOP_NUM 1
#define BG_STOP_DEN 1
#endif
#ifndef BG_MASK
#define BG_MASK 0xffff
#endif
#ifndef PROBE_DUP
#define PROBE_DUP 0
#endif
#ifndef STAGGER
#define STAGGER 0
#endif

#define REPS(k) (((PROBE_DUP >> (k)) & 1) ? 2 : 1)
#ifndef PH_MASK
#define PH_MASK 0x7fff
#endif
#define IN(k) (((PH_MASK >> (k)) & 1) && lo <= (k) && (k) < hi)
#define PHASE_FRAME() Frame Fp = F; { unsigned l_; asm volatile("v_mbcnt_lo_u32_b32 %0, -1, 0\n\tv_mbcnt_hi_u32_b32 %0, -1, %0" : "=v"(l_)); Fp.lane = (int)l_; Fp.tid = F.wave * 64 + (int)l_; }
#define SEAM(k) do { if (IN(k) && IN((k) + 1)) { unsigned l_; asm volatile("v_mbcnt_lo_u32_b32 %0, -1, 0\n\tv_mbcnt_hi_u32_b32 %0, -1, %0" : "=v"(l_)); xcd_barrier(bar, F.wave == 0 && l_ == 0u); if (PROBE_BAR2) xcd_barrier(bar, F.wave == 0 && l_ == 0u); } } while (0)
    unsigned char* ws = args.ws;
    bf16_t* HX = (bf16_t*)(ws + WS_HX);
    const float* mod0 = (const float*)(ws + WS_MOD);

    if (IN(0)) for (int rep_ = 0; rep_ < REPS(0); ++rep_) { PHASE_FRAME(); p0_adaln(Fp, args); p0_router_weights(Fp, args); p0_convert_small(Fp, args); if ((int)blockIdx.x < P0_CONV_WGS) { BgPre nopre_; nopre_.have = 0; bg_convert(Fp, args, 0, 0, 0u, false, nopre_); bg_convert(Fp, args, 1, 0, 0u, false, nopre_); } }
    SEAM(0);
    const bool ctx_p1 = CTX_IN_P1 && !QKV_FP8 && F.G == 256;
    if (IN(1)) for (int rep_ = 0; rep_ < REPS(1); ++rep_) { PHASE_FRAME();
        if (ctx_p1) {
            if (blockIdx.x >= 248) {
                modulate_rows(Fp, args.ctx, CTX, args.norm_g, mod0 + 6144, mod0 + 6144 + D, HX + (size_t)L * D, Fp.wave, NWAVES);
                asm volatile("s_waitcnt vmcnt(0)" ::: "memory"); __syncthreads();
                gm::OneProb P{(const char*)HX, (const char*)(ws + WS_WQKV), 2048u, 2048u, 1024, L / 256, 4 + ((int)blockIdx.x - 248), (size_t)256 * 2048};
                gm::EpiBf16 E{(bf16_t*)(ws + WS_Q), D, nullptr, nullptr, D, (size_t)(WS_K - WS_Q) / 2, QSCALE, 256, 1.f};
                gm::gemm_phase(Fp.lds, Fp.tid, P, E);
            } else {
                modulate_rows(Fp, args.x, L, args.norm_g, mod0, mod0 + D, HX, (int)blockIdx.x * NWAVES + Fp.wave, 248 * NWAVES);
                if (blockIdx.x == 247) vec_phase(Fp, args);
            }
        } else {
            modulate_rows<QKV_FP8 != 0>(Fp, args.x, L, args.norm_g, mod0, mod0 + D, HX, Fp.vcu * NWAVES + Fp.wave, (int)F.G * NWAVES);
            modulate_rows<QKV_FP8 != 0>(Fp, args.ctx, CTX, args.norm_g, mod0 + 6144, mod0 + 6144 + D, QKV_FP8 ? (void*)((unsigned char*)HX + (size_t)L * D) : (void*)(HX + (size_t)L * D), Fp.vcu * NWAVES + Fp.wave, (int)F.G * NWAVES);
        }
    }
    SEAM(1);
    if (IN(2)) for (int rep_ = 0; rep_ < REPS(2); ++rep_) { PHASE_FRAME();
        const int nMq = ctx_p1 ? L / 256 : MQ / 256, NU = nMq * 12; const int Gf = min((int)F.G, (NU + ((NU + F.G - 1) / F.G) - 1) / ((NU + F.G - 1) / F.G));
        if ((int)blockIdx.x < Gf) {
#if QKV_FP8
            gm::DenseProbT<true> P{(const char*)HX, (const char*)(ws + WS_WQKV), 1024u, 1024u, 1024, nMq, 12, Gf, (int)blockIdx.x, 0, (size_t)256 * 1024};
            gm::EpiBf16 E{(bf16_t*)(ws + WS_Q), D, nullptr, nullptr, D, (size_t)(WS_K - WS_Q) / 2, QSCALE, 256, 0.015625f};
#else
            gm::DenseProb P{(const char*)HX, (const char*)(ws + WS_WQKV), 2048u, 2048u, 1024, nMq, 12, Gf, (int)blockIdx.x, 0, (size_t)256 * 2048};
            gm::EpiBf16 E{(bf16_t*)(ws + WS_Q), D, nullptr, nullptr, D, (size_t)(WS_K - WS_Q) / 2, QSCALE, 256, 1.f};
#endif
            gm::gemm_phase(Fp.lds, Fp.tid, P, E);
        }
        if (!ctx_p1 && blockIdx.x == gridDim.x - 1) { PHASE_FRAME(); vec_phase(Fp, args); }
        if ((BG_MASK >> 2) & 1) { PHASE_FRAME(); BgPre nopre_; nopre_.have = 0; bg_convert(Fp, args, 0, 2, (unsigned)max(1, Gf * BG_STOP_NUM / BG_STOP_DEN), (int)blockIdx.x < Gf, nopre_); }
    }
    SEAM(2);
    if (IN(3)) for (int rep_ = 0; rep_ < REPS(3); ++rep_) { PHASE_FRAME(); na::attn_phase(Fp, args);
        if (F.G == 256 && ((BG_MASK >> 3) & 1)) { PHASE_FRAME(); BgPre nopre_; nopre_.have = 0; bg_convert(Fp, args, 0, 3, (unsigned)max(1, 16 * ATT_STRIPS * BG_STOP_NUM / BG_STOP_DEN), (int)blockIdx.x < 16 * ATT_STRIPS, nopre_); } }
    SEAM(3);
    if (IN(4)) for (int rep_ = 0; rep_ < REPS(4); ++rep_) { PHASE_FRAME();
        gm::DenseProb P{(const char*)(ws + WS_O), (const char*)(ws + WS_WO), 2048u, 2048u, 1024, L / 256, 4, F.G, (int)blockIdx.x, 0, (size_t)256 * 2048};
        gm::EpiBf16 E{(bf16_t*)(ws + WS_MX), D, nullptr, nullptr, 0, 0, 1.f, 256, 1.f};
        gm::gemm_phase(Fp.lds, Fp.tid, P, E);
    }
    SEAM(4);
    if (IN(5)) for (int rep_ = 0; rep_ < REPS(5); ++rep_) { const int nfg = (F.G == 256) ? POST_FG : (int)F.G;
        BgPre pre_; pre_.have = 0;
        if ((int)blockIdx.x < nfg) { PHASE_FRAME(); post::post_phase(Fp, args, 0, args.x, nfg, rep_ == REPS(5) - 1, pre_); }
        { PHASE_FRAME(); bg_convert<true>(Fp, args, 0, 5, 0u, false, pre_); } }
    SEAM(5);
    if (IN(6)) for (int rep_ = 0; rep_ < REPS(6); ++rep_) { PHASE_FRAME();
        const gm::MoeTab tb = moe_tables(Fp, args, 0);
        const int NU = tb.T * 8, rounds = (NU + F.G - 1) / F.G + MOE_EXTRA_ROUNDS, Gf = min((int)F.G, (NU + rounds - 1) / rounds);
        if ((int)blockIdx.x < Gf) {
            const bool hot_ = PROBE_HOT == 1 && REPS(6) == 2 && rep_ == 0; const unsigned ld_ = hot_ ? 0u : 1024u;
            gm::MoeProb<true> P{(const char*)(ws + WS_HX2), (const char*)(ws + WS_WUP), ld_, ld_, 1024, 8, Gf, (int)blockIdx.x, tb, (const int*)(ws + WS_LIST), hot_ ? (size_t)0 : (size_t)2048 * 1024, hot_ ? (size_t)0 : (size_t)256 * 1024};
            gm::EpiSwiglu E{ws + WS_ACT, args.b_up};
#if PROBE_NOEPI
            E.skip = REPS(6) == 2 && rep_ == 0;
#endif
            gm::gemm_phase(Fp.lds, Fp.tid, P, E);
        }
        if ((BG_MASK >> 6) & 1) { PHASE_FRAME(); BgPre nopre_; nopre_.have = 0; bg_convert(Fp, args, 1, 6, (unsigned)max(1, Gf * BG_STOP_NUM / BG_STOP_DEN), (int)blockIdx.x < Gf, nopre_); }
    }
    SEAM(6);
    if (IN(7)) for (int rep_ = 0; rep_ < REPS(7); ++rep_) { PHASE_FRAME();
        const gm::MoeTab tb = moe_tables(Fp, args, 0, IN(6));
        const int NU = tb.T * 4, rounds = (NU + F.G - 1) / F.G + MOE_EXTRA_ROUNDS, Gf = min((int)F.G, (NU + rounds - 1) / rounds);
        if (STAGGER && (blockIdx.x & 1)) for (int i_ = 0; i_ < STAGGER; ++i_) __builtin_amdgcn_s_sleep(64);
        if ((int)blockIdx.x < Gf) {
            const bool hot_ = PROBE_HOT == 1 && REPS(7) == 2 && rep_ == 0; const unsigned ld_ = hot_ ? 0u : 1024u;
            gm::MoeProb<false> P{(const char*)(ws + WS_ACT), (const char*)(ws + WS_WDN), ld_, ld_, 1024, 4, Gf, (int)blockIdx.x, tb, (const int*)(ws + WS_LIST), hot_ ? (size_t)0 : (size_t)1024 * 1024, hot_ ? (size_t)0 : (size_t)256 * 1024};
#if PROBE_HOT == 2
            P.same = REPS(7) == 2 && rep_ == 0;
#endif
            gm::EpiDown E{ws + WS_Y, args.b_down, (const float*)(ws + WS_GATE), (const int*)(ws + WS_LIST), tb, Fp.lds};
#if PROBE_NOEPI
            E.skip = REPS(7) == 2 && rep_ == 0;
#endif
            gm::gemm_phase(Fp.lds, Fp.tid, P, E);
        }
        if ((BG_MASK >> 7) & 1) { PHASE_FRAME(); BgPre nopre_; nopre_.have = 0; bg_convert(Fp, args, 1, 7, (unsigned)max(1, Gf * BG_STOP_NUM / BG_STOP_DEN), (int)blockIdx.x < Gf, nopre_); }
    }
    SEAM(7);
    if (IN(8)) for (int rep_ = 0; rep_ < REPS(8); ++rep_) { PHASE_FRAME(); if (Y_SORTED) (void)moe_tables(Fp, args, 0, IN(7)); combine_phase<0>(Fp, args); }
    SEAM(8);
    if (!FUSE_DIFF) { if (IN(9)) for (int rep_ = 0; rep_ < REPS(9); ++rep_) { PHASE_FRAME(); diff_phase(Fp, args); }
        SEAM(9); }
    if (IN(10)) for (int rep_ = 0; rep_ < REPS(10); ++rep_) { PHASE_FRAME();
        gm::DenseProb P{(const char*)(ws + WS_O), (const char*)(ws + WS_WPOOL), 2048u, 512u, 256, L / 256, 4, F.G, (int)blockIdx.x, 512, (size_t)256 * 512};
        if (FUSE_DIFF) {
            gm::Unit u_; for (int i_ = 0; P.next(i_, u_); ++i_) diff_tile(Fp, args, u_.pm, u_.pn);
            asm volatile("s_waitcnt vmcnt(0)" ::: "memory"); __syncthreads();
        }
        gm::EpiBf16 E{(bf16_t*)(ws + WS_MX), D, args.pool_b, args.pool_scale, 0, 0, 1.f, 256, 1.f};
        gm::gemm_phase(Fp.lds, Fp.tid, P, E);
    }
    SEAM(10);
    if (IN(11)) for (int rep_ = 0; rep_ < REPS(11); ++rep_) { const int nfg = (F.G == 256) ? POST_FG : (int)F.G;
        BgPre pre_; pre_.have = 0;
        if ((int)blockIdx.x < nfg) { PHASE_FRAME(); post::post_phase(Fp, args, 1, args.x, nfg, true, pre_); }
        { PHASE_FRAME(); bg_convert<true>(Fp, args, 1, 11, 0u, false, pre_); } }
    SEAM(11);
    if (IN(12)) for (int rep_ = 0; rep_ < REPS(12); ++rep_) { PHASE_FRAME();
        const gm::MoeTab tb = moe_tables(Fp, args, 1);
        gm::MoeProb<true> P{(const char*)(ws + WS_HX2), (const char*)(ws + WS_WUP) + (size_t)32 * 2048 * 1024, 1024u, 1024u, 1024, 8, F.G, (int)blockIdx.x, tb, (const int*)(ws + WS_LIST), (size_t)2048 * 1024, (size_t)256 * 1024};
        gm::EpiSwiglu E{ws + WS_ACT, args.b_up + 32 * 2048};
        gm::gemm_phase(Fp.lds, Fp.tid, P, E);
    }
    SEAM(12);
    if (IN(13)) for (int rep_ = 0; rep_ < REPS(13); ++rep_) { PHASE_FRAME();
        const gm::MoeTab tb = moe_tables(Fp, args, 1, IN(12));
        if (STAGGER && (blockIdx.x & 1)) for (int i_ = 0; i_ < STAGGER; ++i_) __builtin_amdgcn_s_sleep(64);
        gm::MoeProb<false> P{(const char*)(ws + WS_ACT), (const char*)(ws + WS_WDN) + (size_t)32 * 1024 * 1024, 1024u, 1024u, 1024, 4, F.G, (int)blockIdx.x, tb, (const int*)(ws + WS_LIST), (size_t)1024 * 1024, (size_t)256 * 1024};
        gm::EpiDown E{ws + WS_Y, args.b_down + 32 * D, (const float*)(ws + WS_GATE), (const int*)(ws + WS_LIST), tb, Fp.lds};
        gm::gemm_phase(Fp.lds, Fp.tid, P, E);
    }
    SEAM(13);
    if (IN(14)) for (int rep_ = 0; rep_ < REPS(14); ++rep_) { PHASE_FRAME(); if (Y_SORTED) (void)moe_tables(Fp, args, 1, IN(13)); combine_phase<1>(Fp, args); }
#undef IN
#undef SEAM
#undef PHASE_FRAME
}

extern "C" void kernel_launch(void* const* d_in, const int* in_sizes, int n_in, void* d_out, int out_size, void* d_ws, size_t ws_size, hipStream_t stream) {
    static int grid = 0;
    if (grid == 0) {
        if (n_in != 19 || in_sizes[0] != L * D || out_size != L * D || ws_size < WS_END) { fprintf(stderr, "kernel_launch: unexpected problem (n_in %d, in0 %d, out %d, ws %zu); nothing launched\n", n_in, n_in > 0 ? in_sizes[0] : -1, out_size, ws_size); grid = -1; return; }
        int dev = 0, cus = 0, per_cu = 0;
        if (hipGetDevice(&dev) != hipSuccess || hipDeviceGetAttribute(&cus, hipDeviceAttributeMultiprocessorCount, dev) != hipSuccess) { grid = -1; return; }
        if (hipFuncSetAttribute((const void*)mk_fwd, hipFuncAttributeMaxDynamicSharedMemorySize, LDS_BYTES) != hipSuccess) { fprintf(stderr, "kernel_launch: hipFuncSetAttribute failed\n"); grid = -1; return; }
        if (hipOccupancyMaxActiveBlocksPerMultiprocessor(&per_cu, (const void*)mk_fwd, NT, LDS_BYTES) != hipSuccess || per_cu < 1) fprintf(stderr, "kernel_launch: occupancy query reports %d workgroups per CU\n", per_cu);
        (void)hipGetLastError();
        grid = cus;
    }
    if (grid < 0) return;
    (void)hipMemsetAsync((char*)d_ws + WS_CTL, 0, CTL_ZERO_BYTES, stream);
    Args a{};
    a.x = (const float*)d_in[0]; a.c = (const float*)d_in[1]; a.ctx = (const float*)d_in[2]; a.c_ctx = (const float*)d_in[3]; a.ada_w = (const float*)d_in[4]; a.ada_b = (const float*)d_in[5];
    a.norm_g = (const float*)d_in[6]; a.w_qkv = (const float*)d_in[7]; a.w_o = (const float*)d_in[8]; a.rpb = (const float*)d_in[9]; a.pool_w = (const float*)d_in[10]; a.pool_b = (const float*)d_in[11];
    a.pool_scale = (const float*)d_in[12]; a.w_router = (const float*)d_in[13]; a.b_router = (const float*)d_in[14]; a.w_up = (const float*)d_in[15]; a.b_up = (const float*)d_in[16];
    a.w_down = (const float*)d_in[17]; a.b_down = (const float*)d_in[18];
    a.out = (float*)d_out; a.ws = (unsigned char*)d_ws;
#if MK_ONE_LAUNCH
    a.ph_lo = 0; a.ph_hi = N_PHASES;
    hipLaunchKernelGGL(mk_fwd, dim3(grid), dim3(NT), LDS_BYTES, stream, a);
#else
    for (int p = 0; p < N_PHASES; ++p) { a.ph_lo = p; a.ph_hi = p + 1; hipLaunchKernelGGL(mk_fwd, dim3(grid), dim3(NT), LDS_BYTES, stream, a); }
#endif
}
```
